# Optimizing an MI355X kernel written in HIP

```python
import jax, jax.numpy as jnp
from jax import lax
import numpy as np

D_MODEL = 2048
BATCH = 8
SEQ = 2048
DEPTH = 1

NSA_HEADS = 16
NSA_HEAD_DIM = 64
NSA_KV_GROUPS = 4
NSA_WIDTH = NSA_HEADS * NSA_HEAD_DIM
NSA_KV_WIDTH = NSA_KV_GROUPS * NSA_HEAD_DIM
CMP_LEN = 32
CMP_STRIDE = 16
SEL_LEN = 64
N_SEL = 8
WINDOW = 512
Q_BLOCK = 64
LRU_WIDTH = D_MODEL - NSA_WIDTH
LRU_BLOCKS = 16
LRU_BLOCK_W = LRU_WIDTH // LRU_BLOCKS
CONV_W = 4
RG_C = 8.0
N_EXPERTS = 32
TOP_K = 4
D_FF_EXPERT = D_MODEL
SWIGLU_LIMIT = 7.0
SWIGLU_ALPHA = 1.702
MOE_BLOCK = 256
NORM_EPS = 1e-6
NEG_INF = -1e30
SEL_FORCE = 1e30
IN_WIDTH = NSA_WIDTH + 6 * NSA_KV_WIDTH + 3 * NSA_HEADS + 2 * LRU_WIDTH

kernel_name = 'hymba_nsa_rglru_moe_adaln_layer'


def rms_norm(x, g):
    xf = x.astype(jnp.float32)
    y = xf * lax.rsqrt(jnp.mean(xf * xf, axis=-1, keepdims=True) + NORM_EPS)
    return (y * g.astype(jnp.float32)).astype(x.dtype)


def masked_softmax(s, mask):
    return jax.nn.softmax(jnp.where(mask, s, NEG_INF), axis=-1) * mask


def compress_blocks(k, pe, w):
    B, S, G, HD = k.shape
    n_sub = CMP_LEN // CMP_STRIDE
    sub = k.reshape(B, S // CMP_STRIDE, CMP_STRIDE, G, HD)
    n_cmp = S // CMP_STRIDE - n_sub + 1
    blocks = jnp.concatenate([sub[:, j:j + n_cmp] for j in range(n_sub)], axis=2)
    blocks = blocks + pe[None, None, :, None, :]
    flat = blocks.transpose(0, 1, 3, 2, 4).reshape(B, n_cmp, G, CMP_LEN * HD)
    return flat @ w


def nsa_mixer(q, k_c, v_c, k_s, v_s, k_w, v_w, gate_logits, pe_k, pe_v, w_ck, w_cv, q_gain, k_gain):
    B, S, H, HD = q.shape
    G = NSA_KV_GROUPS
    HG = H // G
    dt = q.dtype
    scale = NSA_HEAD_DIM ** -0.5
    qg = rms_norm(q, q_gain).reshape(B, S, G, HG, HD)
    t_all = jnp.arange(S)

    kc = rms_norm(compress_blocks(k_c, pe_k, w_ck), k_gain[0])
    vc = compress_blocks(v_c, pe_v, w_cv)
    n_cmp = kc.shape[1]
    cmp_start = jnp.arange(n_cmp) * CMP_STRIDE
    m_c = (cmp_start + CMP_LEN - 1)[None, :] <= t_all[:, None]
    s_c = jnp.einsum('bsghd,bcgd->bghsc', qg, kc).astype(jnp.float32) * scale
    p_c = masked_softmax(s_c, m_c)
    o_c = jnp.einsum('bghsc,bcgd->bsghd', p_c.astype(dt), vc)

    n_blk = S // SEL_LEN
    n_sel = min(N_SEL, n_blk)
    sel_start = jnp.arange(n_blk) * SEL_LEN
    overlap = ((cmp_start[:, None] < sel_start[None, :] + SEL_LEN)
               & (cmp_start[:, None] + CMP_LEN > sel_start[None, :])).astype(jnp.float32)
    imp = jnp.einsum('bghsc,cj->bgsj', p_c, overlap)
    q_blk = t_all // SEL_LEN
    j = jnp.arange(n_blk)
    valid = j[None, :] <= q_blk[:, None]
    forced = (j[None, :] == 0) | (j[None, :] == q_blk[:, None]) | (j[None, :] == q_blk[:, None] - 1)
    imp = jnp.where(forced, SEL_FORCE, jnp.where(valid, imp, -SEL_FORCE))
    _, sel_idx = lax.top_k(imp, n_sel)

    k_blocks = rms_norm(k_s, k_gain[1]).reshape(B, n_blk, SEL_LEN, G, HD).transpose(0, 3, 1, 2, 4)
    v_blocks = v_s.reshape(B, n_blk, SEL_LEN, G, HD).transpose(0, 3, 1, 2, 4)
    pad = ((0, 0), (WINDOW, 0), (0, 0), (0, 0))
    k_wp = jnp.pad(rms_norm(k_w, k_gain[2]), pad)
    v_wp = jnp.pad(v_w, pad)
    b_ix = jnp.arange(B)[:, None, None, None]
    g_ix = jnp.arange(G)[None, :, None, None]
    n_keys = n_sel * SEL_LEN

    def query_block(qs):
        qc = lax.dynamic_slice_in_dim(qg, qs, Q_BLOCK, axis=1)
        t = qs + jnp.arange(Q_BLOCK)
        ic = lax.dynamic_slice_in_dim(sel_idx, qs, Q_BLOCK, axis=2)
        kg = k_blocks[b_ix, g_ix, ic].reshape(B, G, Q_BLOCK, n_keys, HD)
        vg = v_blocks[b_ix, g_ix, ic].reshape(B, G, Q_BLOCK, n_keys, HD)
        pos = (ic[..., None] * SEL_LEN + jnp.arange(SEL_LEN)).reshape(B, G, Q_BLOCK, n_keys)
        m_s = (pos <= t[None, None, :, None])[:, :, None]
        s_s = jnp.einsum('bqghd,bgqkd->bghqk', qc, kg).astype(jnp.float32) * scale
        o_s = jnp.einsum('bghqk,bgqkd->bqghd', masked_softmax(s_s, m_s).astype(dt), vg)
        kwc = lax.dynamic_slice_in_dim(k_wp, qs, WINDOW + Q_BLOCK, axis=1)
        vwc = lax.dynamic_slice_in_dim(v_wp, qs, WINDOW + Q_BLOCK, axis=1)
        kpos = qs - WINDOW + jnp.arange(WINDOW + Q_BLOCK)
        m_w = ((kpos[None, :] <= t[:, None]) & (kpos[None, :] > t[:, None] - WINDOW)
               & (kpos[None, :] >= 0))
        s_w = jnp.einsum('bqghd,bkgd->bghqk', qc, kwc).astype(jnp.float32) * scale
        o_w = jnp.einsum('bghqk,bkgd->bqghd', masked_softmax(s_w, m_w).astype(dt), vwc)
        return o_s, o_w

    o_s, o_w = lax.map(query_block, jnp.arange(S // Q_BLOCK) * Q_BLOCK)
    o_s = jnp.moveaxis(o_s, 0, 1).reshape(B, S, G, HG, HD)
    o_w = jnp.moveaxis(o_w, 0, 1).reshape(B, S, G, HG, HD)
    g = jax.nn.sigmoid(gate_logits.astype(jnp.float32)).astype(dt).reshape(B, S, G, HG, 3)
    o = g[..., 0:1] * o_c + g[..., 1:2] * o_s + g[..., 2:3] * o_w
    return o.reshape(B, S, H * HD)


def _linear_combine(e1, e2):
    a1, b1 = e1
    a2, b2 = e2
    return a1 * a2, a2 * b1 + b2


def rglru_mixer(xr, xg, conv_w, conv_b, w_rg, b_rg, w_ig, b_ig, lam):
    B, S, W = xr.shape
    xp = jnp.pad(xr, ((0, 0), (CONV_W - 1, 0), (0, 0)))
    xc = conv_b + sum(xp[:, k:k + S] * conv_w[k] for k in range(CONV_W))
    xb = xc.reshape(B, S, LRU_BLOCKS, LRU_BLOCK_W)
    r = jax.nn.sigmoid(jnp.einsum('bsnc,ncd->bsnd', xb, w_rg) + b_rg).reshape(B, S, W)
    i = jax.nn.sigmoid(jnp.einsum('bsnc,ncd->bsnd', xb, w_ig) + b_ig).reshape(B, S, W)
    log_a = (-RG_C * jax.nn.softplus(-lam.astype(jnp.float32))) * r.astype(jnp.float32)
    a = jnp.exp(log_a)
    u = jnp.sqrt(-jnp.expm1(2.0 * log_a)) * (i * xc).astype(jnp.float32)
    _, h = lax.associative_scan(_linear_combine, (a, u), axis=1)
    return h.astype(xr.dtype) * jax.nn.gelu(xg)


def moe_ffn(h, w_router, b_router, w1, b1, w2, b2):
    B, S, D = h.shape
    N = B * S
    A = N * TOP_K
    hf = h.reshape(N, D)
    logits = (hf @ w_router + b_router).astype(jnp.float32)
    top_v, top_e = lax.top_k(logits, TOP_K)
    gates = jax.nn.softmax(top_v, axis=-1)
    e_flat = top_e.reshape(A).astype(jnp.int32)
    tok_flat = jnp.arange(A, dtype=jnp.int32) // TOP_K
    g_flat = gates.reshape(A)
    order = jnp.argsort(e_flat)
    e_s, tok_s, g_s = e_flat[order], tok_flat[order], g_flat[order]
    counts = jnp.bincount(e_flat, length=N_EXPERTS)
    starts = jnp.cumsum(counts) - counts
    pcounts = (counts + MOE_BLOCK - 1) // MOE_BLOCK * MOE_BLOCK
    pends = jnp.cumsum(pcounts)
    pstarts = pends - pcounts
    dest = pstarts[e_s] + jnp.arange(A, dtype=jnp.int32) - starts[e_s]
    n_blocks = (A + N_EXPERTS * (MOE_BLOCK - 1) + MOE_BLOCK - 1) // MOE_BLOCK
    P = n_blocks * MOE_BLOCK
    buf_tok = jnp.zeros((P,), jnp.int32).at[dest].set(tok_s)
    buf_g = jnp.zeros((P,), jnp.float32).at[dest].set(g_s)
    blk_e = jnp.minimum(jnp.searchsorted(pends, jnp.arange(n_blocks) * MOE_BLOCK, side='right'),
                        N_EXPERTS - 1)

    def expert_block(args):
        e, tok, g = args
        xb = hf[tok]
        u = xb @ w1[e] + b1[e]
        u_glu, u_lin = jnp.split(u, 2, axis=-1)
        u_glu = jnp.minimum(u_glu, SWIGLU_LIMIT)
        u_lin = jnp.clip(u_lin, -SWIGLU_LIMIT, SWIGLU_LIMIT)
        act = u_glu * jax.nn.sigmoid(SWIGLU_ALPHA * u_glu) * (u_lin + 1)
        y = act @ w2[e] + b2[e]
        return y * g[:, None].astype(y.dtype)

    yb = lax.map(expert_block, (blk_e, buf_tok.reshape(n_blocks, MOE_BLOCK),
                                buf_g.reshape(n_blocks, MOE_BLOCK)))
    out = jnp.zeros((N, D), yb.dtype).at[buf_tok].add(yb.reshape(P, D))
    return out.reshape(B, S, D).astype(h.dtype)


def hybrid_layer(x, mod, g_norm1, w_in, pe_cmp_k, pe_cmp_v, w_cmp_k, w_cmp_v, q_gain, k_gain,
                 conv_w, conv_b, w_rg, b_rg, w_ig, b_ig, lru_lambda, g_out_nsa, g_out_lru,
                 w_out, g_norm2, w_router, b_router, w_e1, b_e1, w_e2, b_e2):
    B, S, D = x.shape
    shift1, scale1, gate1, shift2, scale2, gate2 = [m[:, None, :] for m in jnp.split(mod, 6, axis=-1)]
    h = rms_norm(x, g_norm1) * (1 + scale1) + shift1
    z = h @ w_in
    sizes = [NSA_WIDTH] + [NSA_KV_WIDTH] * 6 + [3 * NSA_HEADS, LRU_WIDTH, LRU_WIDTH]
    q, k_c, v_c, k_s, v_s, k_w, v_w, gl, xr, xg = jnp.split(z, np.cumsum(sizes)[:-1].tolist(), axis=-1)
    kv = lambda t: t.reshape(B, S, NSA_KV_GROUPS, NSA_HEAD_DIM)
    o_nsa = nsa_mixer(q.reshape(B, S, NSA_HEADS, NSA_HEAD_DIM), kv(k_c), kv(v_c), kv(k_s), kv(v_s),
                      kv(k_w), kv(v_w), gl, pe_cmp_k, pe_cmp_v, w_cmp_k, w_cmp_v, q_gain, k_gain)
    o_lru = rglru_mixer(xr, xg, conv_w, conv_b, w_rg, b_rg, w_ig, b_ig, lru_lambda)
    mix = jnp.concatenate([rms_norm(o_nsa, g_out_nsa), rms_norm(o_lru, g_out_lru)], axis=-1) @ w_out
    x = x + gate1 * mix
    h2 = rms_norm(x, g_norm2) * (1 + scale2) + shift2
    return x + gate2 * moe_ffn(h2, w_router, b_router, w_e1, b_e1, w_e2, b_e2)


def setup_inputs(seed: int = 0) -> dict:
    key = jax.random.key(seed)
    ks = jax.random.split(key, 30)
    L = DEPTH
    nrm = lambda k, shape, s: jax.random.normal(k, shape, jnp.float32) * s
    u = jax.random.uniform(ks[18], (L, LRU_WIDTH), jnp.float32, minval=0.9, maxval=0.999)
    a0 = u ** (1.0 / RG_C)
    return {
        'x': nrm(ks[0], (BATCH, SEQ, D_MODEL), 1.0),
        'c': nrm(ks[1], (BATCH, D_MODEL), 1.0),
        'w_ada': nrm(ks[2], (L, D_MODEL, 6 * D_MODEL), 0.5 * D_MODEL ** -0.5),
        'b_ada': nrm(ks[3], (L, 6 * D_MODEL), 0.02),
        'g_norm1': 1.0 + nrm(ks[4], (L, D_MODEL), 0.02),
        'w_in': nrm(ks[5], (L, D_MODEL, IN_WIDTH), D_MODEL ** -0.5),
        'pe_cmp_k': nrm(ks[6], (L, CMP_LEN, NSA_HEAD_DIM), 0.1),
        'pe_cmp_v': nrm(ks[7], (L, CMP_LEN, NSA_HEAD_DIM), 0.1),
        'w_cmp_k': nrm(ks[8], (L, CMP_LEN * NSA_HEAD_DIM, NSA_HEAD_DIM), (CMP_LEN * NSA_HEAD_DIM) ** -0.5),
        'w_cmp_v': nrm(ks[9], (L, CMP_LEN * NSA_HEAD_DIM, NSA_HEAD_DIM), (CMP_LEN * NSA_HEAD_DIM) ** -0.5),
        'q_gain': 1.0 + nrm(ks[10], (L, NSA_HEAD_DIM), 0.02),
        'k_gain': 1.0 + nrm(ks[11], (L, 3, NSA_HEAD_DIM), 0.02),
        'conv_w': nrm(ks[12], (L, CONV_W, LRU_WIDTH), CONV_W ** -0.5),
        'conv_b': nrm(ks[13], (L, LRU_WIDTH), 0.02),
        'w_rg': nrm(ks[14], (L, LRU_BLOCKS, LRU_BLOCK_W, LRU_BLOCK_W), LRU_BLOCK_W ** -0.5),
        'b_rg': nrm(ks[15], (L, LRU_BLOCKS, LRU_BLOCK_W), 0.02),
        'w_ig': nrm(ks[16], (L, LRU_BLOCKS, LRU_BLOCK_W, LRU_BLOCK_W), LRU_BLOCK_W ** -0.5),
        'b_ig': nrm(ks[17], (L, LRU_BLOCKS, LRU_BLOCK_W), 0.02),
        'lru_lambda': jnp.log(a0) - jnp.log1p(-a0),
        'g_out_nsa': 1.0 + nrm(ks[19], (L, NSA_WIDTH), 0.02),
        'g_out_lru': 1.0 + nrm(ks[20], (L, LRU_WIDTH), 0.02),
        'w_out': nrm(ks[21], (L, D_MODEL, D_MODEL), D_MODEL ** -0.5),
        'g_norm2': 1.0 + nrm(ks[22], (L, D_MODEL), 0.02),
        'w_router': nrm(ks[23], (L, D_MODEL, N_EXPERTS), D_MODEL ** -0.5),
        'b_router': nrm(ks[24], (L, N_EXPERTS), 0.01),
        'w_e1': nrm(ks[25], (L, N_EXPERTS, D_MODEL, 2 * D_FF_EXPERT), D_MODEL ** -0.5),
        'b_e1': nrm(ks[26], (L, N_EXPERTS, 2 * D_FF_EXPERT), 0.02),
        'w_e2': nrm(ks[27], (L, N_EXPERTS, D_FF_EXPERT, D_MODEL), D_FF_EXPERT ** -0.5),
        'b_e2': nrm(ks[28], (L, N_EXPERTS, D_MODEL), 0.02),
    }


def reference(x, c, w_ada, b_ada, g_norm1, w_in, pe_cmp_k, pe_cmp_v, w_cmp_k, w_cmp_v, q_gain, k_gain,
              conv_w, conv_b, w_rg, b_rg, w_ig, b_ig, lru_lambda, g_out_nsa, g_out_lru, w_out,
              g_norm2, w_router, b_router, w_e1, b_e1, w_e2, b_e2):
    for l in range(DEPTH):
        mod = jax.nn.silu(c) @ w_ada[l] + b_ada[l]
        x = hybrid_layer(x, mod, g_norm1[l], w_in[l], pe_cmp_k[l], pe_cmp_v[l], w_cmp_k[l], w_cmp_v[l],
                         q_gain[l], k_gain[l], conv_w[l], conv_b[l], w_rg[l], b_rg[l], w_ig[l], b_ig[l],
                         lru_lambda[l], g_out_nsa[l], g_out_lru[l], w_out[l], g_norm2[l],
                         w_router[l], b_router[l], w_e1[l], b_e1[l], w_e2[l], b_e2[l])
    return x
```

```cpp
#include <hip/hip_runtime.h>
#include <stdint.h>
#include <math.h>

constexpr int DM = 2048, NB = 8, SEQ = 2048, NTOK = NB * SEQ;
constexpr int INW = 4656;
constexpr int NE = 32, TOPK = 4, NSLOT = NTOK * TOPK;
constexpr float EPS = 1e-6f;
#define LAS __attribute__((address_space(3)))
#define GAS __attribute__((address_space(1)))
typedef unsigned short bf16_t;
typedef short bf16x8 __attribute__((ext_vector_type(8)));
typedef short s16x4 __attribute__((ext_vector_type(4)));
typedef float f32x4 __attribute__((ext_vector_type(4)));
typedef float f32x16 __attribute__((ext_vector_type(16)));
typedef float f32x2 __attribute__((ext_vector_type(2)));
typedef unsigned u32x4 __attribute__((ext_vector_type(4)));
typedef unsigned u32x2 __attribute__((ext_vector_type(2)));
typedef GAS unsigned gu32;

constexpr int ZW = 4864;
constexpr int ZC_Q = 0, ZC_KC = 1024, ZC_VC = 1280, ZC_KS = 1536, ZC_VS = 1792, ZC_KW = 2048, ZC_VW = 2304, ZC_XR = 2560, ZC_XG = 3584, ZC_GL = 4608;
constexpr int PMAXT = 288, PMAXROWS = PMAXT * 256;

constexpr size_t MiB = 1u << 20;
constexpr size_t WS_CTL = 0, CTL_ZERO_BYTES = 1 * MiB;
constexpr int CW_TMO = 0, CW_CNT = 1024, CW_BAR = 4096;
constexpr size_t CTL_MOD_B = 256 * 1024;
constexpr size_t CTL_ROWSS_B = 640 * 1024;
constexpr size_t WS_WIN = 2 * MiB, WS_WOUT = 22 * MiB, WS_SMALL = 30 * MiB, WS_W1 = 32 * MiB, WS_W2 = 544 * MiB;
constexpr size_t SM_WR = 0, SM_WCK = 128 * 1024, SM_WCV = 384 * 1024, SM_WRG = 640 * 1024, SM_WIG = 768 * 1024, SM_BIASK = 896 * 1024, SM_BIASV = 897 * 1024;
constexpr size_t WS_X1B = 864 * MiB;
constexpr size_t WS_MODPART = 1700 * MiB, WS_MOD = 1707 * MiB, WS_SSN = 1708 * MiB, WS_SSL = 1709 * MiB, WS_PEPART = 1710 * MiB;
constexpr size_t WS_H8 = 288 * MiB;
constexpr size_t WS_H = 800 * MiB, WS_Z = 864 * MiB, WS_KIMG = 1016 * MiB, WS_LRUS = 1050 * MiB, WS_A2 = 1052 * MiB, WS_ROUTE = 1116 * MiB, WS_ACT = 1122 * MiB, WS_Y = 1410 * MiB, WS_FAST_END = 1710 * MiB;
constexpr size_t KI_KS = 0, KI_KW = 8 * MiB, KI_VS = 16 * MiB, KI_VW = 24 * MiB, KI_KC = 32 * MiB, KI_VC = 32 * MiB + 512 * 1024;
constexpr size_t RT_ROWTOK = 0, RT_ROWG = 2 * MiB, RT_TOKSLOT = 4 * MiB;

constexpr int RING_BYTES = 131072, LDSCTL_OFF = RING_BYTES, MISC_OFF = LDSCTL_OFF + 320, TILETAB_OFF = LDSCTL_OFF + 1024, LDS_BYTES = 163840;
constexpr int NWAVES = 8;

#define RLX_AGENT __ATOMIC_RELAXED, __HIP_MEMORY_SCOPE_AGENT
#define LDS_WAIT() asm volatile("s_waitcnt lgkmcnt(0)" ::: "memory")
#define VM_WAIT() asm volatile("s_waitcnt vmcnt(0)" ::: "memory")
__device__ __forceinline__ unsigned f2bf(float f) { unsigned u = __builtin_bit_cast(unsigned, f); return (u + 0x7fffu + ((u >> 16) & 1u)) >> 16; }
__device__ __forceinline__ unsigned pk2(float lo, float hi) { return f2bf(lo) | (f2bf(hi) << 16); }
__device__ __forceinline__ float bf2f(unsigned short b) { return __builtin_bit_cast(float, (unsigned)b << 16); }
__device__ __forceinline__ float bflo(unsigned w) { return __builtin_bit_cast(float, w << 16); }
__device__ __forceinline__ float bfhi(unsigned w) { return __builtin_bit_cast(float, w & 0xffff0000u); }
__device__ __forceinline__ unsigned cvt_pk_bf16(float lo, float hi) { unsigned r; asm volatile("v_cvt_pk_bf16_f32 %0, %1, %2" : "=v"(r) : "v"(lo), "v"(hi)); return r; }

__device__ __forceinline__ unsigned pk4_fp8(float a, float b, float c, float d) {
    unsigned w = 0u; w = __builtin_amdgcn_cvt_pk_fp8_f32(a, b, w, false); w = __builtin_amdgcn_cvt_pk_fp8_f32(c, d, w, true); return w; }

#define XB_TMO      128
#define XB_XCNT(j)  (256  + 64 * (j))
#define XB_XSUB(j)  (1280 + 64 * (j))
#define XB_XGEN(j)  (2304 + 64 * (j))
#define XB_TOP      3328
#define XB_TOPGEN   3392
#define XCD_BAR_WORDS 3456
#define XB_SPIN_CAP (1u << 18)
__device__ __forceinline__ unsigned xb_ld(unsigned* p)              { return __hip_atomic_load(p, __ATOMIC_RELAXED, __HIP_MEMORY_SCOPE_AGENT); }
__device__ __forceinline__ unsigned xb_add(unsigned* p, unsigned v) { return __hip_atomic_fetch_add(p, v, __ATOMIC_RELAXED, __HIP_MEMORY_SCOPE_AGENT); }
__device__ __forceinline__ unsigned xb_xcc_id() { return (unsigned)__builtin_amdgcn_s_getreg((3 << 11) | 20) & 0xFu; }
#define XB_SPIN(cond, bar) do { unsigned _sp = 0; while (cond) { __builtin_amdgcn_s_sleep(1); \
    if ((++_sp & 255u) == 0u) { if (xb_ld(&(bar)[XB_TMO])) break; if (_sp > XB_SPIN_CAP) { atomicAdd(&(bar)[XB_TMO], 1u); break; } } } } while (0)
struct XcdBarrier { unsigned* bar; unsigned x; volatile LAS unsigned* st; unsigned total; };
__device__ __forceinline__ XcdBarrier xcd_barrier_post(unsigned* bar, volatile LAS unsigned* st, unsigned total, bool member) {
    XcdBarrier b; b.bar = bar; b.x = xb_xcc_id(); b.st = st; b.total = total;
    if (member && threadIdx.x == 0) (void)xb_add(&bar[XB_XCNT(b.x)], 1u);
    return b;
}
__device__ __forceinline__ void xcd_barrier_complete(unsigned* bar, unsigned x, unsigned G, unsigned& nloc, unsigned& nx) {
    unsigned sum, cnt, mine, sp = 0u;
    for (;;) {
        sum = 0u; cnt = 0u; mine = 0u;
#pragma unroll
        for (unsigned j = 0; j < 16; ++j) { const unsigned c = xb_ld(&bar[XB_XCNT(j)]); sum += c; cnt += (c > 0u) ? 1u : 0u; mine = (j == x) ? c : mine; }
        if (sum == G) break;
        __builtin_amdgcn_s_sleep(1);
        if ((++sp & 255u) == 0u) { if (xb_ld(&bar[XB_TMO])) break; if (sp > XB_SPIN_CAP) { atomicAdd(&bar[XB_TMO], 1u); break; } }
    }
    nloc = mine > 0u ? mine : 1u; nx = cnt > 0u ? cnt : 1u;
}
__device__ __forceinline__ void xcd_barrier(const XcdBarrier& b) {
    asm volatile("s_waitcnt vmcnt(0)" ::: "memory");
    __syncthreads();
    if (threadIdx.x == 0) {
        unsigned* bar = b.bar;
        __builtin_amdgcn_s_waitcnt(0);
        unsigned nloc = b.st[0], nx = b.st[1];
        if (nloc == 0u) { xcd_barrier_complete(bar, b.x, b.total, nloc, nx); b.st[0] = nloc; b.st[1] = nx; }
        const unsigned old = xb_add(&bar[XB_XSUB(b.x)], 1u);
        const unsigned gen = old / nloc;
        if (old + 1u == (gen + 1u) * nloc) {
            __builtin_amdgcn_fence(__ATOMIC_RELEASE, "agent");
            asm volatile("s_waitcnt vmcnt(0)" ::: "memory");
            const unsigned og = xb_add(&bar[XB_TOP], 1u);
            const unsigned tg = og / nx;
            if (og + 1u == (tg + 1u) * nx) xb_add(&bar[XB_TOPGEN], 1u);
            else XB_SPIN(xb_ld(&bar[XB_TOPGEN]) == tg, bar);
            __builtin_amdgcn_fence(__ATOMIC_ACQUIRE, "agent");
            xb_add(&bar[XB_XGEN(b.x)], 1u);
            asm volatile("s_waitcnt vmcnt(0)" ::: "memory");
        } else {
            XB_SPIN(xb_ld(&bar[XB_XGEN(b.x)]) == gen, bar);
            __builtin_amdgcn_fence(__ATOMIC_ACQUIRE, "agent");
            asm volatile("s_waitcnt vmcnt(0)" ::: "memory");
        }
    }
    __syncthreads();
}

namespace g8 {
constexpr int BM = 256, BK = 64, HALF = 128, HTB = HALF * BK * 2, STAGE_BYTES = 8 * HTB;
__host__ __device__ __forceinline__ int lds_byte(int r, int c) { const int st = (r >> 4) * 2 + (c >> 5), rr = r & 15, cc = c & 31, ob = rr * 64 + cc * 2; return st * 1024 + (ob ^ (((ob >> 9) & 1) << 5)); }
__host__ __device__ __forceinline__ void stage_rc(int b, int& R, int& C) { const int st = b / 1024, sb = b % 1024, swz = sb ^ (((sb >> 9) & 1) << 5); R = (st >> 1) * 16 + swz / 64; C = (st & 1) * 32 + (swz % 64) / 2; }
__host__ __device__ __forceinline__ int perm32(int rho) { const int n = rho >> 4, i = rho & 15; return 8 * (i >> 2) + 4 * n + (i & 3); }
struct Unit { int pm, pn, e, row0, p0; };
typedef f32x4 Acc[2][2][4][2];

template <class P>
__device__ __forceinline__ void gemm_phase(LAS unsigned char* lds, const P& S) {
    const int tid = threadIdx.x, wid = __builtin_amdgcn_readfirstlane(tid >> 6), lane = tid & 63, wr = wid >> 2, wc = wid & 3, fr = lane & 15, fq = lane >> 4;
    constexpr int K = P::K, nt = K / BK;
    int R0, C0, R1, C1; stage_rc(tid * 16, R0, C0); stage_rc(tid * 16 + 8192, R1, C1);
    const int Rb0 = P::PERM ? ((R0 & ~31) + perm32(R0 & 31)) : R0, Rb1 = P::PERM ? ((R1 & ~31) + perm32(R1 & 31)) : R1;
    const unsigned voffB0 = (unsigned)(Rb0 * K + C0) * 2u, voffB1 = (unsigned)(Rb1 * K + C1) * 2u;
    constexpr size_t kstep = (size_t)(BK * 2);
    constexpr unsigned hstep = (unsigned)HALF * K * 2u;
    const unsigned ldsw = (unsigned)wid * 1024u;
    const int aoff = lds_byte(wr * 64 + fr, fq * 8), boff = lds_byte(wc * 32 + fr, fq * 8);
#define G8_SA(b, h) (((b) * 2 + (h)) * HTB)
#define G8_SB(b, h) ((4 + (b) * 2 + (h)) * HTB)
#define G8_STAGE(bufoff, gbase, o0, o1) do { \
        __builtin_amdgcn_global_load_lds((const unsigned*)((const char*)(gbase) + (o0)), (LAS unsigned*)(lds + (bufoff) + ldsw), 16, 0, 0); \
        __builtin_amdgcn_global_load_lds((const unsigned*)((const char*)(gbase) + (o1)), (LAS unsigned*)(lds + (bufoff) + ldsw + 8192), 16, 0, 0); } while (0)
#define G8_STAGEB(bufoff, gbase, h) G8_STAGE(bufoff, gbase, voffB0 + (h) * hstep, voffB1 + (h) * hstep)
#define G8_LDA(dst, b, h) do { _Pragma("unroll") for (int m = 0; m < 4; ++m) _Pragma("unroll") for (int k = 0; k < 2; ++k) dst[m][k] = *(const LAS bf16x8*)(lds + G8_SA(b, h) + aoff + m * 2048 + k * 1024); } while (0)
#define G8_LDB(dst, b, h) do { _Pragma("unroll") for (int n = 0; n < 2; ++n) _Pragma("unroll") for (int k = 0; k < 2; ++k) dst[n][k] = *(const LAS bf16x8*)(lds + G8_SB(b, h) + boff + n * 2048 + k * 1024); } while (0)
#define G8_MMA(ai, bj, At, Bt) do { __builtin_amdgcn_s_setprio(1); _Pragma("unroll") for (int m = 0; m < 4; ++m) _Pragma("unroll") for (int n = 0; n < 2; ++n) _Pragma("unroll") for (int k = 0; k < 2; ++k) \
        acc[ai][bj][m][n] = __builtin_amdgcn_mfma_f32_16x16x32_bf16(Bt[n][k], At[m][k], acc[ai][bj][m][n], 0, 0, 0); __builtin_amdgcn_s_setprio(0); } while (0)
#define G8_WAIT_V(n) asm volatile("s_waitcnt vmcnt(" #n ")" ::: "memory")
#define G8_WAIT_L(n) asm volatile("s_waitcnt lgkmcnt(" #n ")" ::: "memory")
#define G8_BAR __builtin_amdgcn_s_barrier()
#define G8_SCHED __builtin_amdgcn_sched_barrier(0)
    Unit cur, nxt; int ui = 0;
    if (!S.next(0, cur)) return;
    Acc acc;
#pragma unroll
    for (int a = 0; a < 2; ++a)
#pragma unroll
        for (int b = 0; b < 2; ++b)
#pragma unroll
            for (int m = 0; m < 4; ++m)
#pragma unroll
                for (int n = 0; n < 2; ++n) acc[a][b][m][n] = (f32x4){0.f, 0.f, 0.f, 0.f};
    bf16x8 At[4][2], B0[2][2], B1[2][2];
    unsigned c00, c01, c10, c11, n00, n01, n10, n11;
    S.a_voff(cur, R0, C0, R1, C1, c00, c01, c10, c11);
    n00 = c00; n01 = c01; n10 = c10; n11 = c11;
    const char* cA = S.a_base(cur); const char* cB = S.b_base(cur);
    G8_STAGEB(G8_SB(0, 0), cB, 0); G8_STAGEB(G8_SB(0, 1), cB, 1); G8_STAGE(G8_SA(0, 0), cA, c00, c01); G8_STAGE(G8_SA(0, 1), cA, c10, c11);
    if (wr == 1) G8_BAR;
    G8_WAIT_V(2); G8_BAR;
    G8_STAGEB(G8_SB(1, 0), cB + kstep, 0); G8_STAGE(G8_SA(1, 0), cA + kstep, c00, c01); G8_STAGEB(G8_SB(1, 1), cB + kstep, 1);
    G8_WAIT_V(6); G8_BAR;
    for (;;) {
        const bool has_next = S.next(ui + 1, nxt);
        const char* nA = has_next ? S.a_base(nxt) : cA; const char* nB = has_next ? S.b_base(nxt) : cB;
        if (P::GATHER) { if (has_next) S.a_voff(nxt, R0, C0, R1, C1, n00, n01, n10, n11); else { n00 = c00; n01 = c01; n10 = c10; n11 = c11; } }
        for (int t = 0; t < nt; t += 2) {
            const bool last = (t == nt - 2);
            if (P::MIDK) { if (t == nt / 2) S.midk(acc, cur, wr, fr); }
            const char* a1 = cA + (size_t)(t + 1) * kstep;
            const char* a2 = last ? nA : cA + (size_t)(t + 2) * kstep; const char* b2 = last ? nB : cB + (size_t)(t + 2) * kstep;
            const char* a3 = a2 + kstep; const char* b3 = b2 + kstep;
            const unsigned x00 = (P::GATHER && last) ? n00 : c00, x01 = (P::GATHER && last) ? n01 : c01, x10 = (P::GATHER && last) ? n10 : c10, x11 = (P::GATHER && last) ? n11 : c11;
            G8_LDB(B0, 0, 0); G8_LDB(B1, 0, 1); G8_SCHED; G8_LDA(At, 0, 0); G8_STAGE(G8_SA(1, 1), a1, c10, c11);
            G8_WAIT_V(8); G8_WAIT_L(0); G8_BAR; G8_MMA(0, 0, At, B0); G8_MMA(0, 1, At, B1); G8_BAR; G8_SCHED;
            G8_LDA(At, 0, 1); G8_STAGEB(G8_SB(0, 0), b2, 0); G8_STAGEB(G8_SB(0, 1), b2, 1); G8_STAGE(G8_SA(0, 0), a2, x00, x01);
            G8_WAIT_V(8); G8_WAIT_L(0); G8_BAR; G8_MMA(1, 0, At, B0); G8_MMA(1, 1, At, B1); G8_BAR; G8_SCHED;
            G8_LDB(B0, 1, 0); G8_LDB(B1, 1, 1); G8_SCHED; G8_LDA(At, 1, 0); G8_STAGE(G8_SA(0, 1), a2, x10, x11);
            G8_WAIT_V(8); G8_WAIT_L(0); G8_BAR; G8_MMA(0, 0, At, B0); G8_MMA(0, 1, At, B1); G8_BAR; G8_SCHED;
            G8_LDA(At, 1, 1); G8_STAGEB(G8_SB(1, 0), b3, 0); G8_STAGEB(G8_SB(1, 1), b3, 1); G8_STAGE(G8_SA(1, 0), a3, x00, x01);
            G8_WAIT_V(8); G8_WAIT_L(0); G8_BAR; G8_MMA(1, 0, At, B0); G8_MMA(1, 1, At, B1); G8_BAR; G8_SCHED;
        }
        if (wr == 0) G8_BAR;
        S.epi(acc, cur, wr, wc, fr, fq);
        if (!has_next) break;
#pragma unroll
        for (int a = 0; a < 2; ++a)
#pragma unroll
            for (int b = 0; b < 2; ++b)
#pragma unroll
                for (int m = 0; m < 4; ++m)
#pragma unroll
                    for (int n = 0; n < 2; ++n) acc[a][b][m][n] = (f32x4){0.f, 0.f, 0.f, 0.f};
        cur = nxt; cA = nA; cB = nB; ++ui;
        if (P::GATHER) { c00 = n00; c01 = n01; c10 = n10; c11 = n11; }
        if (wr == 1) G8_BAR;
    }
    G8_WAIT_V(0);
    G8_BAR;
#undef G8_SA
#undef G8_SB
#undef G8_STAGE
#undef G8_STAGEB
#undef G8_LDA
#undef G8_LDB
#undef G8_MMA
#undef G8_WAIT_V
#undef G8_WAIT_L
#undef G8_BAR
#undef G8_SCHED
}

struct DenseOrder {
    int nM, nN, nwg, G, c;
    __device__ __forceinline__ void init(int M, int N, int G_, int c_) { nM = M / BM; nN = N / BM; nwg = nM * nN; G = G_; c = c_; }
    __device__ __forceinline__ bool next(int i, Unit& u) const {
        const long L = (long)i * G + c; if (L >= nwg) return false;
        int wgid = (int)L; { const int q = nwg / 8, r = nwg % 8, xcd = wgid % 8, off = wgid / 8; wgid = (xcd < r ? xcd * (q + 1) : r * (q + 1) + (xcd - r) * q) + off; }
        const int nig = 8 * nN, gid = wgid / nig, fm = gid * 8, gsz = (nM - fm) < 8 ? (nM - fm) : 8;
        u.pm = fm + ((wgid % nig) % gsz); u.pn = (wgid % nig) / gsz; u.e = 0; u.row0 = u.pm * BM; u.p0 = 0; return true;
    }
};
}

struct Args { const float* in[29]; float* out; unsigned char* ws; int ph_lo, ph_hi, li, pad; };
struct Frame {
    LAS unsigned char* lds;
    gu32* ctl;
    int tid, lane, wave, vcu, G, bx;
    unsigned char* ws;
};
__device__ __forceinline__ float wsum(float v) {
#pragma unroll
    for (int o = 1; o < 64; o <<= 1) v += __shfl_xor(v, o);
    return v;
}

__device__ __forceinline__ void conv_item(const float* W, int ldw, int n_src0, int nvalid, int k0, bf16_t* WT, int dst_row0, int Kd, LAS float* scr, int lane) {
    const int ln = lane & 31;
#pragma unroll
    for (int i = 0; i < 32; ++i) { const int kk = 2 * i + (lane >> 5); scr[kk * 33 + ln] = (ln < nvalid) ? W[(size_t)(k0 + kk) * ldw + n_src0 + ln] : 0.f; }
    LDS_WAIT(); asm volatile("" ::: "memory");
    const int c = lane & 7;
#pragma unroll
    for (int j = 0; j < 4; ++j) { const int n = (lane >> 3) + 8 * j; const LAS float* s = scr + (8 * c) * 33 + n;
        u32x4 o; o.x = pk2(s[0 * 33], s[1 * 33]); o.y = pk2(s[2 * 33], s[3 * 33]); o.z = pk2(s[4 * 33], s[5 * 33]); o.w = pk2(s[6 * 33], s[7 * 33]);
        *(GAS u32x4*)(WT + (size_t)(dst_row0 + n) * Kd + k0 + 8 * c) = o; }
    LDS_WAIT(); asm volatile("" ::: "memory");
}
__device__ __forceinline__ void mod_item(const float* c, const float* w, float* modp, int item, int lane, LAS float* scr) {
    const int cb = item % 48, ks = item / 48, j0 = cb * 256 + lane * 4, k0 = ks * 128;
#pragma unroll
    for (int i = 0; i < 16; ++i) { const int idx = i * 64 + lane, kk = idx >> 3, b = idx & 7; const float cv = c[b * DM + k0 + kk]; scr[idx] = cv / (1.f + __expf(-cv)); }
    LDS_WAIT(); asm volatile("" ::: "memory");
    f32x4 acc[NB];
#pragma unroll
    for (int b = 0; b < NB; ++b) acc[b] = (f32x4){0.f, 0.f, 0.f, 0.f};
#pragma unroll 1
    for (int kb = 0; kb < 128; kb += 8) {
        f32x4 wv[8];
#pragma unroll
        for (int k = 0; k < 8; ++k) wv[k] = *(const GAS f32x4*)(w + (size_t)(k0 + kb + k) * (6 * DM) + j0);
        asm volatile("" : "+v"(wv[0]), "+v"(wv[1]), "+v"(wv[2]), "+v"(wv[3]), "+v"(wv[4]), "+v"(wv[5]), "+v"(wv[6]), "+v"(wv[7]) :: "memory");
#pragma unroll
        for (int k = 0; k < 8; ++k) {
            const f32x4 s0 = *(const LAS f32x4*)(scr + (kb + k) * 8), s1 = *(const LAS f32x4*)(scr + (kb + k) * 8 + 4);
            acc[0] += wv[k] * s0.x; acc[1] += wv[k] * s0.y; acc[2] += wv[k] * s0.z; acc[3] += wv[k] * s0.w; acc[4] += wv[k] * s1.x; acc[5] += wv[k] * s1.y; acc[6] += wv[k] * s1.z; acc[7] += wv[k] * s1.w;
        }
    }
#pragma unroll
    for (int b = 0; b < NB; ++b) *(GAS f32x4*)(modp + ((size_t)ks * NB + b) * 6 * DM + j0) = acc[b];
    LDS_WAIT(); asm volatile("" ::: "memory");
}
__device__ __forceinline__ float mod_reduce1(const float* modp, const float* bias, int idx) {
    const int b = idx / (6 * DM), j = idx % (6 * DM);
    float s = bias[j];
#pragma unroll
    for (int ks = 0; ks < 16; ++ks) s += modp[((size_t)ks * NB + b) * 6 * DM + j];
    return s;
}
__device__ __forceinline__ void pebias_part(const float* pe, const float* w, float* part, int kc, int lane) {
    const float* wp = w + (size_t)(kc * 64) * 64 + lane; const float* pp = pe + kc * 64;
    float a0 = 0.f, a1 = 0.f, a2 = 0.f, a3 = 0.f;
#pragma unroll
    for (int b = 0; b < 4; ++b) {
        float v[16];
#pragma unroll
        for (int j = 0; j < 16; ++j) v[j] = wp[(size_t)(b * 16 + j) * 64];
        asm volatile("" : "+v"(v[0]), "+v"(v[1]), "+v"(v[2]), "+v"(v[3]), "+v"(v[4]), "+v"(v[5]), "+v"(v[6]), "+v"(v[7]),
                          "+v"(v[8]), "+v"(v[9]), "+v"(v[10]), "+v"(v[11]), "+v"(v[12]), "+v"(v[13]), "+v"(v[14]), "+v"(v[15]));
#pragma unroll
        for (int j = 0; j < 16; j += 4) { a0 += pp[b * 16 + j] * v[j]; a1 += pp[b * 16 + j + 1] * v[j + 1]; a2 += pp[b * 16 + j + 2] * v[j + 2]; a3 += pp[b * 16 + j + 3] * v[j + 3]; }
    }
    part[kc * 64 + lane] = (a0 + a1) + (a2 + a3);
}
__device__ __forceinline__ void pebias_reduce(const float* part, float* outb, int lane) {
    float v[32];
#pragma unroll
    for (int j = 0; j < 32; ++j) v[j] = part[j * 64 + lane];
    float a = 0.f;
#pragma unroll
    for (int j = 0; j < 32; ++j) a += v[j];
    outb[lane] = a;
}

__device__ __forceinline__ void p0_prologue(Frame& F, const Args& A) {
    LAS float* scr = (LAS float*)(F.lds + F.wave * 16384);
    const int gw = F.wave * F.G + F.vcu, NGW = F.G * NWAVES;
    unsigned char* ws = F.ws;
    float* modp = (float*)(ws + WS_MODPART);
    constexpr int I_MOD = 768;
    constexpr int I_WIN = 32 * (ZW / 32);
    constexpr int I_WOUT = 32 * 64;
    constexpr int I_WR = 32, I_WCK = 64, I_WCV = 64, I_WRG = 32, I_WIG = 32, I_PE = 64;
    constexpr int NITEMS = I_MOD + I_WIN + I_WOUT + I_WR + I_WCK + I_WCV + I_WRG + I_WIG + I_PE;
    for (int it = gw; it < NITEMS; it += NGW) {
        int ln = F.lane; asm volatile("" : "+v"(ln));
        int r = it;
        if (r < I_MOD) { mod_item(A.in[1], A.in[2], modp, r, F.lane, scr); continue; } r -= I_MOD;
        if (r < I_WIN) {
            const int nb = r % (ZW / 32), kb = r / (ZW / 32), zc = nb * 32;
            int src, nv = 32;
            if (zc < 2560) src = zc; else if (zc < 4608) src = zc + 48; else { src = zc - 2048; nv = 4656 - zc; if (nv > 32) nv = 32; if (nv < 0) nv = 0; }
            if (nv == 0) src = 0;
            conv_item(A.in[5], INW, src, nv, kb * 64, (bf16_t*)(ws + WS_WIN), zc, DM, scr, ln); continue; } r -= I_WIN;
        if (r < I_WOUT) { const int nb = r % 64, kb = r / 64; conv_item(A.in[21], DM, nb * 32, 32, kb * 64, (bf16_t*)(ws + WS_WOUT), nb * 32, DM, scr, ln); continue; } r -= I_WOUT;
        if (r < I_WR) { conv_item(A.in[23], 32, 0, 32, r * 64, (bf16_t*)(ws + WS_SMALL + SM_WR), 0, DM, scr, ln); continue; } r -= I_WR;
        if (r < I_WCK) { const int nb = r % 2, kb = r / 2; conv_item(A.in[8], 64, nb * 32, 32, kb * 64, (bf16_t*)(ws + WS_SMALL + SM_WCK), nb * 32, DM, scr, ln); continue; } r -= I_WCK;
        if (r < I_WCV) { const int nb = r % 2, kb = r / 2; conv_item(A.in[9], 64, nb * 32, 32, kb * 64, (bf16_t*)(ws + WS_SMALL + SM_WCV), nb * 32, DM, scr, ln); continue; } r -= I_WCV;
        if (r < I_WRG) { const int nb = r % 2, blk = r / 2; conv_item(A.in[14] + (size_t)blk * 4096, 64, nb * 32, 32, 0, (bf16_t*)(ws + WS_SMALL + SM_WRG) + (size_t)blk * 4096, nb * 32, 64, scr, ln); continue; } r -= I_WRG;
        if (r < I_WIG) { const int nb = r % 2, blk = r / 2; conv_item(A.in[16] + (size_t)blk * 4096, 64, nb * 32, 32, 0, (bf16_t*)(ws + WS_SMALL + SM_WIG) + (size_t)blk * 4096, nb * 32, 64, scr, ln); continue; } r -= I_WIG;
        if (r < I_PE) { const int which = r >> 5; pebias_part(A.in[6 + which], A.in[8 + which], (float*)(ws + WS_PEPART) + which * 2048, r & 31, ln); continue; }
        (void)r;
    }
}

struct ProbZ {
    static constexpr int K = DM; static constexpr bool GATHER = false, PERM = true, MIDK = false;
    g8::DenseOrder ord; const bf16_t* A; const bf16_t* Bt; bf16_t* Z;
    __device__ __forceinline__ bool next(int i, g8::Unit& u) const { return ord.next(i, u); }
    __device__ __forceinline__ const char* a_base(const g8::Unit& u) const { return (const char*)A + (size_t)u.pm * 256 * K * 2; }
    __device__ __forceinline__ const char* b_base(const g8::Unit& u) const { return (const char*)Bt + (size_t)u.pn * 256 * K * 2; }
    __device__ __forceinline__ void a_voff(const g8::Unit&, int R0, int C0, int R1, int C1, unsigned& v00, unsigned& v01, unsigned& v10, unsigned& v11) const {
        v00 = (unsigned)(R0 * K + C0) * 2u; v01 = (unsigned)(R1 * K + C1) * 2u; v10 = v00 + 128u * K * 2u; v11 = v01 + 128u * K * 2u; }
    __device__ __forceinline__ void midk(g8::Acc&, const g8::Unit&, int, int) const {}
    __device__ __forceinline__ void epi(const g8::Acc& acc, const g8::Unit& u, int wr, int wc, int fr, int fq) const {
        const int row0 = u.row0 + wr * 64 + fr, col0 = u.pn * 256 + wc * 32 + 8 * fq;
#pragma unroll
        for (int ai = 0; ai < 2; ++ai)
#pragma unroll
            for (int m = 0; m < 4; ++m) { bf16_t* rowp = Z + (size_t)(row0 + ai * 128 + m * 16) * ZW + col0;
#pragma unroll
                for (int bj = 0; bj < 2; ++bj) { const f32x4 v0 = acc[ai][bj][m][0], v1 = acc[ai][bj][m][1];
                    u32x4 w; w.x = cvt_pk_bf16(v0[0], v0[1]); w.y = cvt_pk_bf16(v0[2], v0[3]); w.z = cvt_pk_bf16(v1[0], v1[1]); w.w = cvt_pk_bf16(v1[2], v1[3]);
                    *(u32x4*)(rowp + bj * 128) = w; } }
    }
};
__device__ __forceinline__ void build_tile_table(Frame& F) {
    LAS int* tab = (LAS int*)(F.lds + TILETAB_OFF);
    if (F.wave == 0) {
        const int lane = F.lane;
        const int* cnt = (const int*)(F.ctl + CW_CNT);
        const int c = (lane < NE) ? cnt[lane] : 0;
        const int t = (c + 255) >> 8;
        int ps = t;
#pragma unroll
        for (int o = 1; o < 32; o <<= 1) { const int v = __shfl_up(ps, o); if (lane >= o) ps += v; }
        const int t0 = ps - t;
        if (lane < NE) { tab[8 + lane] = c; tab[40 + lane] = t0 * 256;
            for (int j = 0; j < t; ++j) { tab[128 + t0 + j] = lane; tab[416 + t0 + j] = j * 256; } }
        if (lane == NE - 1) tab[0] = ps;
    }
    __syncthreads();
}
struct MoeOrder {
    const LAS int* tab; int G, c, NPN;
    __device__ __forceinline__ bool next(int i, g8::Unit& u) const {
        const int nt = tab[0], nunits = nt * NPN; const long L = (long)i * G + c; if (L >= nunits) return false;
        int w = (int)L; { const int q = nunits / 8, r = nunits % 8, xcd = w % 8, off = w / 8; w = (xcd < r ? xcd * (q + 1) : r * (q + 1) + (xcd - r) * q) + off; }
        const int gs = 4 * NPN, grp = w / gs, fm = grp * 4, gsz = (nt - fm) < 4 ? (nt - fm) : 4, rem = w % gs;
        u.pm = fm + rem % gsz; u.pn = rem / gsz; u.e = tab[128 + u.pm]; u.p0 = tab[416 + u.pm]; u.row0 = tab[40 + u.e] + u.p0; return true;
    }
};
__device__ __forceinline__ float fast_sigmoid(float x) { return __builtin_amdgcn_rcpf(1.f + __builtin_amdgcn_exp2f(-1.4426950408889634f * x)); }


__device__ __forceinline__ void p6_row(const u32x2 (&vb)[8], const f32x4 (&Ag)[8], const f32x4 (&Sh)[8], bf16_t* orow, unsigned char* orow8, int lane) {
    f32x4 v[8];
#pragma unroll
    for (int j = 0; j < 8; ++j) v[j] = (f32x4){bflo(vb[j].x), bfhi(vb[j].x), bflo(vb[j].y), bfhi(vb[j].y)};
    float s = 0.f;
#pragma unroll
    for (int j = 0; j < 8; ++j) s += (v[j].x * v[j].x + v[j].y * v[j].y) + (v[j].z * v[j].z + v[j].w * v[j].w);
    const float rstd = rsqrtf(wsum(s) * (1.f / DM) + EPS);
    GAS unsigned long long* o8 = (GAS unsigned long long*)orow + lane; GAS unsigned* o4 = (GAS unsigned*)orow8 + lane;
#pragma unroll
    for (int j = 0; j < 8; ++j) { const f32x4 hv = v[j] * rstd * Ag[j] + Sh[j];
        o8[64 * j] = (unsigned long long)pk2(hv.x, hv.y) | ((unsigned long long)pk2(hv.z, hv.w) << 32);
        o4[64 * j] = pk4_fp8(hv.x, hv.y, hv.z, hv.w); }
}
__device__ __forceinline__ void p6_route(Frame& F, const Args& A, const float* mod) {
    unsigned char* ws = F.ws;
    bf16_t* H2 = (bf16_t*)(ws + WS_H); const bf16_t* WrT = (const bf16_t*)(ws + WS_SMALL + SM_WR);
    int* cnt = (int*)(F.ctl + CW_CNT); int* rowtok = (int*)(ws + WS_ROUTE + RT_ROWTOK); float* rowg = (float*)(ws + WS_ROUTE + RT_ROWG); int* tokslot = (int*)(ws + WS_ROUTE + RT_TOKSLOT);
    const float* br = A.in[24];
    const int lane = F.lane, ar = lane & 15, kq = lane >> 4, tid = F.tid;
    LAS unsigned char* wl = F.lds;
    LAS int* ch_e = (LAS int*)(F.lds + TILETAB_OFF);
    LAS float* ch_g = (LAS float*)(ch_e + 256);
    LAS int* wcnt = (LAS int*)(ch_g + 256);
    LAS int* wbase = wcnt + 128;
    {
#pragma unroll
        for (int i = 0; i < 16; ++i) { const int q = F.wave * 16 + i, n = q >> 2, p = (q & 3) * 64 + lane;
            __builtin_amdgcn_global_load_lds((const unsigned*)((const char*)WrT + (size_t)n * 4096 + ((p ^ (n & 15)) << 4)), (LAS unsigned*)(wl + q * 1024), 16, 0, 0); }
    }
    for (int chunk = F.bx; chunk < NTOK / 64; chunk += F.G) {
        const int row0 = chunk * 64 + F.wave * 8, b = row0 / SEQ; const float* mb = mod + (size_t)b * 6 * DM;
        f32x4 Ag[8], Sh[8];
#pragma unroll
        for (int j = 0; j < 8; ++j) { const f32x4 gg = *((const GAS f32x4*)A.in[22] + lane + 64 * j), sc = *((const GAS f32x4*)(mb + 4 * DM) + lane + 64 * j);
            Ag[j] = gg * (sc + 1.f); Sh[j] = *((const GAS f32x4*)(mb + 3 * DM) + lane + 64 * j); }
        u32x2 xa[8], xb[8];
        const bf16_t* X1B = (const bf16_t*)(ws + WS_X1B);
#pragma unroll
        for (int j = 0; j < 8; ++j) xa[j] = *((const GAS u32x2*)(X1B + (size_t)row0 * DM) + lane + 64 * j);
#pragma unroll 1
        for (int r = 0; r < 8; r += 2) {
#pragma unroll
            for (int j = 0; j < 8; ++j) xb[j] = *((const GAS u32x2*)(X1B + (size_t)(row0 + r + 1) * DM) + lane + 64 * j);
            p6_row(xa, Ag, Sh, H2 + (size_t)(row0 + r) * DM, ws + WS_H8 + (size_t)(row0 + r) * DM, lane);
            if (r + 2 < 8) {
#pragma unroll
                for (int j = 0; j < 8; ++j) xa[j] = *((const GAS u32x2*)(X1B + (size_t)(row0 + r + 2) * DM) + lane + 64 * j); }
            p6_row(xb, Ag, Sh, H2 + (size_t)(row0 + r + 1) * DM, ws + WS_H8 + (size_t)(row0 + r + 1) * DM, lane);
        }
        VM_WAIT();
        __syncthreads();
        f32x4 acc0 = (f32x4){0.f, 0.f, 0.f, 0.f}, acc1 = acc0;
        const bf16_t* ap = H2 + (size_t)(row0 + (ar & 7)) * DM + kq * 8;
        const LAS unsigned char* w0 = wl + ar * 4096, *w1 = wl + (16 + ar) * 4096;
#pragma unroll 16
        for (int s = 0; s < 64; ++s) {
            const bf16x8 a = *(const GAS bf16x8*)(ap + 32 * s);
            const bf16x8 b0 = *(const LAS bf16x8*)(w0 + (((4 * s + kq) ^ ar) << 4)), b1 = *(const LAS bf16x8*)(w1 + (((4 * s + kq) ^ ar) << 4));
            acc0 = __builtin_amdgcn_mfma_f32_16x16x32_bf16(b0, a, acc0, 0, 0, 0);
            acc1 = __builtin_amdgcn_mfma_f32_16x16x32_bf16(b1, a, acc1, 0, 0, 0);
        }
        {
            const f32x4 bb0 = *(const GAS f32x4*)(br + 4 * kq), bb1 = *(const GAS f32x4*)(br + 16 + 4 * kq);
            float v[8] = {acc0[0] + bb0.x, acc0[1] + bb0.y, acc0[2] + bb0.z, acc0[3] + bb0.w, acc1[0] + bb1.x, acc1[1] + bb1.y, acc1[2] + bb1.z, acc1[3] + bb1.w};
            float tv[4]; int te[4];
#pragma unroll
            for (int k = 0; k < 4; ++k) {
                float bv = v[0]; int bi = 4 * kq;
#pragma unroll
                for (int q = 1; q < 8; ++q) { const int eq = (q < 4) ? 4 * kq + q : 16 + 4 * kq + (q - 4); if (v[q] > bv) { bv = v[q]; bi = eq; } }
#pragma unroll
                for (int o = 16; o < 64; o <<= 1) { const float ov = __shfl_xor(bv, o); const int oi = __shfl_xor(bi, o); if (ov > bv || (ov == bv && oi < bi)) { bv = ov; bi = oi; } }
                tv[k] = bv; te[k] = bi;
#pragma unroll
                for (int q = 0; q < 8; ++q) { const int eq = (q < 4) ? 4 * kq + q : 16 + 4 * kq + (q - 4); if (eq == bi) v[q] = -INFINITY; }
            }
            const float e1 = __expf(tv[1] - tv[0]), e2 = __expf(tv[2] - tv[0]), e3 = __expf(tv[3] - tv[0]); const float inv = 1.f / (1.f + e1 + e2 + e3);
            if (kq == 0 && ar < 8) { const int li = (F.wave * 8 + ar) * 4;
                ch_e[li] = te[0]; ch_e[li + 1] = te[1]; ch_e[li + 2] = te[2]; ch_e[li + 3] = te[3];
                ch_g[li] = inv; ch_g[li + 1] = e1 * inv; ch_g[li + 2] = e2 * inv; ch_g[li + 3] = e3 * inv; }
        }
        __syncthreads();
        int my_e = 0, my_rank = 0;
        if (F.wave < 4) { my_e = ch_e[tid];
#pragma unroll 4
            for (int e = 0; e < NE; ++e) { const unsigned long long mk = __ballot(my_e == e);
                if (my_e == e) my_rank = __popcll(mk & ((1ull << lane) - 1ull));
                if (lane == 0) wcnt[F.wave * 32 + e] = __popcll(mk); } }
        __syncthreads();
        if (tid < 32) { const int c0 = wcnt[tid], c1 = wcnt[32 + tid], c2 = wcnt[64 + tid], c3 = wcnt[96 + tid], tot = c0 + c1 + c2 + c3;
            const int base = tot ? atomicAdd(&cnt[tid], tot) : 0;
            wbase[tid] = base; wbase[32 + tid] = base + c0; wbase[64 + tid] = base + c0 + c1; wbase[96 + tid] = base + c0 + c1 + c2; }
        __syncthreads();
        if (F.wave < 4) { const int pos = wbase[F.wave * 32 + my_e] + my_rank, row = chunk * 64 + (tid >> 2);
            rowtok[(size_t)my_e * NTOK + pos] = row; rowg[(size_t)my_e * NTOK + pos] = ch_g[tid]; tokslot[row * 4 + (tid & 3)] = my_e * NTOK + pos; }
        __syncthreads();
    }
    VM_WAIT();
    __syncthreads();
}
__device__ __forceinline__ void p9_combine(Frame& F, const Args& A, const float* mod) {
    unsigned char* ws = F.ws; const LAS int* tab = (const LAS int*)(F.lds + TILETAB_OFF);
    const unsigned char* Y8 = ws + WS_Y; const int* tokslot = (const int*)(ws + WS_ROUTE + RT_TOKSLOT);
    const int lane = F.lane; const int gw = F.vcu * NWAVES + F.wave, NGW = F.G * NWAVES;
    for (int tok = gw; tok < NTOK; tok += NGW) {
        const int b = tok / SEQ; const float* g2 = mod + (size_t)b * 6 * DM + 5 * DM;
        const int4 sl = *(const int4*)(tokslot + tok * 4);
        const int s4[4] = {sl.x, sl.y, sl.z, sl.w};
        const unsigned char* yr[4];
#pragma unroll
        for (int k = 0; k < 4; ++k) { const int e = s4[k] / NTOK, p = s4[k] % NTOK; yr[k] = Y8 + (size_t)(tab[40 + e] + p) * DM + lane * 16; }
        float* orow = A.out + (size_t)tok * DM + lane * 16;
        const bf16_t* xrow = (const bf16_t*)(ws + WS_X1B) + (size_t)tok * DM + lane * 16;
#pragma unroll
        for (int j = 0; j < 2; ++j) {
            float s[16];
#pragma unroll
            for (int q = 0; q < 16; ++q) s[q] = 0.f;
#pragma unroll
            for (int k = 0; k < 4; ++k) { const u32x4 v = *(const GAS u32x4*)(yr[k] + 1024 * j);
                const unsigned w[4] = {v.x, v.y, v.z, v.w};
#pragma unroll
                for (int q = 0; q < 4; ++q) { const f32x2 lo = __builtin_amdgcn_cvt_pk_f32_fp8(w[q], false), hi2 = __builtin_amdgcn_cvt_pk_f32_fp8(w[q], true);
                    s[4 * q] += lo.x; s[4 * q + 1] += lo.y; s[4 * q + 2] += hi2.x; s[4 * q + 3] += hi2.y; } }
            const u32x4 xw0 = *(const GAS u32x4*)(xrow + 1024 * j), xw1 = *(const GAS u32x4*)(xrow + 1024 * j + 8);
            const unsigned xw[8] = {xw0.x, xw0.y, xw0.z, xw0.w, xw1.x, xw1.y, xw1.z, xw1.w};
#pragma unroll
            for (int q = 0; q < 4; ++q) { const f32x4 x0 = (f32x4){bflo(xw[2 * q]), bfhi(xw[2 * q]), bflo(xw[2 * q + 1]), bfhi(xw[2 * q + 1])}; const f32x4 ga = *(const GAS f32x4*)(g2 + lane * 16 + 1024 * j + 4 * q);
                *(GAS f32x4*)(orow + 1024 * j + 4 * q) = x0 + ga * ((f32x4){s[4 * q], s[4 * q + 1], s[4 * q + 2], s[4 * q + 3]} * 0.125f); }
        }
    }
}
constexpr int RSTAB_OFF = TILETAB_OFF + 4096;
struct ProbMix {
    static constexpr int K = DM; static constexpr bool GATHER = false, PERM = false, MIDK = true;
    g8::DenseOrder ord; const bf16_t* A; const bf16_t* Bt; const float* x; const float* mod; bf16_t* x1b; const LAS float* rs;
    __device__ __forceinline__ bool next(int i, g8::Unit& u) const { const bool ok = ord.next(i, u); u.p0 = i; return ok; }
    __device__ __forceinline__ const char* a_base(const g8::Unit& u) const { return (const char*)A + (size_t)u.pm * 256 * K * 2; }
    __device__ __forceinline__ const char* b_base(const g8::Unit& u) const { return (const char*)Bt + (size_t)u.pn * 256 * K * 2; }
    __device__ __forceinline__ void a_voff(const g8::Unit&, int R0, int C0, int R1, int C1, unsigned& v00, unsigned& v01, unsigned& v10, unsigned& v11) const {
        v00 = (unsigned)(R0 * K + C0) * 2u; v01 = (unsigned)(R1 * K + C1) * 2u; v10 = v00 + 128u * K * 2u; v11 = v01 + 128u * K * 2u; }
    __device__ __forceinline__ void midk(g8::Acc& acc, const g8::Unit& u, int wr, int fr) const {
        const LAS float* t = rs + (size_t)u.p0 * 512;
#pragma unroll
        for (int ai = 0; ai < 2; ++ai)
#pragma unroll
            for (int m = 0; m < 4; ++m) { const float r = t[(ai * 128 + wr * 64 + m * 16 + fr) * 2];
#pragma unroll
                for (int bj = 0; bj < 2; ++bj)
#pragma unroll
                    for (int n = 0; n < 2; ++n) acc[ai][bj][m][n] *= r; }
    }
    __device__ __forceinline__ void epi(const g8::Acc& acc, const g8::Unit& u, int wr, int wc, int fr, int fq) const {
        const LAS float* t = rs + (size_t)u.p0 * 512;
        const int lr0 = wr * 64 + fr, col0 = u.pn * 256 + wc * 32 + 4 * fq; const int b = u.row0 / SEQ;
        const float* g1 = mod + (size_t)b * 6 * DM + 2 * DM + col0;
        f32x4 gv[2][2];
#pragma unroll
        for (int bj = 0; bj < 2; ++bj)
#pragma unroll
            for (int n = 0; n < 2; ++n) gv[bj][n] = *(const f32x4*)(g1 + bj * 128 + n * 16);
#pragma unroll
        for (int ai = 0; ai < 2; ++ai) {
            f32x4 xv[4][2][2];
#pragma unroll
            for (int m = 0; m < 4; ++m) { const size_t off = (size_t)(u.row0 + lr0 + ai * 128 + m * 16) * DM + col0;
#pragma unroll
                for (int bj = 0; bj < 2; ++bj)
#pragma unroll
                    for (int n = 0; n < 2; ++n) xv[m][bj][n] = *(const f32x4*)(x + off + bj * 128 + n * 16); }
#pragma unroll
            for (int m = 0; m < 4; ++m) { const int lr = lr0 + ai * 128 + m * 16; const float rl = t[lr * 2 + 1]; const size_t off = (size_t)(u.row0 + lr) * DM + col0;
#pragma unroll
                for (int bj = 0; bj < 2; ++bj)
#pragma unroll
                    for (int n = 0; n < 2; ++n) { const f32x4 r = xv[m][bj][n] + gv[bj][n] * (acc[ai][bj][m][n] * rl);
                        *(u32x2*)(x1b + off + bj * 128 + n * 16) = (u32x2){pk2(r.x, r.y), pk2(r.z, r.w)}; } }
            asm volatile("" ::: "memory");
        }
    }
};
__device__ __forceinline__ void p5_build_rstab(Frame& F, const g8::DenseOrder& ord, const float* ssn, const float* ssl) {
    LAS float* rs = (LAS float*)(F.lds + RSTAB_OFF);
    g8::Unit u;
    for (int i = 0; i < 4 && ord.next(i, u); ++i) {
        for (int r = F.tid; r < 256; r += NWAVES * 64) { const int row = u.row0 + r;
            const f32x4 a = *(const GAS f32x4*)(ssn + (size_t)row * 4); float sn = (a.x + a.y) + (a.z + a.w);
            float sl = 0.f;
#pragma unroll
            for (int q = 0; q < 4; ++q) { const f32x4 c = *(const GAS f32x4*)(ssl + (size_t)row * 16 + 4 * q); sl += (c.x + c.y) + (c.z + c.w); }
            const float rn = rsqrtf(sn * (1.f / 1024.f) + EPS), rl = rsqrtf(sl * (1.f / 1024.f) + EPS);
            rs[(i * 256 + r) * 2] = rn / rl; rs[(i * 256 + r) * 2 + 1] = rl; }
    }
    __syncthreads();
}
constexpr int TOKBUF_OFF = TILETAB_OFF + 3072;
namespace g8 {
typedef int v8i __attribute__((ext_vector_type(8)));
typedef int v4i __attribute__((ext_vector_type(4)));
__host__ __device__ __forceinline__ int sw8(int row) { const int P = (row >> 1) & 7; return P ^ ((((P >> 2) ^ (P >> 1)) & 1) << 1); }
__device__ __forceinline__ void mfma16_fp8(f32x4& acc, const v8i& a, const v8i& b, int scl) {
    asm volatile("v_mfma_scale_f32_16x16x128_f8f6f4 %0, %1, %2, %0, %3, %3 op_sel_hi:[0,0,0]" : "+v"(acc) : "v"(a), "v"(b), "v"(scl)); }

template <class P>
__device__ __forceinline__ void gemm8_phase(LAS unsigned char* lds, const P& S) {
    const int tid = threadIdx.x, wid = __builtin_amdgcn_readfirstlane(tid >> 6), lane = tid & 63, wr = wid >> 2, wc = wid & 3, fr = lane & 15, fq = lane >> 4;
    constexpr int KB = P::KB, nt = KB / 128;
    const int R0 = wid * 8 + (lane >> 3), R1 = R0 + 64;
    const unsigned cs = (unsigned)(((lane & 7) ^ sw8(R0)) * 16);
    const int Rb0 = (R0 & ~31) + perm32(R0 & 31), Rb1 = (R1 & ~31) + perm32(R1 & 31);
    const unsigned voffB0 = (unsigned)Rb0 * KB + cs, voffB1 = (unsigned)Rb1 * KB + cs;
    constexpr size_t kstep = 128;
    constexpr unsigned hstep = 128u * KB;
    const unsigned ldsw = (unsigned)wid * 1024u;
    const int xr = sw8(fr);
    int aoff[2], boff[2];
#pragma unroll
    for (int c = 0; c < 2; ++c) { const int sl = ((2 * fq + c) ^ xr) << 4; aoff[c] = (64 * wr + fr) * 128 + sl; boff[c] = (32 * wc + fr) * 128 + sl; }
    int scl = 0x7f7f7f7f;
    asm volatile("" : "+v"(scl));
#define G8_SA(b, h) (((b) * 2 + (h)) * HTB)
#define G8_SB(b, h) ((4 + (b) * 2 + (h)) * HTB)
#define G8_STAGE(bufoff, gbase, o0, o1) do { \
        __builtin_amdgcn_global_load_lds((const unsigned*)((const char*)(gbase) + (o0)), (LAS unsigned*)(lds + (bufoff) + ldsw), 16, 0, 0); \
        __builtin_amdgcn_global_load_lds((const unsigned*)((const char*)(gbase) + (o1)), (LAS unsigned*)(lds + (bufoff) + ldsw + 8192), 16, 0, 0); } while (0)
#define G8_STAGEB(bufoff, gbase, h) G8_STAGE(bufoff, gbase, voffB0 + (h) * hstep, voffB1 + (h) * hstep)
#define G8_LDA(dst, b, h) do { _Pragma("unroll") for (int m = 0; m < 4; ++m) { \
        const v4i _lo = *(const LAS v4i*)(lds + G8_SA(b, h) + aoff[0] + m * 2048), _hi = *(const LAS v4i*)(lds + G8_SA(b, h) + aoff[1] + m * 2048); \
        dst[m] = __builtin_shufflevector(_lo, _hi, 0, 1, 2, 3, 4, 5, 6, 7); } } while (0)
#define G8_LDB(dst, b, h) do { _Pragma("unroll") for (int n = 0; n < 2; ++n) { \
        const v4i _lo = *(const LAS v4i*)(lds + G8_SB(b, h) + boff[0] + n * 2048), _hi = *(const LAS v4i*)(lds + G8_SB(b, h) + boff[1] + n * 2048); \
        dst[n] = __builtin_shufflevector(_lo, _hi, 0, 1, 2, 3, 4, 5, 6, 7); } } while (0)
#define G8_MMA(ai, bj, At, Bt) do { __builtin_amdgcn_s_setprio(1); _Pragma("unroll") for (int m = 0; m < 4; ++m) _Pragma("unroll") for (int n = 0; n < 2; ++n) \
        mfma16_fp8(acc[ai][bj][m][n], Bt[n], At[m], scl); __builtin_amdgcn_s_setprio(0); } while (0)
#define G8_WAIT_V(n) asm volatile("s_waitcnt vmcnt(" #n ")" ::: "memory")
#define G8_WAIT_L(n) asm volatile("s_waitcnt lgkmcnt(" #n ")" ::: "memory")
#define G8_BAR __builtin_amdgcn_s_barrier()
#define G8_SCHED __builtin_amdgcn_sched_barrier(0)
    Unit cur, nxt; int ui = 0;
    if (!S.next(0, cur)) return;
    Acc acc;
#pragma unroll
    for (int a = 0; a < 2; ++a)
#pragma unroll
        for (int b = 0; b < 2; ++b)
#pragma unroll
            for (int m = 0; m < 4; ++m)
#pragma unroll
                for (int n = 0; n < 2; ++n) acc[a][b][m][n] = (f32x4){0.f, 0.f, 0.f, 0.f};
    v8i At[4], B0[2], B1[2];
    unsigned c00, c01, c10, c11, n00, n01, n10, n11;
    S.a_voff(cur, R0, R1, cs, c00, c01, c10, c11);
    n00 = c00; n01 = c01; n10 = c10; n11 = c11;
    const char* cA = S.a_base(cur); const char* cB = S.b_base(cur);
    if (P::ROWPF) S.tok_prefetch(lds, cur, 0, wid, lane);
    G8_STAGEB(G8_SB(0, 0), cB, 0); G8_STAGEB(G8_SB(0, 1), cB, 1); G8_STAGE(G8_SA(0, 0), cA, c00, c01); G8_STAGE(G8_SA(0, 1), cA, c10, c11);
    if (wr == 1) G8_BAR;
    G8_WAIT_V(2); G8_BAR;
    G8_STAGEB(G8_SB(1, 0), cB + kstep, 0); G8_STAGE(G8_SA(1, 0), cA + kstep, c00, c01); G8_STAGEB(G8_SB(1, 1), cB + kstep, 1);
    G8_WAIT_V(6); G8_BAR;
    for (;;) {
        const bool has_next = S.next(ui + 1, nxt);
        const char* nA = has_next ? S.a_base(nxt) : cA; const char* nB = has_next ? S.b_base(nxt) : cB;
        if (P::GATHER || P::ROWPF) { if (has_next) S.tok_prefetch(lds, nxt, ui + 1, wid, lane); }
        if (P::GATHER) { n00 = c00; n01 = c01; n10 = c10; n11 = c11; }
        for (int t = 0; t < nt; t += 2) {
            const bool last = (t == nt - 2);
            if (P::GATHER) { if (last && has_next) S.a_voff_lds(lds, nxt, ui + 1, R0, R1, cs, n00, n01, n10, n11); }
            const char* a1 = cA + (size_t)(t + 1) * kstep;
            const char* a2 = last ? nA : cA + (size_t)(t + 2) * kstep; const char* b2 = last ? nB : cB + (size_t)(t + 2) * kstep;
            const char* a3 = a2 + kstep; const char* b3 = b2 + kstep;
            const unsigned x00 = (P::GATHER && last) ? n00 : c00, x01 = (P::GATHER && last) ? n01 : c01, x10 = (P::GATHER && last) ? n10 : c10, x11 = (P::GATHER && last) ? n11 : c11;
            G8_LDB(B0, 0, 0); G8_LDB(B1, 0, 1); G8_SCHED; G8_LDA(At, 0, 0); G8_STAGE(G8_SA(1, 1), a1, c10, c11);
            G8_WAIT_V(8); G8_WAIT_L(0); G8_BAR; G8_WAIT_L(0); G8_SCHED; G8_MMA(0, 0, At, B0); G8_MMA(0, 1, At, B1); G8_BAR; G8_SCHED;
            G8_LDA(At, 0, 1); G8_STAGEB(G8_SB(0, 0), b2, 0); G8_STAGEB(G8_SB(0, 1), b2, 1); G8_STAGE(G8_SA(0, 0), a2, x00, x01);
            G8_WAIT_V(8); G8_WAIT_L(0); G8_BAR; G8_WAIT_L(0); G8_SCHED; G8_MMA(1, 0, At, B0); G8_MMA(1, 1, At, B1); G8_BAR; G8_SCHED;
            G8_LDB(B0, 1, 0); G8_LDB(B1, 1, 1); G8_SCHED; G8_LDA(At, 1, 0); G8_STAGE(G8_SA(0, 1), a2, x10, x11);
            G8_WAIT_V(8); G8_WAIT_L(0); G8_BAR; G8_WAIT_L(0); G8_SCHED; G8_MMA(0, 0, At, B0); G8_MMA(0, 1, At, B1); G8_BAR; G8_SCHED;
            G8_LDA(At, 1, 1); G8_STAGEB(G8_SB(1, 0), b3, 0); G8_STAGEB(G8_SB(1, 1), b3, 1); G8_STAGE(G8_SA(1, 0), a3, x00, x01);
            G8_WAIT_V(8); G8_WAIT_L(0); G8_BAR; G8_WAIT_L(0); G8_SCHED; G8_MMA(1, 0, At, B0); G8_MMA(1, 1, At, B1); G8_BAR; G8_SCHED;
        }
        asm volatile("s_nop 15\n\ts_nop 15" ::: "memory");
        if (wr == 0) G8_BAR;
        { int tz = threadIdx.x; asm volatile("" : "+v"(tz));
          const int lz = tz & 63; S.epi(acc, cur, wr, wc, lz & 15, lz >> 4, lds, ui); }
        if (!has_next) break;
#pragma unroll
        for (int a = 0; a < 2; ++a)
#pragma unroll
            for (int b = 0; b < 2; ++b)
#pragma unroll
                for (int m = 0; m < 4; ++m)
#pragma unroll
                    for (int n = 0; n < 2; ++n) acc[a][b][m][n] = (f32x4){0.f, 0.f, 0.f, 0.f};
        cur = nxt; cA = nA; cB = nB; ++ui;
        if (P::GATHER) { c00 = n00; c01 = n01; c10 = n10; c11 = n11; }
        if (wr == 1) G8_BAR;
    }
    G8_WAIT_V(0);
    G8_BAR;
#undef G8_SA
#undef G8_SB
#undef G8_STAGE
#undef G8_STAGEB
#undef G8_LDA
#undef G8_LDB
#undef G8_MMA
#undef G8_WAIT_V
#undef G8_WAIT_L
#undef G8_BAR
#undef G8_SCHED
}
}


struct Conv8Src { const float* W; int ldw, n_src0, k0; unsigned char* WT8; int dst_row0; };
__device__ __forceinline__ void conv8_load(const Conv8Src& s, f32x4 (&v)[8], int tid) {
    const int c4 = tid & 15, kr = tid >> 4;
#pragma unroll
    for (int i = 0; i < 8; ++i) v[i] = *(const GAS f32x4*)(s.W + (size_t)(s.k0 + i * 32 + kr) * s.ldw + s.n_src0 + 4 * c4);
}
__device__ __forceinline__ void conv8_to_lds(const f32x4 (&v)[8], LAS float* scr, int tid) {
    const int c4 = tid & 15, kr = tid >> 4;
#pragma unroll
    for (int i = 0; i < 8; ++i) { const int k = i * 32 + kr; const int g = 4 * ((k >> 4) & 7) + 2 * (k >> 7);
        *(LAS f32x2*)(scr + k * 64 + ((4 * c4) ^ g)) = (f32x2){v[i].x, v[i].y}; *(LAS f32x2*)(scr + k * 64 + ((4 * c4 + 2) ^ g)) = (f32x2){v[i].z, v[i].w}; }
}
__device__ __forceinline__ void conv8_store(const Conv8Src& sd, const LAS float* scr, int tid) {
    const int kc = tid & 15, ns = tid >> 4; const int g = 4 * (kc & 7) + 2 * (kc >> 3);
#pragma unroll
    for (int p = 0; p < 2; ++p) { const int n = ns + 32 * p; const LAS float* s = scr + (16 * kc) * 64 + (n ^ g);
        u32x4 o;
        o.x = pk4_fp8(s[0 * 64] * 32.f, s[1 * 64] * 32.f, s[2 * 64] * 32.f, s[3 * 64] * 32.f);     o.y = pk4_fp8(s[4 * 64] * 32.f, s[5 * 64] * 32.f, s[6 * 64] * 32.f, s[7 * 64] * 32.f);
        o.z = pk4_fp8(s[8 * 64] * 32.f, s[9 * 64] * 32.f, s[10 * 64] * 32.f, s[11 * 64] * 32.f);   o.w = pk4_fp8(s[12 * 64] * 32.f, s[13 * 64] * 32.f, s[14 * 64] * 32.f, s[15 * 64] * 32.f);
        *(GAS u32x4*)(sd.WT8 + (size_t)(sd.dst_row0 + n) * DM + sd.k0 + 16 * kc) = o; }
}

struct ProbM1F {
    static constexpr int KB = DM; static constexpr bool GATHER = true, ROWPF = false;
    MoeOrder ord; const unsigned char* H8; const unsigned char* W1T8; const float* b1; const int* rowtok; unsigned char* ACT8;
    __device__ __forceinline__ bool next(int i, g8::Unit& u) const { return ord.next(i, u); }
    __device__ __forceinline__ const char* a_base(const g8::Unit&) const { return (const char*)H8; }
    __device__ __forceinline__ const char* b_base(const g8::Unit& u) const { return (const char*)W1T8 + ((size_t)u.e * 4096 + (size_t)u.pn * 256) * KB; }
    __device__ __forceinline__ void a_voff(const g8::Unit& u, int R0, int R1, unsigned cs, unsigned& v00, unsigned& v01, unsigned& v10, unsigned& v11) const {
        const int cntE = ord.tab[8 + u.e]; const int* rt = rowtok + (size_t)u.e * NTOK + u.p0; const int lim = cntE - u.p0;
        const int t00 = (R0 < lim) ? rt[R0] : 0, t01 = (R1 < lim) ? rt[R1] : 0, t10 = (128 + R0 < lim) ? rt[128 + R0] : 0, t11 = (128 + R1 < lim) ? rt[128 + R1] : 0;
        v00 = (unsigned)t00 * KB + cs; v01 = (unsigned)t01 * KB + cs; v10 = (unsigned)t10 * KB + cs; v11 = (unsigned)t11 * KB + cs; }
    __device__ __forceinline__ void tok_prefetch(LAS unsigned char* lds, const g8::Unit& u, int ui, int wid, int lane) const {
        if (wid == 0) __builtin_amdgcn_global_load_lds((const unsigned*)(rowtok + (size_t)u.e * NTOK + u.p0 + lane * 4), (LAS unsigned*)(lds + TOKBUF_OFF + (ui & 1) * 1024), 16, 0, 0); }
    __device__ __forceinline__ void a_voff_lds(const LAS unsigned char* lds, const g8::Unit& u, int ui, int R0, int R1, unsigned cs, unsigned& v00, unsigned& v01, unsigned& v10, unsigned& v11) const {
        const LAS int* rt = (const LAS int*)(lds + TOKBUF_OFF + (ui & 1) * 1024); const int lim = ord.tab[8 + u.e] - u.p0;
        const int t00 = (R0 < lim) ? rt[R0] : 0, t01 = (R1 < lim) ? rt[R1] : 0, t10 = (128 + R0 < lim) ? rt[128 + R0] : 0, t11 = (128 + R1 < lim) ? rt[128 + R1] : 0;
        v00 = (unsigned)t00 * KB + cs; v01 = (unsigned)t01 * KB + cs; v10 = (unsigned)t10 * KB + cs; v11 = (unsigned)t11 * KB + cs; }
    __device__ __forceinline__ void epi(const g8::Acc& acc, const g8::Unit& u, int wr, int wc, int fr, int fq, const LAS unsigned char* lds, int ui) const {
        const int cc = u.pn * 128 + wc * 32 + 8 * fq;
        const float* bg = b1 + (size_t)u.e * 4096 + cc; const float* bl = bg + 2048;
        f32x4 bgv[2], blv[2];
#pragma unroll
        for (int n = 0; n < 2; ++n) { bgv[n] = *(const f32x4*)(bg + 4 * n); blv[n] = *(const f32x4*)(bl + 4 * n) + 1.f; }
#pragma unroll
        for (int ai = 0; ai < 2; ++ai)
#pragma unroll
            for (int m = 0; m < 4; ++m) {
                unsigned w[2];
#pragma unroll
                for (int n = 0; n < 2; ++n) { f32x2 o2[2];
#pragma unroll
                    for (int h2 = 0; h2 < 2; ++h2) {
                        const f32x2 ag = (f32x2){acc[ai][0][m][n][2 * h2], acc[ai][0][m][n][2 * h2 + 1]}, al = (f32x2){acc[ai][1][m][n][2 * h2], acc[ai][1][m][n][2 * h2 + 1]};
                        const f32x2 bgg = (f32x2){bgv[n][2 * h2], bgv[n][2 * h2 + 1]}, bll = (f32x2){blv[n][2 * h2], blv[n][2 * h2 + 1]};
                        f32x2 ug = ag * 0.03125f + bgg, ul = al * 0.03125f + bll;
                        ug.x = fminf(ug.x, 7.f); ug.y = fminf(ug.y, 7.f); ul.x = fminf(fmaxf(ul.x, -6.f), 8.f); ul.y = fminf(fmaxf(ul.y, -6.f), 8.f);
                        const f32x2 ea = ug * (-1.702f * 1.4426950408889634f);
                        f32x2 den; den.x = __builtin_amdgcn_exp2f(ea.x); den.y = __builtin_amdgcn_exp2f(ea.y); den = den + 1.f;
                        f32x2 sg; sg.x = __builtin_amdgcn_rcpf(den.x); sg.y = __builtin_amdgcn_rcpf(den.y);
                        o2[h2] = (ug * sg) * ul; }
                    w[n] = pk4_fp8(o2[0].x, o2[0].y, o2[1].x, o2[1].y); }
                *(u32x2*)(ACT8 + (size_t)(u.row0 + ai * 128 + wr * 64 + m * 16 + fr) * DM + cc) = (u32x2){w[0], w[1]}; }
    }
};
struct ProbM2F {
    static constexpr int KB = DM; static constexpr bool GATHER = false, ROWPF = true;
    MoeOrder ord; const unsigned char* ACT8; const unsigned char* W2T8; const float* b2; const float* rowg; unsigned char* Y8;
    __device__ __forceinline__ bool next(int i, g8::Unit& u) const { return ord.next(i, u); }
    __device__ __forceinline__ const char* a_base(const g8::Unit& u) const { return (const char*)ACT8 + (size_t)u.row0 * KB; }
    __device__ __forceinline__ const char* b_base(const g8::Unit& u) const { return (const char*)W2T8 + ((size_t)u.e * DM + (size_t)u.pn * 256) * KB; }
    __device__ __forceinline__ void a_voff(const g8::Unit&, int R0, int R1, unsigned cs, unsigned& v00, unsigned& v01, unsigned& v10, unsigned& v11) const {
        v00 = (unsigned)R0 * KB + cs; v01 = (unsigned)R1 * KB + cs; v10 = v00 + 128u * KB; v11 = v01 + 128u * KB; }
    __device__ __forceinline__ void tok_prefetch(LAS unsigned char* lds, const g8::Unit& u, int ui, int wid, int lane) const {
        if (wid == 0) __builtin_amdgcn_global_load_lds((const unsigned*)(rowg + (size_t)u.e * NTOK + u.p0 + lane * 4), (LAS unsigned*)(lds + RSTAB_OFF + (ui % 3) * 1024), 16, 0, 0); }
    __device__ __forceinline__ void a_voff_lds(const LAS unsigned char*, const g8::Unit&, int, int, int, unsigned, unsigned&, unsigned&, unsigned&, unsigned&) const {}
    __device__ __forceinline__ void epi(const g8::Acc& acc, const g8::Unit& u, int wr, int wc, int fr, int fq, const LAS unsigned char* lds, int ui) const {
        const int lr0 = wr * 64 + fr, col0 = u.pn * 256 + wc * 32 + 8 * fq;
        const LAS float* rg = (const LAS float*)(lds + RSTAB_OFF + (ui % 3) * 1024) + lr0;
        f32x4 bv[2][2];
#pragma unroll
        for (int bj = 0; bj < 2; ++bj)
#pragma unroll
            for (int n = 0; n < 2; ++n) bv[bj][n] = *(const f32x4*)(b2 + (size_t)u.e * DM + col0 + bj * 128 + 4 * n);
#pragma unroll
        for (int ai = 0; ai < 2; ++ai)
#pragma unroll
            for (int m = 0; m < 4; ++m) { const float gsc = rg[ai * 128 + m * 16] * 8.f; unsigned char* rowp = Y8 + (size_t)(u.row0 + lr0 + ai * 128 + m * 16) * DM + col0;
#pragma unroll
                for (int bj = 0; bj < 2; ++bj) { const f32x4 v0 = (acc[ai][bj][m][0] * 0.03125f + bv[bj][0]) * gsc, v1 = (acc[ai][bj][m][1] * 0.03125f + bv[bj][1]) * gsc;
                    *(u32x2*)(rowp + bj * 128) = (u32x2){pk4_fp8(v0[0], v0[1], v0[2], v0[3]), pk4_fp8(v1[0], v1[1], v1[2], v1[3])}; } }
    }
};

constexpr int CONV_NIT1 = NE * 16 * 64, CONV_NIT = CONV_NIT1 + NE * 16 * 32;
struct Conv8Item { const float* W; int ldw, n_src0, k0; unsigned char* WT8; int dst_row0; };
__device__ __forceinline__ Conv8Item conv8_item_of(const Args& A, unsigned char* ws, int it) {
    constexpr int I1 = NE * 16 * 64;
    Conv8Item s;
    if (it < I1) { const int nb = it & 63, kb = (it >> 6) & 15, e = it >> 10; const int d0 = nb * 64, pn = d0 >> 8, rr = d0 & 255;
        s.W = A.in[25] + (size_t)e * DM * 4096; s.ldw = 4096; s.n_src0 = (rr < 128) ? (pn * 128 + rr) : (2048 + pn * 128 + rr - 128); s.k0 = kb * 128; s.WT8 = ws + WS_W1 + (size_t)e * 4096 * DM; s.dst_row0 = d0; }
    else { const int r = it - I1; const int nb = r & 31, kb = (r >> 5) & 15, e = r >> 9;
        s.W = A.in[27] + (size_t)e * DM * DM; s.ldw = DM; s.n_src0 = nb * 64; s.k0 = kb * 128; s.WT8 = ws + WS_W2 + (size_t)e * DM * DM; s.dst_row0 = nb * 64; }
    return s;
}
__device__ __forceinline__ void conv8_dma(const Conv8Item& s, LAS unsigned char* buf, int wave, int lane) {
#pragma unroll
    for (int i = 0; i < 4; ++i) { const int q = wave * 4 + i, k = 4 * q + (lane >> 4), c = lane & 15;
        const float* src = s.W + (size_t)(s.k0 + k) * s.ldw + s.n_src0 + ((c ^ ((k >> 4) & 7)) << 2);
        __builtin_amdgcn_global_load_lds((const unsigned*)src, (LAS unsigned*)(buf + q * 1024), 16, 0, 2); }
}
__device__ __forceinline__ void conv8_out(const Conv8Item& sd, const LAS float* scr, int tid) {
    const int kc = tid & 7, n = tid >> 3; const LAS float* s = scr + (16 * kc) * 64 + ((((n >> 2) ^ kc)) << 2) + (n & 3);
    u32x4 o;
    o.x = pk4_fp8(s[0 * 64] * 32.f, s[1 * 64] * 32.f, s[2 * 64] * 32.f, s[3 * 64] * 32.f);     o.y = pk4_fp8(s[4 * 64] * 32.f, s[5 * 64] * 32.f, s[6 * 64] * 32.f, s[7 * 64] * 32.f);
    o.z = pk4_fp8(s[8 * 64] * 32.f, s[9 * 64] * 32.f, s[10 * 64] * 32.f, s[11 * 64] * 32.f);   o.w = pk4_fp8(s[12 * 64] * 32.f, s[13 * 64] * 32.f, s[14 * 64] * 32.f, s[15 * 64] * 32.f);
    *(GAS u32x4*)(sd.WT8 + (size_t)(sd.dst_row0 + n) * DM + sd.k0 + 16 * kc) = o;
}
__device__ __forceinline__ void p0_experts(Frame& F, const Args& A, int cv, int cG, int it_lo, int it_hi) {
    unsigned char* ws = F.ws;
    const int n = (it_hi - it_lo - cv + cG - 1) / cG;
    if (n <= 0) return;
#define P0_ITEM(j) conv8_item_of(A, ws, it_lo + cv + (((j) < n) ? (j) : n - 1) * cG)
    Conv8Item cur = P0_ITEM(0);
    conv8_dma(cur, F.lds, F.wave, F.lane);
#pragma unroll 1
    for (int j = 1; j < 4; ++j) { const Conv8Item t = P0_ITEM(j); conv8_dma(t, F.lds + j * 32768, F.wave, F.lane); }
    int bi = 0, bn = 4;
#pragma unroll 1
    for (int i = 0; i < n; ++i) {
        if (i < 3) asm volatile("s_waitcnt vmcnt(12)" ::: "memory"); else asm volatile("s_waitcnt vmcnt(15)" ::: "memory");
        asm volatile("s_waitcnt lgkmcnt(0)" ::: "memory"); __builtin_amdgcn_s_barrier(); asm volatile("" ::: "memory");
        { const Conv8Item t4 = P0_ITEM(i + 4); conv8_dma(t4, F.lds + bn * 32768, F.wave, F.lane); }
        conv8_out(cur, (const LAS float*)(F.lds + bi * 32768), F.tid);
        cur = P0_ITEM(i + 1);
        bi = (bi == 4) ? 0 : bi + 1; bn = (bn == 4) ? 0 : bn + 1;
    }
#undef P0_ITEM
    asm volatile("s_waitcnt vmcnt(0)" ::: "memory");
    __syncthreads();
    for (int u = F.tid; u < (LDS_BYTES - LDSCTL_OFF) / 4; u += NWAVES * 64) ((LAS unsigned*)(F.lds + LDSCTL_OFF))[u] = 0u;
    __syncthreads();
}
constexpr int LRU_LDS_PER_WAVE = 16384, LRU_XG_OFF = 9728;
__device__ __forceinline__ float gelu_tanh_f(float x) { return x * fast_sigmoid(1.5957691216057308f * (x + 0.044715f * x * x * x)); }
template <bool PASSB>
__device__ __forceinline__ void lru_item(Frame& F, const Args& A, int item) {
    const int n = item & 15, ck = (item >> 4) & 31, b = item >> 9;
    const int lane = F.lane, l15 = lane & 15, q = lane >> 4;
    unsigned char* ws = F.ws;
    const bf16_t* Z = (const bf16_t*)(ws + WS_Z);
    LAS bf16_t* xl = (LAS bf16_t*)(F.lds + F.wave * LRU_LDS_PER_WAVE);
    LAS bf16_t* xgl = (LAS bf16_t*)(F.lds + F.wave * LRU_LDS_PER_WAVE + LRU_XG_OFF);
    const int t0 = ck * 64; const size_t tokbase = (size_t)b * SEQ;
    float* AS = (float*)(ws + WS_LRUS); float* HS = AS + (size_t)NB * 32 * 1024;
#pragma unroll
    for (int j0 = 0; j0 < 72; j0 += 8) { const int j = j0 + (lane >> 3), t = t0 - 3 + j;
        u32x4 v = (u32x4){0u, 0u, 0u, 0u};
        if (j < 67 && t >= 0) v = *(const GAS u32x4*)(Z + (tokbase + t) * ZW + ZC_XR + n * 64 + (lane & 7) * 8);
        if (j < 67) *(LAS u32x4*)(xl + j * 72 + (lane & 7) * 8) = v; }
    u32x4 xg0[4], xg1[4];
    if (PASSB) {
#pragma unroll
        for (int i = 0; i < 4; ++i) { const int r = 8 * i + (lane >> 3);
            xg0[i] = *(const GAS u32x4*)(Z + (tokbase + t0 + r) * ZW + ZC_XG + n * 64 + (lane & 7) * 8);
            xg1[i] = *(const GAS u32x4*)(Z + (tokbase + t0 + 32 + r) * ZW + ZC_XG + n * 64 + (lane & 7) * 8); }
#pragma unroll
        for (int i = 0; i < 4; ++i) *(LAS u32x4*)(xgl + (8 * i + (lane >> 3)) * 72 + (lane & 7) * 8) = xg0[i];
    }
    const bf16_t* wrg = (const bf16_t*)(ws + WS_SMALL + SM_WRG) + (size_t)n * 4096; const bf16_t* wig = (const bf16_t*)(ws + WS_SMALL + SM_WIG) + (size_t)n * 4096;
    bf16x8 fr_[4][2], fi_[4][2]; float brg[4], big[4], c8[4];
#pragma unroll
    for (int nt = 0; nt < 4; ++nt) {
#pragma unroll
        for (int s = 0; s < 2; ++s) { fr_[nt][s] = *(const GAS bf16x8*)(wrg + (16 * nt + l15) * 64 + 32 * s + 8 * q); fi_[nt][s] = *(const GAS bf16x8*)(wig + (16 * nt + l15) * 64 + 32 * s + 8 * q); }
        const int ch = n * 64 + 16 * nt + l15; brg[nt] = A.in[15][ch]; big[nt] = A.in[17][ch];
        const float L = A.in[18][ch]; const float sp = (L < 0.f) ? (-L + log1pf(__expf(L))) : log1pf(__expf(-L)); c8[nt] = -8.f * sp; }
    LDS_WAIT();
    { const int ch = n * 64 + lane; const float w0 = A.in[12][ch], w1 = A.in[12][1024 + ch], w2 = A.in[12][2048 + ch], w3 = A.in[12][3072 + ch], cb = A.in[13][ch];
      float x0 = bf2f(xl[lane]), x1 = bf2f(xl[72 + lane]), x2 = bf2f(xl[144 + lane]);
#pragma unroll 8
      for (int t = 0; t < 64; ++t) { const float x3 = bf2f(xl[(t + 3) * 72 + lane]); const float xc = cb + w0 * x0 + w1 * x1 + w2 * x2 + w3 * x3; xl[t * 72 + lane] = (bf16_t)f2bf(xc); x0 = x1; x1 = x2; x2 = x3; } }
    LDS_WAIT();
    float carry[4], atot[4];
#pragma unroll
    for (int nt = 0; nt < 4; ++nt) { carry[nt] = 0.f; atot[nt] = 1.f; }
    if (PASSB) {
#pragma unroll 1
        for (int j0 = 0; j0 < ck; j0 += 8) {
            float ta[8][4], th[8][4];
#pragma unroll
            for (int jj = 0; jj < 8; ++jj) { const int j = (j0 + jj < ck) ? j0 + jj : ck - 1;
#pragma unroll
                for (int nt = 0; nt < 4; ++nt) { const size_t o = ((size_t)b * 32 + j) * 1024 + n * 64 + 16 * nt + l15; ta[jj][nt] = AS[o]; th[jj][nt] = HS[o]; } }
#pragma unroll
            for (int jj = 0; jj < 8; ++jj) { if (j0 + jj < ck) {
#pragma unroll
                for (int nt = 0; nt < 4; ++nt) carry[nt] = ta[jj][nt] * carry[nt] + th[jj][nt]; } }
        }
    }
    float gout[4];
#pragma unroll
    for (int nt = 0; nt < 4; ++nt) gout[nt] = PASSB ? A.in[20][n * 64 + 16 * nt + l15] : 0.f;
#pragma unroll 1
    for (int mt = 0; mt < 4; ++mt) {
        const bf16x8 a0 = *(const LAS bf16x8*)(xl + (16 * mt + l15) * 72 + 8 * q), a1 = *(const LAS bf16x8*)(xl + (16 * mt + l15) * 72 + 32 + 8 * q);
        float xg[4][4];
        if (PASSB) {
            if (mt == 2) {
                LDS_WAIT();
#pragma unroll
                for (int i = 0; i < 4; ++i) *(LAS u32x4*)(xgl + (8 * i + (lane >> 3)) * 72 + (lane & 7) * 8) = xg1[i];
                LDS_WAIT();
            }
#pragma unroll
            for (int nt = 0; nt < 4; ++nt)
#pragma unroll
                for (int r = 0; r < 4; ++r) xg[nt][r] = bf2f(xgl[(16 * (mt & 1) + 4 * q + r) * 72 + 16 * nt + l15]);
        }
        float ss[4] = {0.f, 0.f, 0.f, 0.f};
#pragma unroll
        for (int nt = 0; nt < 4; ++nt) {
            f32x4 ar = (f32x4){0.f, 0.f, 0.f, 0.f}, ai = ar;
            ar = __builtin_amdgcn_mfma_f32_16x16x32_bf16(a0, fr_[nt][0], ar, 0, 0, 0); ar = __builtin_amdgcn_mfma_f32_16x16x32_bf16(a1, fr_[nt][1], ar, 0, 0, 0);
            ai = __builtin_amdgcn_mfma_f32_16x16x32_bf16(a0, fi_[nt][0], ai, 0, 0, 0); ai = __builtin_amdgcn_mfma_f32_16x16x32_bf16(a1, fi_[nt][1], ai, 0, 0, 0);
            float av[4], uv[4];
#pragma unroll
            for (int r = 0; r < 4; ++r) {
                const float rg = fast_sigmoid(ar[r] + brg[nt]), ig = fast_sigmoid(ai[r] + big[nt]);
                const float la = c8[nt] * rg; av[r] = __expf(la);
                uv[r] = sqrtf(fmaxf(1.f - av[r] * av[r], 0.f)) * ig * bf2f(xl[(16 * mt + 4 * q + r) * 72 + 16 * nt + l15]);
            }
            const float A4 = (av[0] * av[1]) * (av[2] * av[3]);
            const float H4 = ((uv[0] * av[1] + uv[1]) * av[2] + uv[2]) * av[3] + uv[3];
            float hin = carry[nt], hc = carry[nt], ap = 1.f;
#pragma unroll
            for (int qq = 0; qq < 4; ++qq) { const float Aq = __shfl(A4, l15 + 16 * qq), Hq = __shfl(H4, l15 + 16 * qq);
                hc = Aq * hc + Hq; ap *= Aq; if (qq < q) hin = Aq * hin + Hq; }
            carry[nt] = hc; atot[nt] *= ap;
            if (PASSB) {
                float h = hin;
#pragma unroll
                for (int r = 0; r < 4; ++r) { h = av[r] * h + uv[r]; const float o = h * gelu_tanh_f(xg[nt][r]); ss[r] += o * o;
                    ((bf16_t*)(ws + WS_A2))[(tokbase + t0 + 16 * mt + 4 * q + r) * DM + 1024 + n * 64 + 16 * nt + l15] = (bf16_t)f2bf(o * gout[nt]); }
            }
        }
        if (PASSB) {
#pragma unroll
            for (int r = 0; r < 4; ++r) { float v = ss[r]; v += __shfl_xor(v, 1); v += __shfl_xor(v, 2); v += __shfl_xor(v, 4); v += __shfl_xor(v, 8);
                if (l15 == 0) ((float*)(ws + WS_SSL))[(tokbase + t0 + 16 * mt + 4 * q + r) * 16 + n] = v; }
        }
    }
    if (!PASSB) { if (q == 0) {
#pragma unroll
        for (int nt = 0; nt < 4; ++nt) { const size_t o = ((size_t)b * 32 + ck) * 1024 + n * 64 + 16 * nt + l15; AS[o] = atot[nt]; HS[o] = carry[nt]; } } }
    LDS_WAIT();
}
constexpr float C2 = 0.125f * 1.4426950408889634f;
__device__ __forceinline__ int crow(int r, int hi) { return (r & 3) + 8 * (r >> 2) + 4 * hi; }

__device__ __forceinline__ void prep_item(Frame& F, const Args& A, int item) {
    const int b = item >> 5, tl = item & 31; const size_t tok0 = (size_t)b * SEQ + tl * 64;
    unsigned char* ws = F.ws; bf16_t* Z = (bf16_t*)(ws + WS_Z);
    const int tid = F.tid;
    u32x4 qv[16];
    const f32x4 qga = *(const GAS f32x4*)(A.in[10] + (tid & 7) * 8), qgb = *(const GAS f32x4*)(A.in[10] + (tid & 7) * 8 + 4);
#pragma unroll
    for (int it = 0; it < 16; ++it) { const int u = it * 512 + tid, c = u & 7, h = (u >> 3) & 15, r = u >> 7; qv[it] = *(const GAS u32x4*)(Z + (tok0 + r) * ZW + h * 64 + c * 8); }
#pragma unroll
    for (int it = 0; it < 16; ++it) {
        const int u = it * 512 + tid, c = u & 7, h = (u >> 3) & 15, r = u >> 7;
        bf16_t* p = Z + (tok0 + r) * ZW + h * 64 + c * 8;
        const u32x4 v = qv[it];
        float f[8] = {bflo(v.x), bfhi(v.x), bflo(v.y), bfhi(v.y), bflo(v.z), bfhi(v.z), bflo(v.w), bfhi(v.w)};
        float ss = 0.f;
#pragma unroll
        for (int j = 0; j < 8; ++j) ss += f[j] * f[j];
        ss += __shfl_xor(ss, 1); ss += __shfl_xor(ss, 2); ss += __shfl_xor(ss, 4);
        const float rs = rsqrtf(ss * (1.f / 64.f) + EPS) * C2;
        const f32x4 ga = qga, gb = qgb;
        u32x4 o; o.x = pk2(f[0] * rs * ga.x, f[1] * rs * ga.y); o.y = pk2(f[2] * rs * ga.z, f[3] * rs * ga.w); o.z = pk2(f[4] * rs * gb.x, f[5] * rs * gb.y); o.w = pk2(f[6] * rs * gb.z, f[7] * rs * gb.w);
        *(GAS u32x4*)p = o;
    }
    { const int c = tid & 7, r = tid >> 3;
      u32x4 kv[2][4]; f32x4 kga[2], kgb[2];
#pragma unroll
      for (int br = 0; br < 2; ++br) { const float* kg = A.in[11] + (1 + br) * 64 + c * 8; kga[br] = *(const GAS f32x4*)kg; kgb[br] = *(const GAS f32x4*)(kg + 4); }
#pragma unroll
      for (int br = 0; br < 2; ++br)
#pragma unroll
        for (int g = 0; g < 4; ++g) kv[br][g] = *(const GAS u32x4*)(Z + (tok0 + r) * ZW + (br ? ZC_KW : ZC_KS) + g * 64 + c * 8);
#pragma unroll
      for (int br = 0; br < 2; ++br)
#pragma unroll
        for (int g = 0; g < 4; ++g) {
            const u32x4 v = kv[br][g];
            float f[8] = {bflo(v.x), bfhi(v.x), bflo(v.y), bfhi(v.y), bflo(v.z), bfhi(v.z), bflo(v.w), bfhi(v.w)};
            float ss = 0.f;
#pragma unroll
            for (int j = 0; j < 8; ++j) ss += f[j] * f[j];
            ss += __shfl_xor(ss, 1); ss += __shfl_xor(ss, 2); ss += __shfl_xor(ss, 4);
            const float rs = rsqrtf(ss * (1.f / 64.f) + EPS);
            const f32x4 ga = kga[br], gb = kgb[br];
            u32x4 o; o.x = pk2(f[0] * rs * ga.x, f[1] * rs * ga.y); o.y = pk2(f[2] * rs * ga.z, f[3] * rs * ga.w); o.z = pk2(f[4] * rs * gb.x, f[5] * rs * gb.y); o.w = pk2(f[6] * rs * gb.z, f[7] * rs * gb.w);
            unsigned char* img = ws + WS_KIMG + (br ? KI_KW : KI_KS) + ((size_t)(b * 4 + g) * 32 + tl) * 8192;
            *(GAS u32x4*)(img + c * 1024 + r * 16) = o;
        }
    }
    { LAS bf16_t* vt = (LAS bf16_t*)F.lds;
      const int c = tid & 7, r = tid >> 3;
      u32x4 vv[8];
#pragma unroll
      for (int k = 0; k < 8; ++k) { const int br = k >> 2, g = k & 3; vv[k] = *(const GAS u32x4*)(Z + (tok0 + r) * ZW + (br ? ZC_VW : ZC_VS) + g * 64 + c * 8); }
      asm volatile("" : "+v"(vv[0]), "+v"(vv[1]), "+v"(vv[2]), "+v"(vv[3]), "+v"(vv[4]), "+v"(vv[5]), "+v"(vv[6]), "+v"(vv[7]));
#pragma unroll
      for (int k = 0; k < 8; ++k) *(LAS u32x4*)(vt + k * 4608 + r * 72 + c * 8) = vv[k];
      __syncthreads();
#pragma unroll
      for (int k = 0; k < 8; ++k) { const int br = k >> 2, g = k & 3;
          unsigned char* img = ws + WS_KIMG + (br ? KI_VW : KI_VS) + ((size_t)(b * 4 + g) * 32 + tl) * 8192;
#pragma unroll
          for (int hlf = 0; hlf < 2; ++hlf) { const int un = hlf * 512 + tid, kc = un >> 6, d = un & 63;
              const LAS bf16_t* s = vt + k * 4608 + (4 * kc) * 72 + d;
              u32x2 o; o.x = (unsigned)s[0] | ((unsigned)s[72] << 16); o.y = (unsigned)s[144] | ((unsigned)s[216] << 16);
              *(GAS u32x2*)(img + kc * 512 + d * 8) = o; } }
      __syncthreads(); }
}
__device__ __forceinline__ void compress_item(Frame& F, const Args& A, int item) {
    const int which = item & 1, cg = (item >> 1) & 7, g = (item >> 4) & 3, b = item >> 6;
    const int lane = F.lane, l15 = lane & 15, q = lane >> 4, c0 = cg * 16;
    unsigned char* ws = F.ws; const bf16_t* Z = (const bf16_t*)(ws + WS_Z);
    const bf16_t* WT = (const bf16_t*)(ws + WS_SMALL + (which ? SM_WCV : SM_WCK));
    const int zc = (which ? ZC_VC : ZC_KC) + g * 64;
    f32x4 acc[4];
#pragma unroll
    for (int nt = 0; nt < 4; ++nt) acc[nt] = (f32x4){0.f, 0.f, 0.f, 0.f};
    size_t tb = (size_t)b * SEQ + 16 * (c0 + l15);
#pragma unroll 1
    for (int s0 = 0; s0 < 64; s0 += 4) {
        bf16x8 xv[4], wv[4][4];
#pragma unroll
        for (int ss = 0; ss < 4; ++ss) { const int s = s0 + ss;
            size_t trow = tb + (s >> 1); if (trow > (size_t)b * SEQ + SEQ - 1) trow = (size_t)b * SEQ + SEQ - 1;
            xv[ss] = *(const GAS bf16x8*)(Z + trow * ZW + zc + 32 * (s & 1) + 8 * q);
#pragma unroll
            for (int nt = 0; nt < 4; ++nt) wv[ss][nt] = *(const GAS bf16x8*)(WT + (size_t)(16 * nt + l15) * DM + 32 * s + 8 * q); }
        asm volatile("" : "+v"(xv[0]), "+v"(xv[1]), "+v"(wv[0][0]), "+v"(wv[0][1]), "+v"(wv[0][2]), "+v"(wv[0][3]), "+v"(wv[1][0]), "+v"(wv[1][1]), "+v"(wv[1][2]), "+v"(wv[1][3]) :: "memory");
        asm volatile("" : "+v"(xv[2]), "+v"(xv[3]), "+v"(wv[2][0]), "+v"(wv[2][1]), "+v"(wv[2][2]), "+v"(wv[2][3]), "+v"(wv[3][0]), "+v"(wv[3][1]), "+v"(wv[3][2]), "+v"(wv[3][3]) :: "memory");
#pragma unroll
        for (int ss = 0; ss < 4; ++ss)
#pragma unroll
            for (int nt = 0; nt < 4; ++nt) {
                if (which == 0) acc[nt] = __builtin_amdgcn_mfma_f32_16x16x32_bf16(wv[ss][nt], xv[ss], acc[nt], 0, 0, 0);
                else            acc[nt] = __builtin_amdgcn_mfma_f32_16x16x32_bf16(xv[ss], wv[ss][nt], acc[nt], 0, 0, 0); }
    }
    if (which == 0) {
        const float* bias = (const float*)(ws + WS_SMALL + SM_BIASK);
        float ss = 0.f;
#pragma unroll
        for (int nt = 0; nt < 4; ++nt) { const f32x4 bv = *(const GAS f32x4*)(bias + 16 * nt + 4 * q); acc[nt] += bv; ss += (acc[nt].x * acc[nt].x + acc[nt].y * acc[nt].y) + (acc[nt].z * acc[nt].z + acc[nt].w * acc[nt].w); }
        ss += __shfl_xor(ss, 16); ss += __shfl_xor(ss, 32);
        const float rs = rsqrtf(ss * (1.f / 64.f) + EPS);
        const int c = c0 + l15, T = c >> 6, r = c & 63;
        unsigned char* img = ws + WS_KIMG + KI_KC + ((size_t)(b * 4 + g) * 2 + T) * 8192;
#pragma unroll
        for (int nt = 0; nt < 4; ++nt) { const f32x4 kg = *(const GAS f32x4*)(A.in[11] + 16 * nt + 4 * q);
            u32x2 o; o.x = pk2(acc[nt].x * rs * kg.x, acc[nt].y * rs * kg.y); o.y = pk2(acc[nt].z * rs * kg.z, acc[nt].w * rs * kg.w);
            if (c == 127) { o.x = 0u; o.y = 0u; }
            *(GAS u32x2*)(img + (2 * nt + (q >> 1)) * 1024 + r * 16 + (q & 1) * 8) = o; }
    } else {
        const float* bias = (const float*)(ws + WS_SMALL + SM_BIASV);
        const int cb = c0 + 4 * q, T = cb >> 6, kc = (cb & 63) >> 2;
        unsigned char* img = ws + WS_KIMG + KI_VC + ((size_t)(b * 4 + g) * 2 + T) * 8192;
#pragma unroll
        for (int nt = 0; nt < 4; ++nt) { const float bv = bias[16 * nt + l15];
            float v3 = acc[nt].w + bv; if (cb + 3 == 127) v3 = 0.f;
            u32x2 o; o.x = pk2(acc[nt].x + bv, acc[nt].y + bv); o.y = pk2(acc[nt].z + bv, v3);
            *(GAS u32x2*)(img + kc * 512 + (16 * nt + l15) * 8) = o; }
    }
}

constexpr int AT_SLOT = 16384, AT_IMP = 65536, AT_OT = 98304, AT_SEL = TILETAB_OFF, AT_SS = TILETAB_OFF + 256, AT_OST = 0;
__device__ __forceinline__ void at_stage(LAS unsigned char* lds, int slot, const unsigned char* kimg, const unsigned char* vimg, int wave, int lane) {
    __builtin_amdgcn_global_load_lds((const unsigned*)(kimg + wave * 1024 + lane * 16), (LAS unsigned*)(lds + slot * AT_SLOT + wave * 1024), 16, 0, 0);
    __builtin_amdgcn_global_load_lds((const unsigned*)(vimg + wave * 1024 + lane * 16), (LAS unsigned*)(lds + slot * AT_SLOT + 8192 + wave * 1024), 16, 0, 0);
}
__device__ __forceinline__ void at_qkt(f32x16& p0, f32x16& p1, const LAS unsigned char* ks, const bf16x8 (&qr)[4], const f32x16& cin, int r32, int hi) {
#pragma unroll
    for (int d0 = 0; d0 < 4; ++d0) {
        const bf16x8 k0 = *(const LAS bf16x8*)(ks + (2 * d0 + hi) * 1024 + r32 * 16), k1 = *(const LAS bf16x8*)(ks + (2 * d0 + hi) * 1024 + 512 + r32 * 16);
        if (d0 == 0) { p0 = __builtin_amdgcn_mfma_f32_32x32x16_bf16(k0, qr[0], cin, 0, 0, 0); p1 = __builtin_amdgcn_mfma_f32_32x32x16_bf16(k1, qr[0], cin, 0, 0, 0); }
        else { p0 = __builtin_amdgcn_mfma_f32_32x32x16_bf16(k0, qr[d0], p0, 0, 0, 0); p1 = __builtin_amdgcn_mfma_f32_32x32x16_bf16(k1, qr[d0], p1, 0, 0, 0); }
    }
}
__device__ __forceinline__ bf16x8 at_pack8(const f32x16& p, int base) {
    u32x4 w; w.x = cvt_pk_bf16(p[base], p[base + 1]); w.y = cvt_pk_bf16(p[base + 2], p[base + 3]); w.z = cvt_pk_bf16(p[base + 4], p[base + 5]); w.w = cvt_pk_bf16(p[base + 6], p[base + 7]);
    return __builtin_bit_cast(bf16x8, w);
}
__device__ __forceinline__ void at_pvp(f32x16 (&o)[2], bf16x8 pa0, bf16x8 pa1, bf16x8 pa2, bf16x8 pa3, const LAS unsigned char* vs, int r32, int hi) {
#pragma unroll
    for (int d0 = 0; d0 < 2; ++d0) {
        const LAS unsigned char* vb = vs + (32 * d0 + r32) * 8 + hi * 512;
#pragma unroll
        for (int s = 0; s < 4; ++s) {
            const s16x4 lo = *(const LAS s16x4*)(vb + (4 * s) * 512), h4 = *(const LAS s16x4*)(vb + (4 * s + 2) * 512);
            const bf16x8 vf = (bf16x8){lo[0], lo[1], lo[2], lo[3], h4[0], h4[1], h4[2], h4[3]};
            o[d0] = __builtin_amdgcn_mfma_f32_32x32x16_bf16(s == 0 ? pa0 : s == 1 ? pa1 : s == 2 ? pa2 : pa3, vf, o[d0], 0, 0, 0);
        }
    }
}
__device__ __forceinline__ void at_pv(f32x16 (&o)[2], const f32x16& p0, const f32x16& p1, const LAS unsigned char* vs, int r32, int hi) {
    at_pvp(o, at_pack8(p0, 0), at_pack8(p0, 8), at_pack8(p1, 0), at_pack8(p1, 8), vs, r32, hi);
}
__device__ __forceinline__ void at_tile(const LAS unsigned char* slot, const LAS unsigned char* ql, f32x16 (&o)[2], float& l, bool usekill, bool kill, bool masked, int kvlo, int kvhi, int r32, int hi) {
    bf16x8 kf[8];
#pragma unroll
    for (int d0 = 0; d0 < 4; ++d0) { kf[2 * d0] = *(const LAS bf16x8*)(slot + (2 * d0 + hi) * 1024 + r32 * 16); kf[2 * d0 + 1] = *(const LAS bf16x8*)(slot + (2 * d0 + hi) * 1024 + 512 + r32 * 16); }
    bf16x8 q4[4];
#pragma unroll
    for (int d0 = 0; d0 < 4; ++d0) q4[d0] = *(const LAS bf16x8*)(ql + d0 * 1024);
    const f32x16 zero16 = (f32x16){0.f, 0.f, 0.f, 0.f, 0.f, 0.f, 0.f, 0.f, 0.f, 0.f, 0.f, 0.f, 0.f, 0.f, 0.f, 0.f};
    f32x16 p0 = __builtin_amdgcn_mfma_f32_32x32x16_bf16(kf[0], q4[0], zero16, 0, 0, 0), p1 = __builtin_amdgcn_mfma_f32_32x32x16_bf16(kf[1], q4[0], zero16, 0, 0, 0);
#pragma unroll
    for (int d0 = 1; d0 < 4; ++d0) { p0 = __builtin_amdgcn_mfma_f32_32x32x16_bf16(kf[2 * d0], q4[d0], p0, 0, 0, 0); p1 = __builtin_amdgcn_mfma_f32_32x32x16_bf16(kf[2 * d0 + 1], q4[d0], p1, 0, 0, 0); }
    s16x4 vlo[2][4], vhi[2][4];
    const LAS unsigned char* vs = slot + 8192;
#pragma unroll
    for (int d0 = 0; d0 < 2; ++d0) { const LAS unsigned char* vb = vs + (32 * d0 + r32) * 8 + hi * 512;
#pragma unroll
        for (int s = 0; s < 4; ++s) { vlo[d0][s] = *(const LAS s16x4*)(vb + (4 * s) * 512); vhi[d0][s] = *(const LAS s16x4*)(vb + (4 * s + 2) * 512); } }
    if (masked) {
#pragma unroll
        for (int r = 0; r < 16; ++r) { const int kv = crow(r, hi);
            if (kv < kvlo || kv > kvhi) p0[r] = -INFINITY;
            if (kv + 32 < kvlo || kv + 32 > kvhi) p1[r] = -INFINITY; }
    }
    float s = 0.f;
#pragma unroll
    for (int r = 0; r < 16; ++r) { p0[r] = __builtin_amdgcn_exp2f(p0[r]); p1[r] = __builtin_amdgcn_exp2f(p1[r]); s += p0[r] + p1[r]; }
    u32x4 w0, w1, w2, w3;
    w0.x = cvt_pk_bf16(p0[0], p0[1]); w0.y = cvt_pk_bf16(p0[2], p0[3]); w0.z = cvt_pk_bf16(p0[4], p0[5]); w0.w = cvt_pk_bf16(p0[6], p0[7]);
    w1.x = cvt_pk_bf16(p0[8], p0[9]); w1.y = cvt_pk_bf16(p0[10], p0[11]); w1.z = cvt_pk_bf16(p0[12], p0[13]); w1.w = cvt_pk_bf16(p0[14], p0[15]);
    w2.x = cvt_pk_bf16(p1[0], p1[1]); w2.y = cvt_pk_bf16(p1[2], p1[3]); w2.z = cvt_pk_bf16(p1[4], p1[5]); w2.w = cvt_pk_bf16(p1[6], p1[7]);
    w3.x = cvt_pk_bf16(p1[8], p1[9]); w3.y = cvt_pk_bf16(p1[10], p1[11]); w3.z = cvt_pk_bf16(p1[12], p1[13]); w3.w = cvt_pk_bf16(p1[14], p1[15]);
    if (usekill) { const unsigned km = kill ? 0u : 0xffffffffu; s = kill ? 0.f : s;
        w0 = w0 & km; w1 = w1 & km; w2 = w2 & km; w3 = w3 & km; }
    l += s;
#pragma unroll
    for (int d0 = 0; d0 < 2; ++d0)
#pragma unroll
        for (int s4 = 0; s4 < 4; ++s4) { const bf16x8 vf = (bf16x8){vlo[d0][s4][0], vlo[d0][s4][1], vlo[d0][s4][2], vlo[d0][s4][3], vhi[d0][s4][0], vhi[d0][s4][1], vhi[d0][s4][2], vhi[d0][s4][3]};
            o[d0] = __builtin_amdgcn_mfma_f32_32x32x16_bf16(__builtin_bit_cast(bf16x8, s4 == 0 ? w0 : s4 == 1 ? w1 : s4 == 2 ? w2 : w3), vf, o[d0], 0, 0, 0); }
}

__device__ __forceinline__ void attn_unit(Frame& F, const Args& A, int b, int g, int qblk) {
    const int tid = F.tid, lane = F.lane, r32 = lane & 31, hi = lane >> 5, wid = F.wave, hh = wid >> 1, th = wid & 1, h = 4 * g + hh;
    unsigned char* ws = F.ws; const bf16_t* Z = (const bf16_t*)(ws + WS_Z);
    LAS unsigned char* lds = F.lds;
    const int qs = qblk * 64, tq = 32 * th + r32, t = qs + tq; const size_t tok = (size_t)b * SEQ + t;
    const unsigned char* kimg_c = ws + WS_KIMG + KI_KC + (size_t)(b * 4 + g) * 2 * 8192;
    const int j0 = (qblk >= 8) ? qblk - 8 : 0, total = (qblk + 1) + (qblk - j0 + 1);
#define AT_STAGE_IT(itx) do { int _i = (itx); if (_i > total - 1) _i = total - 1; const bool _br = _i > qblk; const int _j = _br ? j0 + (_i - qblk - 1) : _i; \
        const unsigned char* _ki = ws + WS_KIMG + (_br ? KI_KW : KI_KS) + ((size_t)(b * 4 + g) * 32 + _j) * 8192; at_stage(lds, ((itx) + 2) & 3, _ki, _ki + (KI_VS - KI_KS), wid, lane); } while (0)
    at_stage(lds, 0, kimg_c, kimg_c + (KI_VC - KI_KC), wid, lane); at_stage(lds, 1, kimg_c + 8192, kimg_c + 8192 + (KI_VC - KI_KC), wid, lane);
    AT_STAGE_IT(0); AT_STAGE_IT(1);
    bf16x8 qr[4];
#pragma unroll
    for (int d0 = 0; d0 < 4; ++d0) qr[d0] = *(const GAS bf16x8*)(Z + tok * ZW + h * 64 + 16 * d0 + 8 * hi);
    const bf16_t* glp = Z + tok * ZW + ZC_GL + h * 3;
    const float g0 = fast_sigmoid(bf2f(glp[0])), g1 = fast_sigmoid(bf2f(glp[1])), g2 = fast_sigmoid(bf2f(glp[2]));
    asm volatile("s_waitcnt vmcnt(0)" ::: "memory"); __builtin_amdgcn_s_barrier();
    {
        const int cmax = (t >= 31) ? ((t - 31) >> 4) : -1;
        f32x16 oc[2];
#pragma unroll
        for (int r = 0; r < 16; ++r) { oc[0][r] = 0.f; oc[1][r] = 0.f; }
        float l = 0.f, xprev = 0.f;
        LAS float* impw = (LAS float*)(lds + AT_IMP) + (size_t)(hh * 64 + tq) * 32;
#pragma unroll 1
        for (int T = 0; T < 2; ++T) {
            f32x16 p0, p1;
            { const f32x16 zero = (f32x16){0.f, 0.f, 0.f, 0.f, 0.f, 0.f, 0.f, 0.f, 0.f, 0.f, 0.f, 0.f, 0.f, 0.f, 0.f, 0.f}; at_qkt(p0, p1, lds + T * AT_SLOT, qr, zero, r32, hi); }
            float s = 0.f;
#pragma unroll
            for (int r = 0; r < 16; ++r) { const int c = 64 * T + crow(r, hi); if (c > cmax) p0[r] = -INFINITY; if (c + 32 > cmax) p1[r] = -INFINITY;
                p0[r] = __builtin_amdgcn_exp2f(p0[r]); p1[r] = __builtin_amdgcn_exp2f(p1[r]); s += p0[r] + p1[r]; }
            l += s;
#pragma unroll
            for (int u = 0; u < 2; ++u)
#pragma unroll
                for (int rr = 0; rr < 4; ++rr) {
                    const float a0 = u ? p1[4 * rr] : p0[4 * rr], a1 = u ? p1[4 * rr + 1] : p0[4 * rr + 1], a2 = u ? p1[4 * rr + 2] : p0[4 * rr + 2], a3 = u ? p1[4 * rr + 3] : p0[4 * rr + 3];
                    const float xc = __shfl_xor(a3, 32);
                    impw[2 * (8 * T + 4 * u + rr) + hi] = ((a0 + a1) + (a2 + a3)) + (hi ? xc : xprev);
                    xprev = xc;
                }
            at_pv(oc, p0, p1, lds + T * AT_SLOT + 8192, r32, hi);
        }
        l += __shfl_xor(l, 32);
        const float inv = (l > 0.f) ? 1.f / l : 0.f;
#pragma unroll
        for (int i = 0; i < 16; ++i) impw[2 * i + hi] *= inv;
        const float sc = g0 * inv;
        { LAS unsigned* otp = (LAS unsigned*)(lds + AT_OT + wid * 4096) + lane;
#pragma unroll
          for (int r = 0; r < 16; r += 2) { const float f0 = __shfl(sc, crow(r, hi)), f1 = __shfl(sc, crow(r + 1, hi));
              otp[(r >> 1) * 64] = cvt_pk_bf16(oc[0][r] * f0, oc[0][r + 1] * f1); otp[(8 + (r >> 1)) * 64] = cvt_pk_bf16(oc[1][r] * f0, oc[1][r + 1] * f1); } }
    }
    asm volatile("s_waitcnt lgkmcnt(0)" ::: "memory"); __builtin_amdgcn_s_barrier();
    AT_STAGE_IT(2);
    if (tid < 64) {
        const LAS float* ip = (const LAS float*)(lds + AT_IMP) + tid * 32;
        float v[32];
#pragma unroll
        for (int j = 0; j < 32; ++j) v[j] = ((ip[j] + ip[64 * 32 + j]) + ip[2 * 64 * 32 + j]) + ip[3 * 64 * 32 + j];
        unsigned mask;
        if (qblk < 8) mask = (2u << qblk) - 1u;
        else {
#pragma unroll
            for (int j = 0; j < 32; ++j) { const bool forced = (j == 0) || (j == qblk) || (j == qblk - 1); v[j] = forced ? 1e30f : ((j <= qblk) ? v[j] : -1e30f); }
            mask = 0u;
#pragma unroll 1
            for (int k = 0; k < 8; ++k) {
                float bv = -INFINITY; int bi = 0;
#pragma unroll
                for (int j = 0; j < 32; ++j) if (v[j] > bv) { bv = v[j]; bi = j; }
                mask |= 1u << bi;
#pragma unroll
                for (int j = 0; j < 32; ++j) if (j == bi) v[j] = -INFINITY;
            }
        }
        ((LAS unsigned*)(lds + AT_SEL))[tid] = mask;
    }
    asm volatile("s_waitcnt vmcnt(0) lgkmcnt(0)" ::: "memory"); __builtin_amdgcn_s_barrier();
    const unsigned selm = ((const LAS unsigned*)(lds + AT_SEL))[tq];
    const LAS unsigned char* ql = lds + AT_IMP + wid * 4096 + lane * 16;
#pragma unroll
    for (int d0 = 0; d0 < 4; ++d0) *(LAS bf16x8*)(lds + AT_IMP + wid * 4096 + d0 * 1024 + lane * 16) = qr[d0];
    asm volatile("s_waitcnt lgkmcnt(0)" ::: "memory");
    f32x16 o[2];
    {
#pragma unroll
        for (int r = 0; r < 16; ++r) { o[0][r] = 0.f; o[1][r] = 0.f; }
        float l = 0.f;
#pragma unroll 1
        for (int it = 0; it < total; ++it) {
            const int cur = (it + 2) & 3; const bool br = it > qblk; const int j = br ? j0 + (it - qblk - 1) : it;
            AT_STAGE_IT(it + 3);
            bool masked, kill; int kvlo, kvhi;
            if (!br) { masked = (j == qblk); kvlo = 0; kvhi = tq; kill = !((selm >> j) & 1u); }
            else { const bool first = (qblk >= 8) && (j == j0), lastt = (j == qblk); masked = first || lastt; kvlo = first ? tq + 1 : 0; kvhi = lastt ? tq : 63; kill = false; }
            at_tile(lds + cur * AT_SLOT, ql, o, l, !br, kill, masked, kvlo, kvhi, r32, hi);
            asm volatile("s_waitcnt vmcnt(4) lgkmcnt(0)" ::: "memory"); __builtin_amdgcn_s_barrier();
            if (it == qblk || it == total - 1) {
                l += __shfl_xor(l, 32);
                const float sc = (br ? g2 : g1) / l;
                LAS unsigned* otp = (LAS unsigned*)(lds + AT_OT + wid * 4096) + lane;
                if (!br) {
#pragma unroll
                    for (int r = 0; r < 16; r += 2) { const float f0 = __shfl(sc, crow(r, hi)), f1 = __shfl(sc, crow(r + 1, hi));
                        const unsigned a = otp[(r >> 1) * 64], c = otp[(8 + (r >> 1)) * 64];
                        otp[(r >> 1) * 64] = cvt_pk_bf16(bflo(a) + o[0][r] * f0, bfhi(a) + o[0][r + 1] * f1); otp[(8 + (r >> 1)) * 64] = cvt_pk_bf16(bflo(c) + o[1][r] * f0, bfhi(c) + o[1][r + 1] * f1);
                        o[0][r] = 0.f; o[0][r + 1] = 0.f; o[1][r] = 0.f; o[1][r + 1] = 0.f; }
                } else {
#pragma unroll
                    for (int r = 0; r < 16; r += 2) { const float f0 = __shfl(sc, crow(r, hi)), f1 = __shfl(sc, crow(r + 1, hi));
                        const unsigned a = otp[(r >> 1) * 64], c = otp[(8 + (r >> 1)) * 64];
                        o[0][r] = bflo(a) + o[0][r] * f0; o[0][r + 1] = bfhi(a) + o[0][r + 1] * f1; o[1][r] = bflo(c) + o[1][r] * f0; o[1][r + 1] = bfhi(c) + o[1][r + 1] * f1; }
                }
                l = 0.f;
            }
        }
    }
    asm volatile("s_waitcnt vmcnt(0)" ::: "memory"); __builtin_amdgcn_s_barrier();
#undef AT_STAGE_IT
    {
        LAS bf16_t* stg = (LAS bf16_t*)(lds + AT_OST + wid * 4096);
#pragma unroll
        for (int r = 0; r < 16; ++r) { const int orow = crow(r, hi); stg[orow * 64 + r32] = (bf16_t)f2bf(o[0][r]); stg[orow * 64 + 32 + r32] = (bf16_t)f2bf(o[1][r]); }
        asm volatile("s_waitcnt lgkmcnt(0)" ::: "memory");
        bf16_t* A2 = (bf16_t*)(ws + WS_A2);
        const int ch = lane & 7;
        const f32x4 ga = *(const GAS f32x4*)(A.in[19] + h * 64 + ch * 8), gb = *(const GAS f32x4*)(A.in[19] + h * 64 + ch * 8 + 4);
        LAS float* ssl = (LAS float*)(lds + AT_SS);
#pragma unroll
        for (int i = 0; i < 4; ++i) { const int row = i * 8 + (lane >> 3);
            const u32x4 v = *(const LAS u32x4*)(stg + row * 64 + ch * 8);
            const float f[8] = {bflo(v.x), bfhi(v.x), bflo(v.y), bfhi(v.y), bflo(v.z), bfhi(v.z), bflo(v.w), bfhi(v.w)};
            float ss = 0.f;
#pragma unroll
            for (int j = 0; j < 8; ++j) ss += f[j] * f[j];
            ss += __shfl_xor(ss, 1); ss += __shfl_xor(ss, 2); ss += __shfl_xor(ss, 4);
            if (ch == 0) ssl[hh * 64 + 32 * th + row] = ss;
            u32x4 o; o.x = pk2(f[0] * ga.x, f[1] * ga.y); o.y = pk2(f[2] * ga.z, f[3] * ga.w); o.z = pk2(f[4] * gb.x, f[5] * gb.y); o.w = pk2(f[6] * gb.z, f[7] * gb.w);
            *(GAS u32x4*)(A2 + ((size_t)b * SEQ + qs + 32 * th + row) * DM + h * 64 + ch * 8) = o; }
        asm volatile("s_waitcnt lgkmcnt(0)" ::: "memory"); __builtin_amdgcn_s_barrier();
        if (tid < 64) ((float*)(ws + WS_SSN))[((size_t)b * SEQ + qs + tid) * 4 + g] = ((ssl[tid] + ssl[64 + tid]) + ssl[128 + tid]) + ssl[192 + tid];
        asm volatile("s_waitcnt lgkmcnt(0)" ::: "memory"); __builtin_amdgcn_s_barrier();
    }
}
constexpr bool W2_LATE = false;
constexpr int NCX = 10, JOIN_PH = 4, CONV_SPLIT = 3072;
__global__ void __launch_bounds__(NWAVES * 64, 2) mega(Args args) {
    extern __shared__ __attribute__((aligned(16))) unsigned char lds_raw[];
    Frame F;
    F.lds = (LAS unsigned char*)lds_raw;
    F.tid = threadIdx.x; F.lane = F.tid & 63; F.wave = __builtin_amdgcn_readfirstlane(F.tid >> 6);
    F.ws = args.ws; F.ctl = (gu32*)(args.ws + WS_CTL);
    unsigned char* ws = args.ws;
    for (int u = F.tid; u < (LDS_BYTES - LDSCTL_OFF) / 4; u += NWAVES * 64) ((LAS unsigned*)(F.lds + LDSCTL_OFF))[u] = 0u;
    __syncthreads();
    volatile LAS unsigned* MISC = (volatile LAS unsigned*)(F.lds + MISC_OFF);
    const int lo = args.ph_lo, hi = args.ph_hi;
    const int G0 = gridDim.x, bx0 = blockIdx.x;
    const int vcu0 = (G0 % 8 == 0) ? (bx0 % 8) * (G0 / 8) + bx0 / 8 : bx0;
    const bool part = (G0 == 256) && lo < JOIN_PH && hi > JOIN_PH;
    const int xl = vcu0 & 31, xx = vcu0 >> 5;
    const bool is_conv = part && xl >= 32 - NCX;
    const int GB = part ? G0 - 8 * NCX : G0, vcuB = part ? xx * (32 - NCX) + xl : vcu0, bxB = part ? xl * 8 + xx : bx0;
    const int cv = (xl - (32 - NCX)) * 8 + xx;
    const bool w2_late = W2_LATE && (G0 == 256) && lo == 0 && hi > 5;
    const bool conv5 = w2_late && xl >= 32 - NCX;
    XcdBarrier bar = xcd_barrier_post((unsigned*)(F.ctl + CW_BAR) + args.li * XCD_BAR_WORDS, MISC + 8, (unsigned)G0, true);
    XcdBarrier barB = xcd_barrier_post((unsigned*)(F.ctl + CW_BAR) + (8 + args.li) * XCD_BAR_WORDS, MISC + 10, (unsigned)GB, part && !is_conv);
#define IN(k) (lo <= (k) && (k) < hi)
#define BOTH(k) (IN(k) && IN((k) + 1))
#define GRID_BAR(k) do { if (part && (k) + 1 < JOIN_PH) xcd_barrier(barB); else xcd_barrier(bar); } while (0)
#define SET_ID(k) do { const bool sub_ = part && (k) < JOIN_PH; F.G = sub_ ? GB : G0; F.vcu = sub_ ? vcuB : vcu0; F.bx = sub_ ? bxB : bx0; gw = F.vcu * NWAVES + F.wave; NGW = F.G * NWAVES; gw2 = F.wave * F.G + F.vcu; } while (0)
    int gw, NGW, gw2;
    SET_ID(lo);
    const float* mod = (const float*)(ws + WS_MOD);

    if (IN(0)) {
        p0_experts(F, args, is_conv ? cv : F.vcu, is_conv ? 8 * NCX : F.G, is_conv ? CONV_SPLIT : 0, (part && !is_conv) ? CONV_SPLIT : (w2_late ? CONV_NIT1 : CONV_NIT));
        if (!is_conv) p0_prologue(F, args);
        if (!is_conv && BOTH(0)) GRID_BAR(0);
    }
    if (is_conv) { xcd_barrier(bar); }
    const bool skip_pre = is_conv;
    if (IN(1) && !(skip_pre && 1 < JOIN_PH)) {
        const float* modp = (const float*)(ws + WS_MODPART); float* modw = (float*)(ws + WS_MOD);
        if (F.bx == 0 && F.wave < 2) pebias_reduce((const float*)(ws + WS_PEPART) + F.wave * 2048, (float*)(ws + WS_SMALL + (F.wave ? SM_BIASV : SM_BIASK)), F.lane);
        for (int idx = F.bx * (NWAVES * 64) + F.tid; idx < NB * 6 * DM; idx += F.G * NWAVES * 64) modw[idx] = mod_reduce1(modp, args.in[3], idx);
        LAS float* lmod = (LAS float*)F.lds;
        const int rpb = ((NTOK + F.G - 1) / F.G + 7) & ~7, r0 = F.bx * rpb, r1 = (r0 + rpb < NTOK) ? r0 + rpb : NTOK;
        int curb = -1;
        f32x4 g1v[8];
#pragma unroll
        for (int j = 0; j < 8; ++j) g1v[j] = *((const GAS f32x4*)args.in[4] + F.lane + 64 * j);
        for (int rb = r0; rb < r1; rb += 8) {
            const int b = rb / SEQ;
            if (b != curb) { __syncthreads(); for (int i = F.tid; i < 2 * DM; i += NWAVES * 64) lmod[i] = mod_reduce1(modp, args.in[3], b * 6 * DM + i); curb = b; __syncthreads(); }
            const int row = rb + F.wave;
            if (row < r1) {
                const GAS f32x4* xr = (const GAS f32x4*)(args.in[0] + (size_t)row * DM) + F.lane;
                f32x4 v[8]; float s = 0.f;
#pragma unroll
                for (int j = 0; j < 8; ++j) { v[j] = xr[64 * j]; s += (v[j].x * v[j].x + v[j].y * v[j].y) + (v[j].z * v[j].z + v[j].w * v[j].w); }
                const float rstd = rsqrtf(wsum(s) * (1.f / DM) + EPS);
                GAS unsigned long long* o8 = (GAS unsigned long long*)((bf16_t*)(ws + WS_H) + (size_t)row * DM) + F.lane;
#pragma unroll
                for (int j = 0; j < 8; ++j) {
                    const f32x4 gg = g1v[j], sh = *((const LAS f32x4*)lmod + F.lane + 64 * j), sc = *((const LAS f32x4*)(lmod + DM) + F.lane + 64 * j);
                    const f32x4 hv = v[j] * rstd * gg * (sc + 1.f) + sh;
                    o8[64 * j] = (unsigned long long)pk2(hv.x, hv.y) | ((unsigned long long)pk2(hv.z, hv.w) << 32);
                }
            }
        }
        __syncthreads();
        if (BOTH(1)) GRID_BAR(1);
    }
    if (IN(2)) SET_ID(2);
    if (IN(2) && !(skip_pre && 2 < JOIN_PH)) {
        ProbZ P; P.ord.init(NTOK, ZW, F.G, F.bx); P.A = (const bf16_t*)(ws + WS_H); P.Bt = (const bf16_t*)(ws + WS_WIN); P.Z = (bf16_t*)(ws + WS_Z);
        g8::gemm_phase<ProbZ>(F.lds, P);
        if (BOTH(2)) GRID_BAR(2);
    }
    if (IN(3)) SET_ID(3);
    if (IN(3) && !(skip_pre && 3 < JOIN_PH)) {
        for (int it = F.bx; it < NB * 32; it += F.G) prep_item(F, args, it);
        for (int it = gw2; it < NB * 4 * 8 * 2; it += NGW) compress_item(F, args, it);
        for (int it = gw; it < NB * 32 * 16; it += NGW) lru_item<false>(F, args, it);
        if (BOTH(3)) GRID_BAR(3);
    }
    if (IN(4)) SET_ID(4);
    if (IN(4)) {
        {
            const bool bal = (F.G == 256); const int nu = bal ? 4 : (NB * 4 * 32 + F.G - 1 - F.bx) / F.G;
#pragma unroll 1
            for (int i = 0; i < nu; ++i) {
                int bg, qb;
                if (bal) { const int s = F.vcu & 7; bg = F.vcu >> 3; qb = (i == 0) ? 31 - s : (i == 1) ? 16 + s : (i == 2) ? 15 - s : s; }
                else { const int u = F.bx + i * F.G; bg = u & 31; qb = 31 - (u >> 5); }
                attn_unit(F, args, bg >> 2, bg & 3, qb);
            }
        }
        for (int it = gw; it < NB * 32 * 16; it += NGW) lru_item<true>(F, args, it);
        if (BOTH(4)) GRID_BAR(4);
    }
    if (IN(5) && conv5) { p0_experts(F, args, cv, 8 * NCX, CONV_NIT1, CONV_NIT); if (BOTH(5)) GRID_BAR(5); }
    if (IN(5) && !conv5) {
        if (w2_late) { F.G = GB; F.vcu = vcuB; F.bx = bxB; }
        ProbMix P; P.ord.init(NTOK, DM, F.G, F.bx); P.A = (const bf16_t*)(ws + WS_A2); P.Bt = (const bf16_t*)(ws + WS_WOUT); P.x = args.in[0]; P.mod = mod; P.x1b = (bf16_t*)(ws + WS_X1B);
        P.rs = (const LAS float*)(F.lds + RSTAB_OFF);
        p5_build_rstab(F, P.ord, (const float*)(ws + WS_SSN), (const float*)(ws + WS_SSL));
        g8::gemm_phase<ProbMix>(F.lds, P);
        if (BOTH(5)) GRID_BAR(5);
    }
    if (IN(6)) SET_ID(6);
    if (IN(6)) { p6_route(F, args, mod); if (BOTH(6)) GRID_BAR(6); }
    if (IN(7)) {
        build_tile_table(F);
        ProbM1F P; P.ord.tab = (const LAS int*)(F.lds + TILETAB_OFF); P.ord.G = F.G; P.ord.c = F.bx; P.ord.NPN = 16;
        P.H8 = ws + WS_H8; P.W1T8 = ws + WS_W1; P.b1 = args.in[26]; P.rowtok = (const int*)(ws + WS_ROUTE + RT_ROWTOK); P.ACT8 = ws + WS_ACT;
        g8::gemm8_phase<ProbM1F>(F.lds, P);
        if (BOTH(7)) GRID_BAR(7);
    }
    if (IN(8)) {
        build_tile_table(F);
        ProbM2F P; P.ord.tab = (const LAS int*)(F.lds + TILETAB_OFF); P.ord.G = F.G; P.ord.c = F.bx; P.ord.NPN = 8;
        P.ACT8 = ws + WS_ACT; P.W2T8 = ws + WS_W2; P.b2 = args.in[28]; P.rowg = (const float*)(ws + WS_ROUTE + RT_ROWG); P.Y8 = ws + WS_Y;
        g8::gemm8_phase<ProbM2F>(F.lds, P);
        if (BOTH(8)) GRID_BAR(8);
    }
    if (IN(9)) { build_tile_table(F); p9_combine(F, args, mod); }
#undef IN
#undef BOTH
#undef GRID_BAR
#undef SET_ID
}

extern "C" void kernel_launch(void* const* d_in, const int* in_sizes, int n_in, void* d_out, int out_size, void* d_ws, size_t ws_size, hipStream_t stream) {
    float* out = (float*)d_out;
    static int grid = 0;
    if (grid == 0) {
        int dev = 0, cus = 0;
        (void)hipGetDevice(&dev); (void)hipDeviceGetAttribute(&cus, hipDeviceAttributeMultiprocessorCount, dev);
        (void)hipFuncSetAttribute((const void*)mega, hipFuncAttributeMaxDynamicSharedMemorySize, LDS_BYTES);
        int per_cu = 0;
        (void)hipOccupancyMaxActiveBlocksPerMultiprocessor(&per_cu, (const void*)mega, NWAVES * 64, LDS_BYTES);
        (void)hipGetLastError();
        grid = (cus > 0 ? cus : 256) * (per_cu >= 1 ? 1 : 1);
    }
    char* ws = (char*)d_ws;
    (void)ws_size; (void)in_sizes; (void)n_in; (void)out_size;

    (void)hipMemsetAsync(ws + WS_CTL, 0, CTL_ZERO_BYTES, stream);
    Args a{};
    for (int i = 0; i < 29; ++i) a.in[i] = (const float*)d_in[i];
    a.out = out; a.ws = (unsigned char*)d_ws; a.ph_lo = 0; a.ph_hi = 10; a.li = 0; a.pad = 0;
    hipLaunchKernelGGL(mega, dim3(grid), dim3(NWAVES * 64), LDS_BYTES, stream, a);
}
```

```cpp
#include <hip/hip_runtime.h>
#include <stdint.h>
#include <math.h>

constexpr int DM = 2048, NB = 8, SEQ = 2048, NTOK = NB * SEQ;
constexpr int INW = 4656;
constexpr int NE = 32, TOPK = 4, NSLOT = NTOK * TOPK;
constexpr float EPS = 1e-6f;
#define LAS __attribute__((address_space(3)))
#define GAS __attribute__((address_space(1)))
typedef unsigned short bf16_t;
typedef short bf16x8 __attribute__((ext_vector_type(8)));
typedef short s16x4 __attribute__((ext_vector_type(4)));
typedef float f32x4 __attribute__((ext_vector_type(4)));
typedef float f32x16 __attribute__((ext_vector_type(16)));
typedef float f32x2 __attribute__((ext_vector_type(2)));
typedef unsigned u32x4 __attribute__((ext_vector_type(4)));
typedef unsigned u32x2 __attribute__((ext_vector_type(2)));
typedef GAS unsigned gu32;

constexpr int ZW = 4864;
constexpr int ZC_Q = 0, ZC_KC = 1024, ZC_VC = 1280, ZC_KS = 1536, ZC_VS = 1792, ZC_KW = 2048, ZC_VW = 2304, ZC_XR = 2560, ZC_XG = 3584, ZC_GL = 4608;
constexpr int PMAXT = 288, PMAXROWS = PMAXT * 256;

constexpr size_t MiB = 1u << 20;
constexpr size_t WS_CTL = 0, CTL_ZERO_BYTES = 1 * MiB;
constexpr int CW_TMO = 0, CW_CNT = 1024, CW_BAR = 4096;
constexpr size_t CTL_MOD_B = 256 * 1024;
constexpr size_t CTL_ROWSS_B = 640 * 1024;
constexpr size_t WS_WIN = 2 * MiB, WS_WOUT = 22 * MiB, WS_SMALL = 30 * MiB, WS_W1 = 32 * MiB, WS_W2 = 544 * MiB;
constexpr size_t SM_WR = 0, SM_WCK = 128 * 1024, SM_WCV = 384 * 1024, SM_WRG = 640 * 1024, SM_WIG = 768 * 1024, SM_BIASK = 896 * 1024, SM_BIASV = 897 * 1024;
constexpr float A2_SCALE = 16.f;
constexpr size_t WS_X1B = 864 * MiB;
constexpr size_t WS_MODPART = 1700 * MiB, WS_MOD = 1707 * MiB, WS_SSN = 1708 * MiB, WS_SSL = 1709 * MiB, WS_PEPART = 1710 * MiB;
constexpr size_t WS_H8 = 288 * MiB;
constexpr size_t WS_H = 800 * MiB, WS_Z = 864 * MiB, WS_KIMG = 1016 * MiB, WS_LRUS = 1050 * MiB, WS_A2 = 1052 * MiB, WS_ROUTE = 1116 * MiB, WS_ACT = 1122 * MiB, WS_Y = 1410 * MiB, WS_FAST_END = 1710 * MiB;
constexpr size_t KI_KS = 0, KI_KW = 8 * MiB, KI_VS = 16 * MiB, KI_VW = 24 * MiB, KI_KC = 32 * MiB, KI_VC = 32 * MiB + 512 * 1024;
constexpr size_t RT_ROWTOK = 0, RT_ROWG = 2 * MiB, RT_TOKSLOT = 4 * MiB;

constexpr int RING_BYTES = 131072, LDSCTL_OFF = RING_BYTES, MISC_OFF = LDSCTL_OFF + 320, TILETAB_OFF = LDSCTL_OFF + 1024, LDS_BYTES = 163840;
constexpr int NWAVES = 8;

#define RLX_AGENT __ATOMIC_RELAXED, __HIP_MEMORY_SCOPE_AGENT
#define LDS_WAIT() asm volatile("s_waitcnt lgkmcnt(0)" ::: "memory")
#define VM_WAIT() asm volatile("s_waitcnt vmcnt(0)" ::: "memory")
__device__ __forceinline__ unsigned f2bf(float f) { unsigned u = __builtin_bit_cast(unsigned, f); return (u + 0x7fffu + ((u >> 16) & 1u)) >> 16; }
__device__ __forceinline__ unsigned pk2(float lo, float hi) { return f2bf(lo) | (f2bf(hi) << 16); }
__device__ __forceinline__ float bf2f(unsigned short b) { return __builtin_bit_cast(float, (unsigned)b << 16); }
__device__ __forceinline__ float bflo(unsigned w) { return __builtin_bit_cast(float, w << 16); }
__device__ __forceinline__ float bfhi(unsigned w) { return __builtin_bit_cast(float, w & 0xffff0000u); }
__device__ __forceinline__ unsigned cvt_pk_bf16(float lo, float hi) { unsigned r; asm volatile("v_cvt_pk_bf16_f32 %0, %1, %2" : "=v"(r) : "v"(lo), "v"(hi)); return r; }

__device__ __forceinline__ float clamp448(float v) { return fminf(fmaxf(v, -448.f), 448.f); }
__device__ __forceinline__ unsigned pk4_fp8(float a, float b, float c, float d);
__device__ __forceinline__ unsigned pk4_fp8c(float a, float b, float c, float d) { return pk4_fp8(clamp448(a), clamp448(b), clamp448(c), clamp448(d)); }
__device__ __forceinline__ unsigned pk4_fp8(float a, float b, float c, float d) {
    unsigned w = 0u; w = __builtin_amdgcn_cvt_pk_fp8_f32(a, b, w, false); w = __builtin_amdgcn_cvt_pk_fp8_f32(c, d, w, true); return w; }

#define XB_TMO      128
#define XB_XCNT(j)  (256  + 64 * (j))
#define XB_XSUB(j)  (1280 + 64 * (j))
#define XB_XGEN(j)  (2304 + 64 * (j))
#define XB_TOP      3328
#define XB_TOPGEN   3392
#define XCD_BAR_WORDS 3456
#define XB_SPIN_CAP (1u << 18)
__device__ __forceinline__ unsigned xb_ld(unsigned* p)              { return __hip_atomic_load(p, __ATOMIC_RELAXED, __HIP_MEMORY_SCOPE_AGENT); }
__device__ __forceinline__ unsigned xb_add(unsigned* p, unsigned v) { return __hip_atomic_fetch_add(p, v, __ATOMIC_RELAXED, __HIP_MEMORY_SCOPE_AGENT); }
__device__ __forceinline__ unsigned xb_xcc_id() { return (unsigned)__builtin_amdgcn_s_getreg((3 << 11) | 20) & 0xFu; }
#define XB_SPIN(cond, bar) do { unsigned _sp = 0; while (cond) { __builtin_amdgcn_s_sleep(1); \
    if ((++_sp & 255u) == 0u) { if (xb_ld(&(bar)[XB_TMO])) break; if (_sp > XB_SPIN_CAP) { atomicAdd(&(bar)[XB_TMO], 1u); break; } } } } while (0)
struct XcdBarrier { unsigned* bar; unsigned x; volatile LAS unsigned* st; unsigned total; };
__device__ __forceinline__ XcdBarrier xcd_barrier_post(unsigned* bar, volatile LAS unsigned* st, unsigned total, bool member) {
    XcdBarrier b; b.bar = bar; b.x = xb_xcc_id(); b.st = st; b.total = total;
    if (member && threadIdx.x == 0) (void)xb_add(&bar[XB_XCNT(b.x)], 1u);
    return b;
}
__device__ __forceinline__ void xcd_barrier_complete(unsigned* bar, unsigned x, unsigned G, unsigned& nloc, unsigned& nx) {
    unsigned sum, cnt, mine, sp = 0u;
    for (;;) {
        sum = 0u; cnt = 0u; mine = 0u;
#pragma unroll
        for (unsigned j = 0; j < 16; ++j) { const unsigned c = xb_ld(&bar[XB_XCNT(j)]); sum += c; cnt += (c > 0u) ? 1u : 0u; mine = (j == x) ? c : mine; }
        if (sum == G) break;
        __builtin_amdgcn_s_sleep(1);
        if ((++sp & 255u) == 0u) { if (xb_ld(&bar[XB_TMO])) break; if (sp > XB_SPIN_CAP) { atomicAdd(&bar[XB_TMO], 1u); break; } }
    }
    nloc = mine > 0u ? mine : 1u; nx = cnt > 0u ? cnt : 1u;
}
__device__ __forceinline__ void xcd_barrier(const XcdBarrier& b) {
    asm volatile("s_waitcnt vmcnt(0)" ::: "memory");
    __syncthreads();
    if (threadIdx.x == 0) {
        unsigned* bar = b.bar;
        __builtin_amdgcn_s_waitcnt(0);
        unsigned nloc = b.st[0], nx = b.st[1];
        if (nloc == 0u) { xcd_barrier_complete(bar, b.x, b.total, nloc, nx); b.st[0] = nloc; b.st[1] = nx; }
        const unsigned old = xb_add(&bar[XB_XSUB(b.x)], 1u);
        const unsigned gen = old / nloc;
        if (old + 1u == (gen + 1u) * nloc) {
            __builtin_amdgcn_fence(__ATOMIC_RELEASE, "agent");
            asm volatile("s_waitcnt vmcnt(0)" ::: "memory");
            const unsigned og = xb_add(&bar[XB_TOP], 1u);
            const unsigned tg = og / nx;
            if (og + 1u == (tg + 1u) * nx) xb_add(&bar[XB_TOPGEN], 1u);
            else XB_SPIN(xb_ld(&bar[XB_TOPGEN]) == tg, bar);
            __builtin_amdgcn_fence(__ATOMIC_ACQUIRE, "agent");
            xb_add(&bar[XB_XGEN(b.x)], 1u);
            asm volatile("s_waitcnt vmcnt(0)" ::: "memory");
        } else {
            XB_SPIN(xb_ld(&bar[XB_XGEN(b.x)]) == gen, bar);
            __builtin_amdgcn_fence(__ATOMIC_ACQUIRE, "agent");
            asm volatile("s_waitcnt vmcnt(0)" ::: "memory");
        }
    }
    __syncthreads();
}

namespace g8 {
constexpr int BM = 256, BK = 64, HALF = 128, HTB = HALF * BK * 2, STAGE_BYTES = 8 * HTB;
__host__ __device__ __forceinline__ int lds_byte(int r, int c) { const int st = (r >> 4) * 2 + (c >> 5), rr = r & 15, cc = c & 31, ob = rr * 64 + cc * 2; return st * 1024 + (ob ^ (((ob >> 9) & 1) << 5)); }
__host__ __device__ __forceinline__ void stage_rc(int b, int& R, int& C) { const int st = b / 1024, sb = b % 1024, swz = sb ^ (((sb >> 9) & 1) << 5); R = (st >> 1) * 16 + swz / 64; C = (st & 1) * 32 + (swz % 64) / 2; }
__host__ __device__ __forceinline__ int perm32(int rho) { const int n = rho >> 4, i = rho & 15; return 8 * (i >> 2) + 4 * n + (i & 3); }
struct Unit { int pm, pn, e, row0, p0; };
typedef f32x4 Acc[2][2][4][2];

template <class P>
__device__ __forceinline__ void gemm_phase(LAS unsigned char* lds, const P& S) {
    const int tid = threadIdx.x, wid = __builtin_amdgcn_readfirstlane(tid >> 6), lane = tid & 63, wr = wid >> 2, wc = wid & 3, fr = lane & 15, fq = lane >> 4;
    constexpr int K = P::K, nt = K / BK;
    int R0, C0, R1, C1; stage_rc(tid * 16, R0, C0); stage_rc(tid * 16 + 8192, R1, C1);
    const int Rb0 = P::PERM ? ((R0 & ~31) + perm32(R0 & 31)) : R0, Rb1 = P::PERM ? ((R1 & ~31) + perm32(R1 & 31)) : R1;
    const unsigned voffB0 = (unsigned)(Rb0 * K + C0) * 2u, voffB1 = (unsigned)(Rb1 * K + C1) * 2u;
    constexpr size_t kstep = (size_t)(BK * 2);
    constexpr unsigned hstep = (unsigned)HALF * K * 2u;
    const unsigned ldsw = (unsigned)wid * 1024u;
    const int aoff = lds_byte(wr * 64 + fr, fq * 8), boff = lds_byte(wc * 32 + fr, fq * 8);
#define G8_SA(b, h) (((b) * 2 + (h)) * HTB)
#define G8_SB(b, h) ((4 + (b) * 2 + (h)) * HTB)
#define G8_STAGE(bufoff, gbase, o0, o1) do { \
        __builtin_amdgcn_global_load_lds((const unsigned*)((const char*)(gbase) + (o0)), (LAS unsigned*)(lds + (bufoff) + ldsw), 16, 0, 0); \
        __builtin_amdgcn_global_load_lds((const unsigned*)((const char*)(gbase) + (o1)), (LAS unsigned*)(lds + (bufoff) + ldsw + 8192), 16, 0, 0); } while (0)
#define G8_STAGEB(bufoff, gbase, h) G8_STAGE(bufoff, gbase, voffB0 + (h) * hstep, voffB1 + (h) * hstep)
#define G8_LDA(dst, b, h) do { _Pragma("unroll") for (int m = 0; m < 4; ++m) _Pragma("unroll") for (int k = 0; k < 2; ++k) dst[m][k] = *(const LAS bf16x8*)(lds + G8_SA(b, h) + aoff + m * 2048 + k * 1024); } while (0)
#define G8_LDB(dst, b, h) do { _Pragma("unroll") for (int n = 0; n < 2; ++n) _Pragma("unroll") for (int k = 0; k < 2; ++k) dst[n][k] = *(const LAS bf16x8*)(lds + G8_SB(b, h) + boff + n * 2048 + k * 1024); } while (0)
#define G8_MMA(ai, bj, At, Bt) do { __builtin_amdgcn_s_setprio(1); _Pragma("unroll") for (int m = 0; m < 4; ++m) _Pragma("unroll") for (int n = 0; n < 2; ++n) _Pragma("unroll") for (int k = 0; k < 2; ++k) \
        acc[ai][bj][m][n] = __builtin_amdgcn_mfma_f32_16x16x32_bf16(Bt[n][k], At[m][k], acc[ai][bj][m][n], 0, 0, 0); __builtin_amdgcn_s_setprio(0); } while (0)
#define G8_WAIT_V(n) asm volatile("s_waitcnt vmcnt(" #n ")" ::: "memory")
#define G8_WAIT_L(n) asm volatile("s_waitcnt lgkmcnt(" #n ")" ::: "memory")
#define G8_BAR __builtin_amdgcn_s_barrier()
#define G8_SCHED __builtin_amdgcn_sched_barrier(0)
    Unit cur, nxt; int ui = 0;
    if (!S.next(0, cur)) return;
    Acc acc;
#pragma unroll
    for (int a = 0; a < 2; ++a)
#pragma unroll
        for (int b = 0; b < 2; ++b)
#pragma unroll
            for (int m = 0; m < 4; ++m)
#pragma unroll
                for (int n = 0; n < 2; ++n) acc[a][b][m][n] = (f32x4){0.f, 0.f, 0.f, 0.f};
    bf16x8 At[4][2], B0[2][2], B1[2][2];
    unsigned c00, c01, c10, c11, n00, n01, n10, n11;
    S.a_voff(cur, R0, C0, R1, C1, c00, c01, c10, c11);
    n00 = c00; n01 = c01; n10 = c10; n11 = c11;
    const char* cA = S.a_base(cur); const char* cB = S.b_base(cur);
    G8_STAGEB(G8_SB(0, 0), cB, 0); G8_STAGEB(G8_SB(0, 1), cB, 1); G8_STAGE(G8_SA(0, 0), cA, c00, c01); G8_STAGE(G8_SA(0, 1), cA, c10, c11);
    if (wr == 1) G8_BAR;
    G8_WAIT_V(2); G8_BAR;
    G8_STAGEB(G8_SB(1, 0), cB + kstep, 0); G8_STAGE(G8_SA(1, 0), cA + kstep, c00, c01); G8_STAGEB(G8_SB(1, 1), cB + kstep, 1);
    G8_WAIT_V(6); G8_BAR;
    for (;;) {
        const bool has_next = S.next(ui + 1, nxt);
        const char* nA = has_next ? S.a_base(nxt) : cA; const char* nB = has_next ? S.b_base(nxt) : cB;
        if (P::GATHER) { if (has_next) S.a_voff(nxt, R0, C0, R1, C1, n00, n01, n10, n11); else { n00 = c00; n01 = c01; n10 = c10; n11 = c11; } }
        for (int t = 0; t < nt; t += 2) {
            const bool last = (t == nt - 2);
            if (P::MIDK) { if (t == nt / 2) S.midk(acc, cur, wr, fr); }
            const char* a1 = cA + (size_t)(t + 1) * kstep;
            const char* a2 = last ? nA : cA + (size_t)(t + 2) * kstep; const char* b2 = last ? nB : cB + (size_t)(t + 2) * kstep;
            const char* a3 = a2 + kstep; const char* b3 = b2 + kstep;
            const unsigned x00 = (P::GATHER && last) ? n00 : c00, x01 = (P::GATHER && last) ? n01 : c01, x10 = (P::GATHER && last) ? n10 : c10, x11 = (P::GATHER && last) ? n11 : c11;
            G8_LDB(B0, 0, 0); G8_LDB(B1, 0, 1); G8_SCHED; G8_LDA(At, 0, 0); G8_STAGE(G8_SA(1, 1), a1, c10, c11);
            G8_WAIT_V(8); G8_WAIT_L(0); G8_BAR; G8_MMA(0, 0, At, B0); G8_MMA(0, 1, At, B1); G8_BAR; G8_SCHED;
            G8_LDA(At, 0, 1); G8_STAGEB(G8_SB(0, 0), b2, 0); G8_STAGEB(G8_SB(0, 1), b2, 1); G8_STAGE(G8_SA(0, 0), a2, x00, x01);
            G8_WAIT_V(8); G8_WAIT_L(0); G8_BAR; G8_MMA(1, 0, At, B0); G8_MMA(1, 1, At, B1); G8_BAR; G8_SCHED;
            G8_LDB(B0, 1, 0); G8_LDB(B1, 1, 1); G8_SCHED; G8_LDA(At, 1, 0); G8_STAGE(G8_SA(0, 1), a2, x10, x11);
            G8_WAIT_V(8); G8_WAIT_L(0); G8_BAR; G8_MMA(0, 0, At, B0); G8_MMA(0, 1, At, B1); G8_BAR; G8_SCHED;
            G8_LDA(At, 1, 1); G8_STAGEB(G8_SB(1, 0), b3, 0); G8_STAGEB(G8_SB(1, 1), b3, 1); G8_STAGE(G8_SA(1, 0), a3, x00, x01);
            G8_WAIT_V(8); G8_WAIT_L(0); G8_BAR; G8_MMA(1, 0, At, B0); G8_MMA(1, 1, At, B1); G8_BAR; G8_SCHED;
        }
        if (wr == 0) G8_BAR;
        S.epi(acc, cur, wr, wc, fr, fq);
        if (!has_next) break;
#pragma unroll
        for (int a = 0; a < 2; ++a)
#pragma unroll
            for (int b = 0; b < 2; ++b)
#pragma unroll
                for (int m = 0; m < 4; ++m)
#pragma unroll
                    for (int n = 0; n < 2; ++n) acc[a][b][m][n] = (f32x4){0.f, 0.f, 0.f, 0.f};
        cur = nxt; cA = nA; cB = nB; ++ui;
        if (P::GATHER) { c00 = n00; c01 = n01; c10 = n10; c11 = n11; }
        if (wr == 1) G8_BAR;
    }
    G8_WAIT_V(0);
    G8_BAR;
#undef G8_SA
#undef G8_SB
#undef G8_STAGE
#undef G8_STAGEB
#undef G8_LDA
#undef G8_LDB
#undef G8_MMA
#undef G8_WAIT_V
#undef G8_WAIT_L
#undef G8_BAR
#undef G8_SCHED
}

struct DenseOrder {
    int nM, nN, nwg, G, c;
    __device__ __forceinline__ void init(int M, int N, int G_, int c_) { nM = M / BM; nN = N / BM; nwg = nM * nN; G = G_; c = c_; }
    __device__ __forceinline__ bool next(int i, Unit& u) const {
        const long L = (long)i * G + c; if (L >= nwg) return false;
        int wgid = (int)L; { const int q = nwg / 8, r = nwg % 8, xcd = wgid % 8, off = wgid / 8; wgid = (xcd < r ? xcd * (q + 1) : r * (q + 1) + (xcd - r) * q) + off; }
        const int nig = 8 * nN, gid = wgid / nig, fm = gid * 8, gsz = (nM - fm) < 8 ? (nM - fm) : 8;
        u.pm = fm + ((wgid % nig) % gsz); u.pn = (wgid % nig) / gsz; u.e = 0; u.row0 = u.pm * BM; u.p0 = 0; return true;
    }
};
}

struct Args { const float* in[29]; float* out; unsigned char* ws; int ph_lo, ph_hi, li, pad; };
struct Frame {
    LAS unsigned char* lds;
    gu32* ctl;
    int tid, lane, wave, vcu, G, bx;
    unsigned char* ws;
};
__device__ __forceinline__ float wsum(float v) {
#pragma unroll
    for (int o = 1; o < 64; o <<= 1) v += __shfl_xor(v, o);
    return v;
}

__device__ __forceinline__ void conv_item(const float* W, int ldw, int n_src0, int nvalid, int k0, bf16_t* WT, int dst_row0, int Kd, LAS float* scr, int lane) {
    const int ln = lane & 31;
#pragma unroll
    for (int i = 0; i < 32; ++i) { const int kk = 2 * i + (lane >> 5); scr[kk * 33 + ln] = (ln < nvalid) ? W[(size_t)(k0 + kk) * ldw + n_src0 + ln] : 0.f; }
    LDS_WAIT(); asm volatile("" ::: "memory");
    const int c = lane & 7;
#pragma unroll
    for (int j = 0; j < 4; ++j) { const int n = (lane >> 3) + 8 * j; const LAS float* s = scr + (8 * c) * 33 + n;
        u32x4 o; o.x = pk2(s[0 * 33], s[1 * 33]); o.y = pk2(s[2 * 33], s[3 * 33]); o.z = pk2(s[4 * 33], s[5 * 33]); o.w = pk2(s[6 * 33], s[7 * 33]);
        *(GAS u32x4*)(WT + (size_t)(dst_row0 + n) * Kd + k0 + 8 * c) = o; }
    LDS_WAIT(); asm volatile("" ::: "memory");
}
__device__ __forceinline__ void mod_item(const float* c, const float* w, float* modp, int item, int lane, LAS float* scr) {
    const int cb = item % 48, ks = item / 48, j0 = cb * 256 + lane * 4, k0 = ks * 128;
#pragma unroll
    for (int i = 0; i < 16; ++i) { const int idx = i * 64 + lane, kk = idx >> 3, b = idx & 7; const float cv = c[b * DM + k0 + kk]; scr[idx] = cv / (1.f + __expf(-cv)); }
    LDS_WAIT(); asm volatile("" ::: "memory");
    f32x4 acc[NB];
#pragma unroll
    for (int b = 0; b < NB; ++b) acc[b] = (f32x4){0.f, 0.f, 0.f, 0.f};
#pragma unroll 1
    for (int kb = 0; kb < 128; kb += 8) {
        f32x4 wv[8];
#pragma unroll
        for (int k = 0; k < 8; ++k) wv[k] = *(const GAS f32x4*)(w + (size_t)(k0 + kb + k) * (6 * DM) + j0);
        asm volatile("" : "+v"(wv[0]), "+v"(wv[1]), "+v"(wv[2]), "+v"(wv[3]), "+v"(wv[4]), "+v"(wv[5]), "+v"(wv[6]), "+v"(wv[7]) :: "memory");
#pragma unroll
        for (int k = 0; k < 8; ++k) {
            const f32x4 s0 = *(const LAS f32x4*)(scr + (kb + k) * 8), s1 = *(const LAS f32x4*)(scr + (kb + k) * 8 + 4);
            acc[0] += wv[k] * s0.x; acc[1] += wv[k] * s0.y; acc[2] += wv[k] * s0.z; acc[3] += wv[k] * s0.w; acc[4] += wv[k] * s1.x; acc[5] += wv[k] * s1.y; acc[6] += wv[k] * s1.z; acc[7] += wv[k] * s1.w;
        }
    }
#pragma unroll
    for (int b = 0; b < NB; ++b) *(GAS f32x4*)(modp + ((size_t)ks * NB + b) * 6 * DM + j0) = acc[b];
    LDS_WAIT(); asm volatile("" ::: "memory");
}
__device__ __forceinline__ float mod_reduce1(const float* modp, const float* bias, int idx) {
    const int b = idx / (6 * DM), j = idx % (6 * DM);
    float s = bias[j];
#pragma unroll
    for (int ks = 0; ks < 16; ++ks) s += modp[((size_t)ks * NB + b) * 6 * DM + j];
    return s;
}
__device__ __forceinline__ void pebias_part(const float* pe, const float* w, float* part, int kc, int lane) {
    const float* wp = w + (size_t)(kc * 64) * 64 + lane; const float* pp = pe + kc * 64;
    float a0 = 0.f, a1 = 0.f, a2 = 0.f, a3 = 0.f;
#pragma unroll
    for (int b = 0; b < 4; ++b) {
        float v[16];
#pragma unroll
        for (int j = 0; j < 16; ++j) v[j] = wp[(size_t)(b * 16 + j) * 64];
        asm volatile("" : "+v"(v[0]), "+v"(v[1]), "+v"(v[2]), "+v"(v[3]), "+v"(v[4]), "+v"(v[5]), "+v"(v[6]), "+v"(v[7]),
                          "+v"(v[8]), "+v"(v[9]), "+v"(v[10]), "+v"(v[11]), "+v"(v[12]), "+v"(v[13]), "+v"(v[14]), "+v"(v[15]));
#pragma unroll
        for (int j = 0; j < 16; j += 4) { a0 += pp[b * 16 + j] * v[j]; a1 += pp[b * 16 + j + 1] * v[j + 1]; a2 += pp[b * 16 + j + 2] * v[j + 2]; a3 += pp[b * 16 + j + 3] * v[j + 3]; }
    }
    part[kc * 64 + lane] = (a0 + a1) + (a2 + a3);
}
__device__ __forceinline__ void pebias_reduce(const float* part, float* outb, int lane) {
    float v[32];
#pragma unroll
    for (int j = 0; j < 32; ++j) v[j] = part[j * 64 + lane];
    float a = 0.f;
#pragma unroll
    for (int j = 0; j < 32; ++j) a += v[j];
    outb[lane] = a;
}

__device__ __forceinline__ void p0_prologue(Frame& F, const Args& A) {
    LAS float* scr = (LAS float*)(F.lds + F.wave * 16384);
    const int gw = F.wave * F.G + F.vcu, NGW = F.G * NWAVES;
    unsigned char* ws = F.ws;
    float* modp = (float*)(ws + WS_MODPART);
    constexpr int I_MOD = 768;
    constexpr int I_WIN = 32 * (ZW / 32);
    constexpr int I_WOUT = 0;
    constexpr int I_WR = 32, I_WCK = 64, I_WCV = 64, I_WRG = 32, I_WIG = 32, I_PE = 64;
    constexpr int NITEMS = I_MOD + I_WIN + I_WOUT + I_WR + I_WCK + I_WCV + I_WRG + I_WIG + I_PE;
    for (int it = gw; it < NITEMS; it += NGW) {
        int ln = F.lane; asm volatile("" : "+v"(ln));
        int r = it;
        if (r < I_MOD) { mod_item(A.in[1], A.in[2], modp, r, F.lane, scr); continue; } r -= I_MOD;
        if (r < I_WIN) {
            const int nb = r % (ZW / 32), kb = r / (ZW / 32), zc = nb * 32;
            int src, nv = 32;
            if (zc < 2560) src = zc; else if (zc < 4608) src = zc + 48; else { src = zc - 2048; nv = 4656 - zc; if (nv > 32) nv = 32; if (nv < 0) nv = 0; }
            if (nv == 0) src = 0;
            conv_item(A.in[5], INW, src, nv, kb * 64, (bf16_t*)(ws + WS_WIN), zc, DM, scr, ln); continue; } r -= I_WIN;
        if (r < I_WOUT) { const int nb = r % 64, kb = r / 64; conv_item(A.in[21], DM, nb * 32, 32, kb * 64, (bf16_t*)(ws + WS_WOUT), nb * 32, DM, scr, ln); continue; } r -= I_WOUT;
        if (r < I_WR) { conv_item(A.in[23], 32, 0, 32, r * 64, (bf16_t*)(ws + WS_SMALL + SM_WR), 0, DM, scr, ln); continue; } r -= I_WR;
        if (r < I_WCK) { const int nb = r % 2, kb = r / 2; conv_item(A.in[8], 64, nb * 32, 32, kb * 64, (bf16_t*)(ws + WS_SMALL + SM_WCK), nb * 32, DM, scr, ln); continue; } r -= I_WCK;
        if (r < I_WCV) { const int nb = r % 2, kb = r / 2; conv_item(A.in[9], 64, nb * 32, 32, kb * 64, (bf16_t*)(ws + WS_SMALL + SM_WCV), nb * 32, DM, scr, ln); continue; } r -= I_WCV;
        if (r < I_WRG) { const int nb = r % 2, blk = r / 2; conv_item(A.in[14] + (size_t)blk * 4096, 64, nb * 32, 32, 0, (bf16_t*)(ws + WS_SMALL + SM_WRG) + (size_t)blk * 4096, nb * 32, 64, scr, ln); continue; } r -= I_WRG;
        if (r < I_WIG) { const int nb = r % 2, blk = r / 2; conv_item(A.in[16] + (size_t)blk * 4096, 64, nb * 32, 32, 0, (bf16_t*)(ws + WS_SMALL + SM_WIG) + (size_t)blk * 4096, nb * 32, 64, scr, ln); continue; } r -= I_WIG;
        if (r < I_PE) { const int which = r >> 5; pebias_part(A.in[6 + which], A.in[8 + which], (float*)(ws + WS_PEPART) + which * 2048, r & 31, ln); continue; }
        (void)r;
    }
}

struct ProbZ {
    static constexpr int K = DM; static constexpr bool GATHER = false, PERM = true, MIDK = false;
    g8::DenseOrder ord; const bf16_t* A; const bf16_t* Bt; bf16_t* Z;
    __device__ __forceinline__ bool next(int i, g8::Unit& u) const { return ord.next(i, u); }
    __device__ __forceinline__ const char* a_base(const g8::Unit& u) const { return (const char*)A + (size_t)u.pm * 256 * K * 2; }
    __device__ __forceinline__ const char* b_base(const g8::Unit& u) const { return (const char*)Bt + (size_t)u.pn * 256 * K * 2; }
    __device__ __forceinline__ void a_voff(const g8::Unit&, int R0, int C0, int R1, int C1, unsigned& v00, unsigned& v01, unsigned& v10, unsigned& v11) const {
        v00 = (unsigned)(R0 * K + C0) * 2u; v01 = (unsigned)(R1 * K + C1) * 2u; v10 = v00 + 128u * K * 2u; v11 = v01 + 128u * K * 2u; }
    __device__ __forceinline__ void midk(g8::Acc&, const g8::Unit&, int, int) const {}
    __device__ __forceinline__ void epi(const g8::Acc& acc, const g8::Unit& u, int wr, int wc, int fr, int fq) const {
        const int row0 = u.row0 + wr * 64 + fr, col0 = u.pn * 256 + wc * 32 + 8 * fq;
#pragma unroll
        for (int ai = 0; ai < 2; ++ai)
#pragma unroll
            for (int m = 0; m < 4; ++m) { bf16_t* rowp = Z + (size_t)(row0 + ai * 128 + m * 16) * ZW + col0;
#pragma unroll
                for (int bj = 0; bj < 2; ++bj) { const f32x4 v0 = acc[ai][bj][m][0], v1 = acc[ai][bj][m][1];
                    u32x4 w; w.x = cvt_pk_bf16(v0[0], v0[1]); w.y = cvt_pk_bf16(v0[2], v0[3]); w.z = cvt_pk_bf16(v1[0], v1[1]); w.w = cvt_pk_bf16(v1[2], v1[3]);
                    *(u32x4*)(rowp + bj * 128) = w; } }
    }
};
__device__ __forceinline__ void build_tile_table(Frame& F) {
    LAS int* tab = (LAS int*)(F.lds + TILETAB_OFF);
    if (F.wave == 0) {
        const int lane = F.lane;
        const int* cnt = (const int*)(F.ctl + CW_CNT);
        const int c = (lane < NE) ? cnt[lane] : 0;
        const int t = (c + 255) >> 8;
        int ps = t;
#pragma unroll
        for (int o = 1; o < 32; o <<= 1) { const int v = __shfl_up(ps, o); if (lane >= o) ps += v; }
        const int t0 = ps - t;
        if (lane < NE) { tab[8 + lane] = c; tab[40 + lane] = t0 * 256;
            for (int j = 0; j < t; ++j) { tab[128 + t0 + j] = lane; tab[416 + t0 + j] = j * 256; } }
        if (lane == NE - 1) tab[0] = ps;
    }
    __syncthreads();
}
struct MoeOrder {
    const LAS int* tab; int G, c, NPN;
    __device__ __forceinline__ bool next(int i, g8::Unit& u) const {
        const int nt = tab[0], nunits = nt * NPN; const long L = (long)i * G + c; if (L >= nunits) return false;
        int w = (int)L; { const int q = nunits / 8, r = nunits % 8, xcd = w % 8, off = w / 8; w = (xcd < r ? xcd * (q + 1) : r * (q + 1) + (xcd - r) * q) + off; }
        const int gs = 4 * NPN, grp = w / gs, fm = grp * 4, gsz = (nt - fm) < 4 ? (nt - fm) : 4, rem = w % gs;
        u.pm = fm + rem % gsz; u.pn = rem / gsz; u.e = tab[128 + u.pm]; u.p0 = tab[416 + u.pm]; u.row0 = tab[40 + u.e] + u.p0; return true;
    }
};
__device__ __forceinline__ float fast_sigmoid(float x) { return __builtin_amdgcn_rcpf(1.f + __builtin_amdgcn_exp2f(-1.4426950408889634f * x)); }


__device__ __forceinline__ void p6_row(const u32x2 (&vb)[8], const f32x4 (&Ag)[8], const f32x4 (&Sh)[8], bf16_t* orow, unsigned char* orow8, int lane) {
    f32x4 v[8];
#pragma unroll
    for (int j = 0; j < 8; ++j) v[j] = (f32x4){bflo(vb[j].x), bfhi(vb[j].x), bflo(vb[j].y), bfhi(vb[j].y)};
    float s = 0.f;
#pragma unroll
    for (int j = 0; j < 8; ++j) s += (v[j].x * v[j].x + v[j].y * v[j].y) + (v[j].z * v[j].z + v[j].w * v[j].w);
    const float rstd = rsqrtf(wsum(s) * (1.f / DM) + EPS);
    GAS unsigned long long* o8 = (GAS unsigned long long*)orow + lane; GAS unsigned* o4 = (GAS unsigned*)orow8 + lane;
#pragma unroll
    for (int j = 0; j < 8; ++j) { const f32x4 hv = v[j] * rstd * Ag[j] + Sh[j];
        o8[64 * j] = (unsigned long long)pk2(hv.x, hv.y) | ((unsigned long long)pk2(hv.z, hv.w) << 32);
        o4[64 * j] = pk4_fp8(hv.x, hv.y, hv.z, hv.w); }
}
__device__ __forceinline__ void p6_route(Frame& F, const Args& A, const float* mod) {
    unsigned char* ws = F.ws;
    bf16_t* H2 = (bf16_t*)(ws + WS_H); const bf16_t* WrT = (const bf16_t*)(ws + WS_SMALL + SM_WR);
    int* cnt = (int*)(F.ctl + CW_CNT); int* rowtok = (int*)(ws + WS_ROUTE + RT_ROWTOK); float* rowg = (float*)(ws + WS_ROUTE + RT_ROWG); int* tokslot = (int*)(ws + WS_ROUTE + RT_TOKSLOT);
    const float* br = A.in[24];
    const int lane = F.lane, ar = lane & 15, kq = lane >> 4, tid = F.tid;
    LAS unsigned char* wl = F.lds;
    LAS int* ch_e = (LAS int*)(F.lds + TILETAB_OFF);
    LAS float* ch_g = (LAS float*)(ch_e + 256);
    LAS int* wcnt = (LAS int*)(ch_g + 256);
    LAS int* wbase = wcnt + 128;
    {
#pragma unroll
        for (int i = 0; i < 16; ++i) { const int q = F.wave * 16 + i, n = q >> 2, p = (q & 3) * 64 + lane;
            __builtin_amdgcn_global_load_lds((const unsigned*)((const char*)WrT + (size_t)n * 4096 + ((p ^ (n & 15)) << 4)), (LAS unsigned*)(wl + q * 1024), 16, 0, 0); }
    }
    for (int chunk = F.bx; chunk < NTOK / 64; chunk += F.G) {
        const int row0 = chunk * 64 + F.wave * 8, b = row0 / SEQ; const float* mb = mod + (size_t)b * 6 * DM;
        f32x4 Ag[8], Sh[8];
#pragma unroll
        for (int j = 0; j < 8; ++j) { const f32x4 gg = *((const GAS f32x4*)A.in[22] + lane + 64 * j), sc = *((const GAS f32x4*)(mb + 4 * DM) + lane + 64 * j);
            Ag[j] = gg * (sc + 1.f); Sh[j] = *((const GAS f32x4*)(mb + 3 * DM) + lane + 64 * j); }
        u32x2 xa[8], xb[8];
        const bf16_t* X1B = (const bf16_t*)(ws + WS_X1B);
#pragma unroll
        for (int j = 0; j < 8; ++j) xa[j] = *((const GAS u32x2*)(X1B + (size_t)row0 * DM) + lane + 64 * j);
#pragma unroll 1
        for (int r = 0; r < 8; r += 2) {
#pragma unroll
            for (int j = 0; j < 8; ++j) xb[j] = *((const GAS u32x2*)(X1B + (size_t)(row0 + r + 1) * DM) + lane + 64 * j);
            p6_row(xa, Ag, Sh, H2 + (size_t)(row0 + r) * DM, ws + WS_H8 + (size_t)(row0 + r) * DM, lane);
            if (r + 2 < 8) {
#pragma unroll
                for (int j = 0; j < 8; ++j) xa[j] = *((const GAS u32x2*)(X1B + (size_t)(row0 + r + 2) * DM) + lane + 64 * j); }
            p6_row(xb, Ag, Sh, H2 + (size_t)(row0 + r + 1) * DM, ws + WS_H8 + (size_t)(row0 + r + 1) * DM, lane);
        }
        VM_WAIT();
        __syncthreads();
        f32x4 acc0 = (f32x4){0.f, 0.f, 0.f, 0.f}, acc1 = acc0;
        const bf16_t* ap = H2 + (size_t)(row0 + (ar & 7)) * DM + kq * 8;
        const LAS unsigned char* w0 = wl + ar * 4096, *w1 = wl + (16 + ar) * 4096;
#pragma unroll 16
        for (int s = 0; s < 64; ++s) {
            const bf16x8 a = *(const GAS bf16x8*)(ap + 32 * s);
            const bf16x8 b0 = *(const LAS bf16x8*)(w0 + (((4 * s + kq) ^ ar) << 4)), b1 = *(const LAS bf16x8*)(w1 + (((4 * s + kq) ^ ar) << 4));
            acc0 = __builtin_amdgcn_mfma_f32_16x16x32_bf16(b0, a, acc0, 0, 0, 0);
            acc1 = __builtin_amdgcn_mfma_f32_16x16x32_bf16(b1, a, acc1, 0, 0, 0);
        }
        {
            const f32x4 bb0 = *(const GAS f32x4*)(br + 4 * kq), bb1 = *(const GAS f32x4*)(br + 16 + 4 * kq);
            float v[8] = {acc0[0] + bb0.x, acc0[1] + bb0.y, acc0[2] + bb0.z, acc0[3] + bb0.w, acc1[0] + bb1.x, acc1[1] + bb1.y, acc1[2] + bb1.z, acc1[3] + bb1.w};
            float tv[4]; int te[4];
#pragma unroll
            for (int k = 0; k < 4; ++k) {
                float bv = v[0]; int bi = 4 * kq;
#pragma unroll
                for (int q = 1; q < 8; ++q) { const int eq = (q < 4) ? 4 * kq + q : 16 + 4 * kq + (q - 4); if (v[q] > bv) { bv = v[q]; bi = eq; } }
#pragma unroll
                for (int o = 16; o < 64; o <<= 1) { const float ov = __shfl_xor(bv, o); const int oi = __shfl_xor(bi, o); if (ov > bv || (ov == bv && oi < bi)) { bv = ov; bi = oi; } }
                tv[k] = bv; te[k] = bi;
#pragma unroll
                for (int q = 0; q < 8; ++q) { const int eq = (q < 4) ? 4 * kq + q : 16 + 4 * kq + (q - 4); if (eq == bi) v[q] = -INFINITY; }
            }
            const float e1 = __expf(tv[1] - tv[0]), e2 = __expf(tv[2] - tv[0]), e3 = __expf(tv[3] - tv[0]); const float inv = 1.f / (1.f + e1 + e2 + e3);
            if (kq == 0 && ar < 8) { const int li = (F.wave * 8 + ar) * 4;
                ch_e[li] = te[0]; ch_e[li + 1] = te[1]; ch_e[li + 2] = te[2]; ch_e[li + 3] = te[3];
                ch_g[li] = inv; ch_g[li + 1] = e1 * inv; ch_g[li + 2] = e2 * inv; ch_g[li + 3] = e3 * inv; }
        }
        __syncthreads();
        int my_e = 0, my_rank = 0;
        if (F.wave < 4) { my_e = ch_e[tid];
#pragma unroll 4
            for (int e = 0; e < NE; ++e) { const unsigned long long mk = __ballot(my_e == e);
                if (my_e == e) my_rank = __popcll(mk & ((1ull << lane) - 1ull));
                if (lane == 0) wcnt[F.wave * 32 + e] = __popcll(mk); } }
        __syncthreads();
        if (tid < 32) { const int c0 = wcnt[tid], c1 = wcnt[32 + tid], c2 = wcnt[64 + tid], c3 = wcnt[96 + tid], tot = c0 + c1 + c2 + c3;
            const int base = tot ? atomicAdd(&cnt[tid], tot) : 0;
            wbase[tid] = base; wbase[32 + tid] = base + c0; wbase[64 + tid] = base + c0 + c1; wbase[96 + tid] = base + c0 + c1 + c2; }
        __syncthreads();
        if (F.wave < 4) { const int pos = wbase[F.wave * 32 + my_e] + my_rank, row = chunk * 64 + (tid >> 2);
            rowtok[(size_t)my_e * NTOK + pos] = row; rowg[(size_t)my_e * NTOK + pos] = ch_g[tid]; tokslot[row * 4 + (tid & 3)] = my_e * NTOK + pos; }
        __syncthreads();
    }
    VM_WAIT();
    __syncthreads();
}
__device__ __forceinline__ void p9_combine(Frame& F, const Args& A, const float* mod) {
    unsigned char* ws = F.ws; const LAS int* tab = (const LAS int*)(F.lds + TILETAB_OFF);
    const unsigned char* Y8 = ws + WS_Y; const int* tokslot = (const int*)(ws + WS_ROUTE + RT_TOKSLOT);
    const int lane = F.lane; const int gw = F.vcu * NWAVES + F.wave, NGW = F.G * NWAVES;
    for (int tok = gw; tok < NTOK; tok += NGW) {
        const int b = tok / SEQ; const float* g2 = mod + (size_t)b * 6 * DM + 5 * DM;
        const int4 sl = *(const int4*)(tokslot + tok * 4);
        const int s4[4] = {sl.x, sl.y, sl.z, sl.w};
        const unsigned char* yr[4];
#pragma unroll
        for (int k = 0; k < 4; ++k) { const int e = s4[k] / NTOK, p = s4[k] % NTOK; yr[k] = Y8 + (size_t)(tab[40 + e] + p) * DM + lane * 16; }
        float* orow = A.out + (size_t)tok * DM + lane * 16;
        const bf16_t* xrow = (const bf16_t*)(ws + WS_X1B) + (size_t)tok * DM + lane * 16;
#pragma unroll
        for (int j = 0; j < 2; ++j) {
            float s[16];
#pragma unroll
            for (int q = 0; q < 16; ++q) s[q] = 0.f;
#pragma unroll
            for (int k = 0; k < 4; ++k) { const u32x4 v = *(const GAS u32x4*)(yr[k] + 1024 * j);
                const unsigned w[4] = {v.x, v.y, v.z, v.w};
#pragma unroll
                for (int q = 0; q < 4; ++q) { const f32x2 lo = __builtin_amdgcn_cvt_pk_f32_fp8(w[q], false), hi2 = __builtin_amdgcn_cvt_pk_f32_fp8(w[q], true);
                    s[4 * q] += lo.x; s[4 * q + 1] += lo.y; s[4 * q + 2] += hi2.x; s[4 * q + 3] += hi2.y; } }
            const u32x4 xw0 = *(const GAS u32x4*)(xrow + 1024 * j), xw1 = *(const GAS u32x4*)(xrow + 1024 * j + 8);
            const unsigned xw[8] = {xw0.x, xw0.y, xw0.z, xw0.w, xw1.x, xw1.y, xw1.z, xw1.w};
#pragma unroll
            for (int q = 0; q < 4; ++q) { const f32x4 x0 = (f32x4){bflo(xw[2 * q]), bfhi(xw[2 * q]), bflo(xw[2 * q + 1]), bfhi(xw[2 * q + 1])}; const f32x4 ga = *(const GAS f32x4*)(g2 + lane * 16 + 1024 * j + 4 * q);
                *(GAS f32x4*)(orow + 1024 * j + 4 * q) = x0 + ga * ((f32x4){s[4 * q], s[4 * q + 1], s[4 * q + 2], s[4 * q + 3]} * 0.125f); }
        }
    }
}
constexpr int RSTAB_OFF = TILETAB_OFF + 4096;
struct ProbMix {
    static constexpr int K = DM; static constexpr bool GATHER = false, PERM = false, MIDK = true;
    g8::DenseOrder ord; const bf16_t* A; const bf16_t* Bt; const float* x; const float* mod; bf16_t* x1b; const LAS float* rs;
    __device__ __forceinline__ bool next(int i, g8::Unit& u) const { const bool ok = ord.next(i, u); u.p0 = i; return ok; }
    __device__ __forceinline__ const char* a_base(const g8::Unit& u) const { return (const char*)A + (size_t)u.pm * 256 * K * 2; }
    __device__ __forceinline__ const char* b_base(const g8::Unit& u) const { return (const char*)Bt + (size_t)u.pn * 256 * K * 2; }
    __device__ __forceinline__ void a_voff(const g8::Unit&, int R0, int C0, int R1, int C1, unsigned& v00, unsigned& v01, unsigned& v10, unsigned& v11) const {
        v00 = (unsigned)(R0 * K + C0) * 2u; v01 = (unsigned)(R1 * K + C1) * 2u; v10 = v00 + 128u * K * 2u; v11 = v01 + 128u * K * 2u; }
    __device__ __forceinline__ void midk(g8::Acc& acc, const g8::Unit& u, int wr, int fr) const {
        const LAS float* t = rs + (size_t)u.p0 * 512;
#pragma unroll
        for (int ai = 0; ai < 2; ++ai)
#pragma unroll
            for (int m = 0; m < 4; ++m) { const float r = t[(ai * 128 + wr * 64 + m * 16 + fr) * 2];
#pragma unroll
                for (int bj = 0; bj < 2; ++bj)
#pragma unroll
                    for (int n = 0; n < 2; ++n) acc[ai][bj][m][n] *= r; }
    }
    __device__ __forceinline__ void epi(const g8::Acc& acc, const g8::Unit& u, int wr, int wc, int fr, int fq) const {
        const LAS float* t = rs + (size_t)u.p0 * 512;
        const int lr0 = wr * 64 + fr, col0 = u.pn * 256 + wc * 32 + 4 * fq; const int b = u.row0 / SEQ;
        const float* g1 = mod + (size_t)b * 6 * DM + 2 * DM + col0;
        f32x4 gv[2][2];
#pragma unroll
        for (int bj = 0; bj < 2; ++bj)
#pragma unroll
            for (int n = 0; n < 2; ++n) gv[bj][n] = *(const f32x4*)(g1 + bj * 128 + n * 16);
#pragma unroll
        for (int ai = 0; ai < 2; ++ai) {
            f32x4 xv[4][2][2];
#pragma unroll
            for (int m = 0; m < 4; ++m) { const size_t off = (size_t)(u.row0 + lr0 + ai * 128 + m * 16) * DM + col0;
#pragma unroll
                for (int bj = 0; bj < 2; ++bj)
#pragma unroll
                    for (int n = 0; n < 2; ++n) xv[m][bj][n] = *(const f32x4*)(x + off + bj * 128 + n * 16); }
#pragma unroll
            for (int m = 0; m < 4; ++m) { const int lr = lr0 + ai * 128 + m * 16; const float rl = t[lr * 2 + 1]; const size_t off = (size_t)(u.row0 + lr) * DM + col0;
#pragma unroll
                for (int bj = 0; bj < 2; ++bj)
#pragma unroll
                    for (int n = 0; n < 2; ++n) { const f32x4 r = xv[m][bj][n] + gv[bj][n] * (acc[ai][bj][m][n] * rl);
                        *(u32x2*)(x1b + off + bj * 128 + n * 16) = (u32x2){pk2(r.x, r.y), pk2(r.z, r.w)}; } }
            asm volatile("" ::: "memory");
        }
    }
};
__device__ __forceinline__ void p5_build_rstab(Frame& F, const g8::DenseOrder& ord, const float* ssn, const float* ssl) {
    LAS float* rs = (LAS float*)(F.lds + RSTAB_OFF);
    g8::Unit u;
    for (int i = 0; i < 4 && ord.next(i, u); ++i) {
        for (int r = F.tid; r < 256; r += NWAVES * 64) { const int row = u.row0 + r;
            const f32x4 a = *(const GAS f32x4*)(ssn + (size_t)row * 4); float sn = (a.x + a.y) + (a.z + a.w);
            float sl = 0.f;
#pragma unroll
            for (int q = 0; q < 4; ++q) { const f32x4 c = *(const GAS f32x4*)(ssl + (size_t)row * 16 + 4 * q); sl += (c.x + c.y) + (c.z + c.w); }
            const float rn = rsqrtf(sn * (1.f / 1024.f) + EPS), rl = rsqrtf(sl * (1.f / 1024.f) + EPS);
            rs[(i * 256 + r) * 2] = rn / rl; rs[(i * 256 + r) * 2 + 1] = rl; }
    }
    __syncthreads();
}
constexpr int TOKBUF_OFF = TILETAB_OFF + 3072;
namespace g8 {
typedef int v8i __attribute__((ext_vector_type(8)));
typedef int v4i __attribute__((ext_vector_type(4)));
__host__ __device__ __forceinline__ int sw8(int row) { const int P = (row >> 1) & 7; return P ^ ((((P >> 2) ^ (P >> 1)) & 1) << 1); }
__device__ __forceinline__ void mfma16_fp8(f32x4& acc, const v8i& a, const v8i& b, int scl) {
    asm volatile("v_mfma_scale_f32_16x16x128_f8f6f4 %0, %1, %2, %0, %3, %3 op_sel_hi:[0,0,0]" : "+v"(acc) : "v"(a), "v"(b), "v"(scl)); }

template <class P>
__device__ __forceinline__ void gemm8_phase(LAS unsigned char* lds, const P& S) {
    const int tid = threadIdx.x, wid = __builtin_amdgcn_readfirstlane(tid >> 6), lane = tid & 63, wr = wid >> 2, wc = wid & 3, fr = lane & 15, fq = lane >> 4;
    constexpr int KB = P::KB, nt = KB / 128;
    const int R0 = wid * 8 + (lane >> 3), R1 = R0 + 64;
    const unsigned cs = (unsigned)(((lane & 7) ^ sw8(R0)) * 16);
    const int Rb0 = (R0 & ~31) + perm32(R0 & 31), Rb1 = (R1 & ~31) + perm32(R1 & 31);
    const unsigned voffB0 = (unsigned)Rb0 * KB + cs, voffB1 = (unsigned)Rb1 * KB + cs;
    constexpr size_t kstep = 128;
    constexpr unsigned hstep = 128u * KB;
    const unsigned ldsw = (unsigned)wid * 1024u;
    const int xr = sw8(fr);
    int aoff[2], boff[2];
#pragma unroll
    for (int c = 0; c < 2; ++c) { const int sl = ((2 * fq + c) ^ xr) << 4; aoff[c] = (64 * wr + fr) * 128 + sl; boff[c] = (32 * wc + fr) * 128 + sl; }
    int scl = 0x7f7f7f7f;
    asm volatile("" : "+v"(scl));
#define G8_SA(b, h) (((b) * 2 + (h)) * HTB)
#define G8_SB(b, h) ((4 + (b) * 2 + (h)) * HTB)
#define G8_STAGE(bufoff, gbase, o0, o1) do { \
        __builtin_amdgcn_global_load_lds((const unsigned*)((const char*)(gbase) + (o0)), (LAS unsigned*)(lds + (bufoff) + ldsw), 16, 0, 0); \
        __builtin_amdgcn_global_load_lds((const unsigned*)((const char*)(gbase) + (o1)), (LAS unsigned*)(lds + (bufoff) + ldsw + 8192), 16, 0, 0); } while (0)
#define G8_STAGEB(bufoff, gbase, h) G8_STAGE(bufoff, gbase, voffB0 + (h) * hstep, voffB1 + (h) * hstep)
#define G8_LDA(dst, b, h) do { _Pragma("unroll") for (int m = 0; m < 4; ++m) { \
        const v4i _lo = *(const LAS v4i*)(lds + G8_SA(b, h) + aoff[0] + m * 2048), _hi = *(const LAS v4i*)(lds + G8_SA(b, h) + aoff[1] + m * 2048); \
        dst[m] = __builtin_shufflevector(_lo, _hi, 0, 1, 2, 3, 4, 5, 6, 7); } } while (0)
#define G8_LDB(dst, b, h) do { _Pragma("unroll") for (int n = 0; n < 2; ++n) { \
        const v4i _lo = *(const LAS v4i*)(lds + G8_SB(b, h) + boff[0] + n * 2048), _hi = *(const LAS v4i*)(lds + G8_SB(b, h) + boff[1] + n * 2048); \
        dst[n] = __builtin_shufflevector(_lo, _hi, 0, 1, 2, 3, 4, 5, 6, 7); } } while (0)
#define G8_MMA(ai, bj, At, Bt) do { __builtin_amdgcn_s_setprio(1); _Pragma("unroll") for (int m = 0; m < 4; ++m) _Pragma("unroll") for (int n = 0; n < 2; ++n) \
        mfma16_fp8(acc[ai][bj][m][n], Bt[n], At[m], scl); __builtin_amdgcn_s_setprio(0); } while (0)
#define G8_WAIT_V(n) asm volatile("s_waitcnt vmcnt(" #n ")" ::: "memory")
#define G8_WAIT_L(n) asm volatile("s_waitcnt lgkmcnt(" #n ")" ::: "memory")
#define G8_BAR __builtin_amdgcn_s_barrier()
#define G8_SCHED __builtin_amdgcn_sched_barrier(0)
    Unit cur, nxt; int ui = 0;
    if (!S.next(0, cur)) return;
    Acc acc;
#pragma unroll
    for (int a = 0; a < 2; ++a)
#pragma unroll
        for (int b = 0; b < 2; ++b)
#pragma unroll
            for (int m = 0; m < 4; ++m)
#pragma unroll
                for (int n = 0; n < 2; ++n) acc[a][b][m][n] = (f32x4){0.f, 0.f, 0.f, 0.f};
    v8i At[4], B0[2], B1[2];
    unsigned c00, c01, c10, c11, n00, n01, n10, n11;
    S.a_voff(cur, R0, R1, cs, c00, c01, c10, c11);
    n00 = c00; n01 = c01; n10 = c10; n11 = c11;
    const char* cA = S.a_base(cur); const char* cB = S.b_base(cur);
    if (P::ROWPF) S.tok_prefetch(lds, cur, 0, wid, lane);
    G8_STAGEB(G8_SB(0, 0), cB, 0); G8_STAGEB(G8_SB(0, 1), cB, 1); G8_STAGE(G8_SA(0, 0), cA, c00, c01); G8_STAGE(G8_SA(0, 1), cA, c10, c11);
    if (wr == 1) G8_BAR;
    G8_WAIT_V(2); G8_BAR;
    G8_STAGEB(G8_SB(1, 0), cB + kstep, 0); G8_STAGE(G8_SA(1, 0), cA + kstep, c00, c01); G8_STAGEB(G8_SB(1, 1), cB + kstep, 1);
    G8_WAIT_V(6); G8_BAR;
    for (;;) {
        const bool has_next = S.next(ui + 1, nxt);
        const char* nA = has_next ? S.a_base(nxt) : cA; const char* nB = has_next ? S.b_base(nxt) : cB;
        if (P::GATHER || P::ROWPF) { if (has_next) S.tok_prefetch(lds, nxt, ui + 1, wid, lane); }
        if (P::GATHER) { n00 = c00; n01 = c01; n10 = c10; n11 = c11; }
        for (int t = 0; t < nt; t += 2) {
            const bool last = (t == nt - 2);
            if (P::MIDK) { if (t == nt / 2) S.midk(acc, cur, wr, fr); }
            if (P::GATHER) { if (last && has_next) S.a_voff_lds(lds, nxt, ui + 1, R0, R1, cs, n00, n01, n10, n11); }
            const char* a1 = cA + (size_t)(t + 1) * kstep;
            const char* a2 = last ? nA : cA + (size_t)(t + 2) * kstep; const char* b2 = last ? nB : cB + (size_t)(t + 2) * kstep;
            const char* a3 = a2 + kstep; const char* b3 = b2 + kstep;
            const unsigned x00 = (P::GATHER && last) ? n00 : c00, x01 = (P::GATHER && last) ? n01 : c01, x10 = (P::GATHER && last) ? n10 : c10, x11 = (P::GATHER && last) ? n11 : c11;
            G8_LDB(B0, 0, 0); G8_LDB(B1, 0, 1); G8_SCHED; G8_LDA(At, 0, 0); G8_STAGE(G8_SA(1, 1), a1, c10, c11);
            G8_WAIT_V(8); G8_WAIT_L(0); G8_BAR; G8_WAIT_L(0); G8_SCHED; G8_MMA(0, 0, At, B0); G8_MMA(0, 1, At, B1); G8_BAR; G8_SCHED;
            G8_LDA(At, 0, 1); G8_STAGEB(G8_SB(0, 0), b2, 0); G8_STAGEB(G8_SB(0, 1), b2, 1); G8_STAGE(G8_SA(0, 0), a2, x00, x01);
            G8_WAIT_V(8); G8_WAIT_L(0); G8_BAR; G8_WAIT_L(0); G8_SCHED; G8_MMA(1, 0, At, B0); G8_MMA(1, 1, At, B1); G8_BAR; G8_SCHED;
            G8_LDB(B0, 1, 0); G8_LDB(B1, 1, 1); G8_SCHED; G8_LDA(At, 1, 0); G8_STAGE(G8_SA(0, 1), a2, x10, x11);
            G8_WAIT_V(8); G8_WAIT_L(0); G8_BAR; G8_WAIT_L(0); G8_SCHED; G8_MMA(0, 0, At, B0); G8_MMA(0, 1, At, B1); G8_BAR; G8_SCHED;
            G8_LDA(At, 1, 1); G8_STAGEB(G8_SB(1, 0), b3, 0); G8_STAGEB(G8_SB(1, 1), b3, 1); G8_STAGE(G8_SA(1, 0), a3, x00, x01);
            G8_WAIT_V(8); G8_WAIT_L(0); G8_BAR; G8_WAIT_L(0); G8_SCHED; G8_MMA(1, 0, At, B0); G8_MMA(1, 1, At, B1); G8_BAR; G8_SCHED;
        }
        asm volatile("s_nop 15\n\ts_nop 15" ::: "memory");
        if (wr == 0) G8_BAR;
        { int tz = threadIdx.x; asm volatile("" : "+v"(tz));
          const int lz = tz & 63; S.epi(acc, cur, wr, wc, lz & 15, lz >> 4, lds, ui); }
        if (!has_next) break;
#pragma unroll
        for (int a = 0; a < 2; ++a)
#pragma unroll
            for (int b = 0; b < 2; ++b)
#pragma unroll
                for (int m = 0; m < 4; ++m)
#pragma unroll
                    for (int n = 0; n < 2; ++n) acc[a][b][m][n] = (f32x4){0.f, 0.f, 0.f, 0.f};
        cur = nxt; cA = nA; cB = nB; ++ui;
        if (P::GATHER) { c00 = n00; c01 = n01; c10 = n10; c11 = n11; }
        if (wr == 1) G8_BAR;
    }
    G8_WAIT_V(0);
    G8_BAR;
#undef G8_SA
#undef G8_SB
#undef G8_STAGE
#undef G8_STAGEB
#undef G8_LDA
#undef G8_LDB
#undef G8_MMA
#undef G8_WAIT_V
#undef G8_WAIT_L
#undef G8_BAR
#undef G8_SCHED
}
}


struct Conv8Src { const float* W; int ldw, n_src0, k0; unsigned char* WT8; int dst_row0; };
__device__ __forceinline__ void conv8_load(const Conv8Src& s, f32x4 (&v)[8], int tid) {
    const int c4 = tid & 15, kr = tid >> 4;
#pragma unroll
    for (int i = 0; i < 8; ++i) v[i] = *(const GAS f32x4*)(s.W + (size_t)(s.k0 + i * 32 + kr) * s.ldw + s.n_src0 + 4 * c4);
}
__device__ __forceinline__ void conv8_to_lds(const f32x4 (&v)[8], LAS float* scr, int tid) {
    const int c4 = tid & 15, kr = tid >> 4;
#pragma unroll
    for (int i = 0; i < 8; ++i) { const int k = i * 32 + kr; const int g = 4 * ((k >> 4) & 7) + 2 * (k >> 7);
        *(LAS f32x2*)(scr + k * 64 + ((4 * c4) ^ g)) = (f32x2){v[i].x, v[i].y}; *(LAS f32x2*)(scr + k * 64 + ((4 * c4 + 2) ^ g)) = (f32x2){v[i].z, v[i].w}; }
}
__device__ __forceinline__ void conv8_store(const Conv8Src& sd, const LAS float* scr, int tid) {
    const int kc = tid & 15, ns = tid >> 4; const int g = 4 * (kc & 7) + 2 * (kc >> 3);
#pragma unroll
    for (int p = 0; p < 2; ++p) { const int n = ns + 32 * p; const LAS float* s = scr + (16 * kc) * 64 + (n ^ g);
        u32x4 o;
        o.x = pk4_fp8(s[0 * 64] * 32.f, s[1 * 64] * 32.f, s[2 * 64] * 32.f, s[3 * 64] * 32.f);     o.y = pk4_fp8(s[4 * 64] * 32.f, s[5 * 64] * 32.f, s[6 * 64] * 32.f, s[7 * 64] * 32.f);
        o.z = pk4_fp8(s[8 * 64] * 32.f, s[9 * 64] * 32.f, s[10 * 64] * 32.f, s[11 * 64] * 32.f);   o.w = pk4_fp8(s[12 * 64] * 32.f, s[13 * 64] * 32.f, s[14 * 64] * 32.f, s[15 * 64] * 32.f);
        *(GAS u32x4*)(sd.WT8 + (size_t)(sd.dst_row0 + n) * DM + sd.k0 + 16 * kc) = o; }
}

struct ProbM1F {
    static constexpr int KB = DM; static constexpr bool GATHER = true, ROWPF = false, MIDK = false;
    MoeOrder ord; const unsigned char* H8; const unsigned char* W1T8; const float* b1; const int* rowtok; unsigned char* ACT8;
    __device__ __forceinline__ bool next(int i, g8::Unit& u) const { return ord.next(i, u); }
    __device__ __forceinline__ const char* a_base(const g8::Unit&) const { return (const char*)H8; }
    __device__ __forceinline__ const char* b_base(const g8::Unit& u) const { return (const char*)W1T8 + ((size_t)u.e * 4096 + (size_t)u.pn * 256) * KB; }
    __device__ __forceinline__ void a_voff(const g8::Unit& u, int R0, int R1, unsigned cs, unsigned& v00, unsigned& v01, unsigned& v10, unsigned& v11) const {
        const int cntE = ord.tab[8 + u.e]; const int* rt = rowtok + (size_t)u.e * NTOK + u.p0; const int lim = cntE - u.p0;
        const int t00 = (R0 < lim) ? rt[R0] : 0, t01 = (R1 < lim) ? rt[R1] : 0, t10 = (128 + R0 < lim) ? rt[128 + R0] : 0, t11 = (128 + R1 < lim) ? rt[128 + R1] : 0;
        v00 = (unsigned)t00 * KB + cs; v01 = (unsigned)t01 * KB + cs; v10 = (unsigned)t10 * KB + cs; v11 = (unsigned)t11 * KB + cs; }
    __device__ __forceinline__ void tok_prefetch(LAS unsigned char* lds, const g8::Unit& u, int ui, int wid, int lane) const {
        if (wid == 0) __builtin_amdgcn_global_load_lds((const unsigned*)(rowtok + (size_t)u.e * NTOK + u.p0 + lane * 4), (LAS unsigned*)(lds + TOKBUF_OFF + (ui & 1) * 1024), 16, 0, 0); }
    __device__ __forceinline__ void a_voff_lds(const LAS unsigned char* lds, const g8::Unit& u, int ui, int R0, int R1, unsigned cs, unsigned& v00, unsigned& v01, unsigned& v10, unsigned& v11) const {
        const LAS int* rt = (const LAS int*)(lds + TOKBUF_OFF + (ui & 1) * 1024); const int lim = ord.tab[8 + u.e] - u.p0;
        const int t00 = (R0 < lim) ? rt[R0] : 0, t01 = (R1 < lim) ? rt[R1] : 0, t10 = (128 + R0 < lim) ? rt[128 + R0] : 0, t11 = (128 + R1 < lim) ? rt[128 + R1] : 0;
        v00 = (unsigned)t00 * KB + cs; v01 = (unsigned)t01 * KB + cs; v10 = (unsigned)t10 * KB + cs; v11 = (unsigned)t11 * KB + cs; }
    __device__ __forceinline__ void midk(g8::Acc&, const g8::Unit&, int, int) const {}
    __device__ __forceinline__ void epi(const g8::Acc& acc, const g8::Unit& u, int wr, int wc, int fr, int fq, const LAS unsigned char* lds, int ui) const {
        const int cc = u.pn * 128 + wc * 32 + 8 * fq;
        const float* bg = b1 + (size_t)u.e * 4096 + cc; const float* bl = bg + 2048;
        f32x4 bgv[2], blv[2];
#pragma unroll
        for (int n = 0; n < 2; ++n) { bgv[n] = *(const f32x4*)(bg + 4 * n); blv[n] = *(const f32x4*)(bl + 4 * n) + 1.f; }
#pragma unroll
        for (int ai = 0; ai < 2; ++ai)
#pragma unroll
            for (int m = 0; m < 4; ++m) {
                unsigned w[2];
#pragma unroll
                for (int n = 0; n < 2; ++n) { f32x2 o2[2];
#pragma unroll
                    for (int h2 = 0; h2 < 2; ++h2) {
                        const f32x2 ag = (f32x2){acc[ai][0][m][n][2 * h2], acc[ai][0][m][n][2 * h2 + 1]}, al = (f32x2){acc[ai][1][m][n][2 * h2], acc[ai][1][m][n][2 * h2 + 1]};
                        const f32x2 bgg = (f32x2){bgv[n][2 * h2], bgv[n][2 * h2 + 1]}, bll = (f32x2){blv[n][2 * h2], blv[n][2 * h2 + 1]};
                        f32x2 ug = ag * 0.03125f + bgg, ul = al * 0.03125f + bll;
                        ug.x = fminf(ug.x, 7.f); ug.y = fminf(ug.y, 7.f); ul.x = fminf(fmaxf(ul.x, -6.f), 8.f); ul.y = fminf(fmaxf(ul.y, -6.f), 8.f);
                        const f32x2 ea = ug * (-1.702f * 1.4426950408889634f);
                        f32x2 den; den.x = __builtin_amdgcn_exp2f(ea.x); den.y = __builtin_amdgcn_exp2f(ea.y); den = den + 1.f;
                        f32x2 sg; sg.x = __builtin_amdgcn_rcpf(den.x); sg.y = __builtin_amdgcn_rcpf(den.y);
                        o2[h2] = (ug * sg) * ul; }
                    w[n] = pk4_fp8(o2[0].x, o2[0].y, o2[1].x, o2[1].y); }
                *(u32x2*)(ACT8 + (size_t)(u.row0 + ai * 128 + wr * 64 + m * 16 + fr) * DM + cc) = (u32x2){w[0], w[1]}; }
    }
};
struct ProbM2F {
    static constexpr int KB = DM; static constexpr bool GATHER = false, ROWPF = true, MIDK = false;
    MoeOrder ord; const unsigned char* ACT8; const unsigned char* W2T8; const float* b2; const float* rowg; unsigned char* Y8;
    __device__ __forceinline__ bool next(int i, g8::Unit& u) const { return ord.next(i, u); }
    __device__ __forceinline__ const char* a_base(const g8::Unit& u) const { return (const char*)ACT8 + (size_t)u.row0 * KB; }
    __device__ __forceinline__ const char* b_base(const g8::Unit& u) const { return (const char*)W2T8 + ((size_t)u.e * DM + (size_t)u.pn * 256) * KB; }
    __device__ __forceinline__ void a_voff(const g8::Unit&, int R0, int R1, unsigned cs, unsigned& v00, unsigned& v01, unsigned& v10, unsigned& v11) const {
        v00 = (unsigned)R0 * KB + cs; v01 = (unsigned)R1 * KB + cs; v10 = v00 + 128u * KB; v11 = v01 + 128u * KB; }
    __device__ __forceinline__ void tok_prefetch(LAS unsigned char* lds, const g8::Unit& u, int ui, int wid, int lane) const {
        if (wid == 0) __builtin_amdgcn_global_load_lds((const unsigned*)(rowg + (size_t)u.e * NTOK + u.p0 + lane * 4), (LAS unsigned*)(lds + RSTAB_OFF + (ui % 3) * 1024), 16, 0, 0); }
    __device__ __forceinline__ void a_voff_lds(const LAS unsigned char*, const g8::Unit&, int, int, int, unsigned, unsigned&, unsigned&, unsigned&, unsigned&) const {}
    __device__ __forceinline__ void midk(g8::Acc&, const g8::Unit&, int, int) const {}
    __device__ __forceinline__ void epi(const g8::Acc& acc, const g8::Unit& u, int wr, int wc, int fr, int fq, const LAS unsigned char* lds, int ui) const {
        const int lr0 = wr * 64 + fr, col0 = u.pn * 256 + wc * 32 + 8 * fq;
        const LAS float* rg = (const LAS float*)(lds + RSTAB_OFF + (ui % 3) * 1024) + lr0;
        f32x4 bv[2][2];
#pragma unroll
        for (int bj = 0; bj < 2; ++bj)
#pragma unroll
            for (int n = 0; n < 2; ++n) bv[bj][n] = *(const f32x4*)(b2 + (size_t)u.e * DM + col0 + bj * 128 + 4 * n);
#pragma unroll
        for (int ai = 0; ai < 2; ++ai)
#pragma unroll
            for (int m = 0; m < 4; ++m) { const float gsc = rg[ai * 128 + m * 16] * 8.f; unsigned char* rowp = Y8 + (size_t)(u.row0 + lr0 + ai * 128 + m * 16) * DM + col0;
#pragma unroll
                for (int bj = 0; bj < 2; ++bj) { const f32x4 v0 = (acc[ai][bj][m][0] * 0.03125f + bv[bj][0]) * gsc, v1 = (acc[ai][bj][m][1] * 0.03125f + bv[bj][1]) * gsc;
                    *(u32x2*)(rowp + bj * 128) = (u32x2){pk4_fp8(v0[0], v0[1], v0[2], v0[3]), pk4_fp8(v1[0], v1[1], v1[2], v1[3])}; } }
    }
};

struct ProbMix8 {
    static constexpr int KB = DM; static constexpr bool GATHER = false, ROWPF = false, MIDK = true;
    g8::DenseOrder ord; const unsigned char* A8; const unsigned char* W8; const float* x; const float* mod; bf16_t* x1b; const LAS float* rs;
    __device__ __forceinline__ bool next(int i, g8::Unit& u) const { const bool ok = ord.next(i, u); u.p0 = i; return ok; }
    __device__ __forceinline__ const char* a_base(const g8::Unit& u) const { return (const char*)A8 + (size_t)u.pm * 256 * KB; }
    __device__ __forceinline__ const char* b_base(const g8::Unit& u) const { return (const char*)W8 + (size_t)u.pn * 256 * KB; }
    __device__ __forceinline__ void a_voff(const g8::Unit&, int R0, int R1, unsigned cs, unsigned& v00, unsigned& v01, unsigned& v10, unsigned& v11) const {
        v00 = (unsigned)R0 * KB + cs; v01 = (unsigned)R1 * KB + cs; v10 = v00 + 128u * KB; v11 = v01 + 128u * KB; }
    __device__ __forceinline__ void tok_prefetch(LAS unsigned char*, const g8::Unit&, int, int, int) const {}
    __device__ __forceinline__ void a_voff_lds(const LAS unsigned char*, const g8::Unit&, int, int, int, unsigned, unsigned&, unsigned&, unsigned&, unsigned&) const {}
    __device__ __forceinline__ void midk(g8::Acc& acc, const g8::Unit& u, int wr, int fr) const {
        const LAS float* t = rs + (size_t)u.p0 * 512;
#pragma unroll
        for (int ai = 0; ai < 2; ++ai)
#pragma unroll
            for (int m = 0; m < 4; ++m) { const float r = t[(ai * 128 + wr * 64 + m * 16 + fr) * 2];
#pragma unroll
                for (int bj = 0; bj < 2; ++bj)
#pragma unroll
                    for (int n = 0; n < 2; ++n) acc[ai][bj][m][n] *= r; }
    }
    __device__ __forceinline__ void epi(const g8::Acc& acc, const g8::Unit& u, int wr, int wc, int fr, int fq, const LAS unsigned char*, int) const {
        const LAS float* t = rs + (size_t)u.p0 * 512;
        const int lr0 = wr * 64 + fr, col0 = u.pn * 256 + wc * 32 + 8 * fq; const int b = u.row0 / SEQ;
        const float* g1 = mod + (size_t)b * 6 * DM + 2 * DM + col0;
        f32x4 gv[2][2];
#pragma unroll
        for (int bj = 0; bj < 2; ++bj)
#pragma unroll
            for (int n = 0; n < 2; ++n) gv[bj][n] = *(const f32x4*)(g1 + bj * 128 + 4 * n) * (1.f / (32.f * A2_SCALE));
#pragma unroll
        for (int ai = 0; ai < 2; ++ai) {
            f32x4 xv[4][2][2];
#pragma unroll
            for (int m = 0; m < 4; ++m) { const size_t off = (size_t)(u.row0 + lr0 + ai * 128 + m * 16) * DM + col0;
#pragma unroll
                for (int bj = 0; bj < 2; ++bj)
#pragma unroll
                    for (int n = 0; n < 2; ++n) xv[m][bj][n] = *(const f32x4*)(x + off + bj * 128 + 4 * n); }
#pragma unroll
            for (int m = 0; m < 4; ++m) { const int lr = lr0 + ai * 128 + m * 16; const float rl = t[lr * 2 + 1]; const size_t off = (size_t)(u.row0 + lr) * DM + col0;
#pragma unroll
                for (int bj = 0; bj < 2; ++bj) { const f32x4 r0 = xv[m][bj][0] + gv[bj][0] * (acc[ai][bj][m][0] * rl), r1 = xv[m][bj][1] + gv[bj][1] * (acc[ai][bj][m][1] * rl);
                    *(u32x4*)(x1b + off + bj * 128) = (u32x4){pk2(r0.x, r0.y), pk2(r0.z, r0.w), pk2(r1.x, r1.y), pk2(r1.z, r1.w)}; } }
            asm volatile("" ::: "memory");
        }
    }
};

constexpr int CONV_NIT1 = NE * 16 * 64, CONV_NIT = CONV_NIT1 + NE * 16 * 32, CONV_NITX = CONV_NIT + 16 * 32;
struct Conv8Item { const float* W; int ldw, n_src0, k0; unsigned char* WT8; int dst_row0; };
__device__ __forceinline__ Conv8Item conv8_item_of(const Args& A, unsigned char* ws, int it) {
    constexpr int I1 = NE * 16 * 64;
    Conv8Item s;
    if (it < I1) { const int nb = it & 63, kb = (it >> 6) & 15, e = it >> 10; const int d0 = nb * 64, pn = d0 >> 8, rr = d0 & 255;
        s.W = A.in[25] + (size_t)e * DM * 4096; s.ldw = 4096; s.n_src0 = (rr < 128) ? (pn * 128 + rr) : (2048 + pn * 128 + rr - 128); s.k0 = kb * 128; s.WT8 = ws + WS_W1 + (size_t)e * 4096 * DM; s.dst_row0 = d0; }
    else if (it < CONV_NIT) { const int r = it - I1; const int nb = r & 31, kb = (r >> 5) & 15, e = r >> 9;
        s.W = A.in[27] + (size_t)e * DM * DM; s.ldw = DM; s.n_src0 = nb * 64; s.k0 = kb * 128; s.WT8 = ws + WS_W2 + (size_t)e * DM * DM; s.dst_row0 = nb * 64; }
    else { const int r = it - CONV_NIT; const int nb = r & 31, kb = r >> 5;
        s.W = A.in[21]; s.ldw = DM; s.n_src0 = nb * 64; s.k0 = kb * 128; s.WT8 = ws + WS_WOUT; s.dst_row0 = nb * 64; }
    return s;
}
__device__ __forceinline__ void conv8_dma(const Conv8Item& s, LAS unsigned char* buf, int wave, int lane) {
#pragma unroll
    for (int i = 0; i < 4; ++i) { const int q = wave * 4 + i, k = 4 * q + (lane >> 4), c = lane & 15;
        const float* src = s.W + (size_t)(s.k0 + k) * s.ldw + s.n_src0 + ((c ^ ((k >> 4) & 7)) << 2);
        __builtin_amdgcn_global_load_lds((const unsigned*)src, (LAS unsigned*)(buf + q * 1024), 16, 0, 2); }
}
__device__ __forceinline__ void conv8_out(const Conv8Item& sd, const LAS float* scr, int tid) {
    const int kc = tid & 7, n = tid >> 3; const LAS float* s = scr + (16 * kc) * 64 + ((((n >> 2) ^ kc)) << 2) + (n & 3);
    u32x4 o;
    o.x = pk4_fp8(s[0 * 64] * 32.f, s[1 * 64] * 32.f, s[2 * 64] * 32.f, s[3 * 64] * 32.f);     o.y = pk4_fp8(s[4 * 64] * 32.f, s[5 * 64] * 32.f, s[6 * 64] * 32.f, s[7 * 64] * 32.f);
    o.z = pk4_fp8(s[8 * 64] * 32.f, s[9 * 64] * 32.f, s[10 * 64] * 32.f, s[11 * 64] * 32.f);   o.w = pk4_fp8(s[12 * 64] * 32.f, s[13 * 64] * 32.f, s[14 * 64] * 32.f, s[15 * 64] * 32.f);
    *(GAS u32x4*)(sd.WT8 + (size_t)(sd.dst_row0 + n) * DM + sd.k0 + 16 * kc) = o;
}
__device__ __forceinline__ void p0_experts(Frame& F, const Args& A, int cv, int cG, int it_lo, int it_hi) {
    unsigned char* ws = F.ws;
    const int npb = (it_hi - it_lo + cG - 1) / cG, first = it_lo + cv * npb, n = (first + npb <= it_hi) ? npb : (it_hi - first);
    if (n <= 0) return;
#define P0_ITEM(j) conv8_item_of(A, ws, first + (((j) < n) ? (j) : n - 1))
    Conv8Item cur = P0_ITEM(0);
    conv8_dma(cur, F.lds, F.wave, F.lane);
#pragma unroll 1
    for (int j = 1; j < 4; ++j) { const Conv8Item t = P0_ITEM(j); conv8_dma(t, F.lds + j * 32768, F.wave, F.lane); }
    int bi = 0, bn = 4;
#pragma unroll 1
    for (int i = 0; i < n; ++i) {
        if (i < 3) asm volatile("s_waitcnt vmcnt(12)" ::: "memory"); else asm volatile("s_waitcnt vmcnt(15)" ::: "memory");
        asm volatile("s_waitcnt lgkmcnt(0)" ::: "memory"); __builtin_amdgcn_s_barrier(); asm volatile("" ::: "memory");
        { const Conv8Item t4 = P0_ITEM(i + 4); conv8_dma(t4, F.lds + bn * 32768, F.wave, F.lane); }
        conv8_out(cur, (const LAS float*)(F.lds + bi * 32768), F.tid);
        cur = P0_ITEM(i + 1);
        bi = (bi == 4) ? 0 : bi + 1; bn = (bn == 4) ? 0 : bn + 1;
    }
#undef P0_ITEM
    asm volatile("s_waitcnt vmcnt(0)" ::: "memory");
    __syncthreads();
    for (int u = F.tid; u < (LDS_BYTES - LDSCTL_OFF) / 4; u += NWAVES * 64) ((LAS unsigned*)(F.lds + LDSCTL_OFF))[u] = 0u;
    __syncthreads();
}
constexpr int LRU_LDS_PER_WAVE = 16384, LRU_XG_OFF = 9728;
__device__ __forceinline__ float gelu_tanh_f(float x) { return x * fast_sigmoid(1.5957691216057308f * (x + 0.044715f * x * x * x)); }
template <bool PASSB>
__device__ __forceinline__ void lru_item(Frame& F, const Args& A, int item) {
    const int n = item & 15, ck = (item >> 4) & 31, b = item >> 9;
    const int lane = F.lane, l15 = lane & 15, q = lane >> 4;
    unsigned char* ws = F.ws;
    const bf16_t* Z = (const bf16_t*)(ws + WS_Z);
    LAS bf16_t* xl = (LAS bf16_t*)(F.lds + F.wave * LRU_LDS_PER_WAVE);
    LAS bf16_t* xgl = (LAS bf16_t*)(F.lds + F.wave * LRU_LDS_PER_WAVE + LRU_XG_OFF);
    const int t0 = ck * 64; const size_t tokbase = (size_t)b * SEQ;
    float* AS = (float*)(ws + WS_LRUS); float* HS = AS + (size_t)NB * 32 * 1024;
#pragma unroll
    for (int j0 = 0; j0 < 72; j0 += 8) { const int j = j0 + (lane >> 3), t = t0 - 3 + j;
        u32x4 v = (u32x4){0u, 0u, 0u, 0u};
        if (j < 67 && t >= 0) v = *(const GAS u32x4*)(Z + (tokbase + t) * ZW + ZC_XR + n * 64 + (lane & 7) * 8);
        if (j < 67) *(LAS u32x4*)(xl + j * 72 + (lane & 7) * 8) = v; }
    u32x4 xg0[4], xg1[4];
    if (PASSB) {
#pragma unroll
        for (int i = 0; i < 4; ++i) { const int r = 8 * i + (lane >> 3);
            xg0[i] = *(const GAS u32x4*)(Z + (tokbase + t0 + r) * ZW + ZC_XG + n * 64 + (lane & 7) * 8);
            xg1[i] = *(const GAS u32x4*)(Z + (tokbase + t0 + 32 + r) * ZW + ZC_XG + n * 64 + (lane & 7) * 8); }
#pragma unroll
        for (int i = 0; i < 4; ++i) *(LAS u32x4*)(xgl + (8 * i + (lane >> 3)) * 72 + (lane & 7) * 8) = xg0[i];
    }
    const bf16_t* wrg = (const bf16_t*)(ws + WS_SMALL + SM_WRG) + (size_t)n * 4096; const bf16_t* wig = (const bf16_t*)(ws + WS_SMALL + SM_WIG) + (size_t)n * 4096;
    bf16x8 fr_[4][2], fi_[4][2]; float brg[4], big[4], c8[4];
#pragma unroll
    for (int nt = 0; nt < 4; ++nt) {
#pragma unroll
        for (int s = 0; s < 2; ++s) { fr_[nt][s] = *(const GAS bf16x8*)(wrg + (16 * nt + l15) * 64 + 32 * s + 8 * q); fi_[nt][s] = *(const GAS bf16x8*)(wig + (16 * nt + l15) * 64 + 32 * s + 8 * q); }
        const int ch = n * 64 + 16 * nt + l15; brg[nt] = A.in[15][ch]; big[nt] = A.in[17][ch];
        const float L = A.in[18][ch]; const float sp = (L < 0.f) ? (-L + log1pf(__expf(L))) : log1pf(__expf(-L)); c8[nt] = -8.f * sp; }
    LDS_WAIT();
    { const int ch = n * 64 + lane; const float w0 = A.in[12][ch], w1 = A.in[12][1024 + ch], w2 = A.in[12][2048 + ch], w3 = A.in[12][3072 + ch], cb = A.in[13][ch];
      float x0 = bf2f(xl[lane]), x1 = bf2f(xl[72 + lane]), x2 = bf2f(xl[144 + lane]);
#pragma unroll 8
      for (int t = 0; t < 64; ++t) { const float x3 = bf2f(xl[(t + 3) * 72 + lane]); const float xc = cb + w0 * x0 + w1 * x1 + w2 * x2 + w3 * x3; xl[t * 72 + lane] = (bf16_t)f2bf(xc); x0 = x1; x1 = x2; x2 = x3; } }
    LDS_WAIT();
    float carry[4], atot[4];
#pragma unroll
    for (int nt = 0; nt < 4; ++nt) { carry[nt] = 0.f; atot[nt] = 1.f; }
    if (PASSB) {
#pragma unroll 1
        for (int j0 = 0; j0 < ck; j0 += 8) {
            float ta[8][4], th[8][4];
#pragma unroll
            for (int jj = 0; jj < 8; ++jj) { const int j = (j0 + jj < ck) ? j0 + jj : ck - 1;
#pragma unroll
                for (int nt = 0; nt < 4; ++nt) { const size_t o = ((size_t)b * 32 + j) * 1024 + n * 64 + 16 * nt + l15; ta[jj][nt] = AS[o]; th[jj][nt] = HS[o]; } }
#pragma unroll
            for (int jj = 0; jj < 8; ++jj) { if (j0 + jj < ck) {
#pragma unroll
                for (int nt = 0; nt < 4; ++nt) carry[nt] = ta[jj][nt] * carry[nt] + th[jj][nt]; } }
        }
    }
    float gout[4];
#pragma unroll
    for (int nt = 0; nt < 4; ++nt) gout[nt] = PASSB ? A.in[20][n * 64 + 16 * nt + l15] : 0.f;
#pragma unroll 1
    for (int mt = 0; mt < 4; ++mt) {
        const bf16x8 a0 = *(const LAS bf16x8*)(xl + (16 * mt + l15) * 72 + 8 * q), a1 = *(const LAS bf16x8*)(xl + (16 * mt + l15) * 72 + 32 + 8 * q);
        float xg[4][4];
        if (PASSB) {
            if (mt == 2) {
                LDS_WAIT();
#pragma unroll
                for (int i = 0; i < 4; ++i) *(LAS u32x4*)(xgl + (8 * i + (lane >> 3)) * 72 + (lane & 7) * 8) = xg1[i];
                LDS_WAIT();
            }
#pragma unroll
            for (int nt = 0; nt < 4; ++nt)
#pragma unroll
                for (int r = 0; r < 4; ++r) xg[nt][r] = bf2f(xgl[(16 * (mt & 1) + 4 * q + r) * 72 + 16 * nt + l15]);
        }
        float ss[4] = {0.f, 0.f, 0.f, 0.f};
#pragma unroll
        for (int nt = 0; nt < 4; ++nt) {
            f32x4 ar = (f32x4){0.f, 0.f, 0.f, 0.f}, ai = ar;
            ar = __builtin_amdgcn_mfma_f32_16x16x32_bf16(a0, fr_[nt][0], ar, 0, 0, 0); ar = __builtin_amdgcn_mfma_f32_16x16x32_bf16(a1, fr_[nt][1], ar, 0, 0, 0);
            ai = __builtin_amdgcn_mfma_f32_16x16x32_bf16(a0, fi_[nt][0], ai, 0, 0, 0); ai = __builtin_amdgcn_mfma_f32_16x16x32_bf16(a1, fi_[nt][1], ai, 0, 0, 0);
            float av[4], uv[4];
#pragma unroll
            for (int r = 0; r < 4; ++r) {
                const float rg = fast_sigmoid(ar[r] + brg[nt]), ig = fast_sigmoid(ai[r] + big[nt]);
                const float la = c8[nt] * rg; av[r] = __expf(la);
                uv[r] = sqrtf(fmaxf(1.f - av[r] * av[r], 0.f)) * ig * bf2f(xl[(16 * mt + 4 * q + r) * 72 + 16 * nt + l15]);
            }
            const float A4 = (av[0] * av[1]) * (av[2] * av[3]);
            const float H4 = ((uv[0] * av[1] + uv[1]) * av[2] + uv[2]) * av[3] + uv[3];
            float hin = carry[nt], hc = carry[nt], ap = 1.f;
#pragma unroll
            for (int qq = 0; qq < 4; ++qq) { const float Aq = __shfl(A4, l15 + 16 * qq), Hq = __shfl(H4, l15 + 16 * qq);
                hc = Aq * hc + Hq; ap *= Aq; if (qq < q) hin = Aq * hin + Hq; }
            carry[nt] = hc; atot[nt] *= ap;
            if (PASSB) {
                float h = hin;
#pragma unroll
                for (int r = 0; r < 4; ++r) { h = av[r] * h + uv[r]; const float o = h * gelu_tanh_f(xg[nt][r]); ss[r] += o * o;
                    (ws + WS_A2)[(tokbase + t0 + 16 * mt + 4 * q + r) * DM + 1024 + n * 64 + 16 * nt + l15] = (unsigned char)(pk4_fp8c(o * gout[nt] * A2_SCALE, 0.f, 0.f, 0.f) & 0xffu); }
            }
        }
        if (PASSB) {
#pragma unroll
            for (int r = 0; r < 4; ++r) { float v = ss[r]; v += __shfl_xor(v, 1); v += __shfl_xor(v, 2); v += __shfl_xor(v, 4); v += __shfl_xor(v, 8);
                if (l15 == 0) ((float*)(ws + WS_SSL))[(tokbase + t0 + 16 * mt + 4 * q + r) * 16 + n] = v; }
        }
    }
    if (!PASSB) { if (q == 0) {
#pragma unroll
        for (int nt = 0; nt < 4; ++nt) { const size_t o = ((size_t)b * 32 + ck) * 1024 + n * 64 + 16 * nt + l15; AS[o] = atot[nt]; HS[o] = carry[nt]; } } }
    LDS_WAIT();
}
constexpr float C2 = 0.125f * 1.4426950408889634f;
__device__ __forceinline__ int crow(int r, int hi) { return (r & 3) + 8 * (r >> 2) + 4 * hi; }

__device__ __forceinline__ void prep_item(Frame& F, const Args& A, int item) {
    const int b = item >> 5, tl = item & 31; const size_t tok0 = (size_t)b * SEQ + tl * 64;
    unsigned char* ws = F.ws; bf16_t* Z = (bf16_t*)(ws + WS_Z);
    const int tid = F.tid;
    u32x4 qv[16];
    const f32x4 qga = *(const GAS f32x4*)(A.in[10] + (tid & 7) * 8), qgb = *(const GAS f32x4*)(A.in[10] + (tid & 7) * 8 + 4);
#pragma unroll
    for (int it = 0; it < 16; ++it) { const int u = it * 512 + tid, c = u & 7, h = (u >> 3) & 15, r = u >> 7; qv[it] = *(const GAS u32x4*)(Z + (tok0 + r) * ZW + h * 64 + c * 8); }
#pragma unroll
    for (int it = 0; it < 16; ++it) {
        const int u = it * 512 + tid, c = u & 7, h = (u >> 3) & 15, r = u >> 7;
        bf16_t* p = Z + (tok0 + r) * ZW + h * 64 + c * 8;
        const u32x4 v = qv[it];
        float f[8] = {bflo(v.x), bfhi(v.x), bflo(v.y), bfhi(v.y), bflo(v.z), bfhi(v.z), bflo(v.w), bfhi(v.w)};
        float ss = 0.f;
#pragma unroll
        for (int j = 0; j < 8; ++j) ss += f[j] * f[j];
        ss += __shfl_xor(ss, 1); ss += __shfl_xor(ss, 2); ss += __shfl_xor(ss, 4);
        const float rs = rsqrtf(ss * (1.f / 64.f) + EPS) * C2;
        const f32x4 ga = qga, gb = qgb;
        u32x4 o; o.x = pk2(f[0] * rs * ga.x, f[1] * rs * ga.y); o.y = pk2(f[2] * rs * ga.z, f[3] * rs * ga.w); o.z = pk2(f[4] * rs * gb.x, f[5] * rs * gb.y); o.w = pk2(f[6] * rs * gb.z, f[7] * rs * gb.w);
        *(GAS u32x4*)p = o;
    }
    { const int c = tid & 7, r = tid >> 3;
      u32x4 kv[2][4]; f32x4 kga[2], kgb[2];
#pragma unroll
      for (int br = 0; br < 2; ++br) { const float* kg = A.in[11] + (1 + br) * 64 + c * 8; kga[br] = *(const GAS f32x4*)kg; kgb[br] = *(const GAS f32x4*)(kg + 4); }
#pragma unroll
      for (int br = 0; br < 2; ++br)
#pragma unroll
        for (int g = 0; g < 4; ++g) kv[br][g] = *(const GAS u32x4*)(Z + (tok0 + r) * ZW + (br ? ZC_KW : ZC_KS) + g * 64 + c * 8);
#pragma unroll
      for (int br = 0; br < 2; ++br)
#pragma unroll
        for (int g = 0; g < 4; ++g) {
            const u32x4 v = kv[br][g];
            float f[8] = {bflo(v.x), bfhi(v.x), bflo(v.y), bfhi(v.y), bflo(v.z), bfhi(v.z), bflo(v.w), bfhi(v.w)};
            float ss = 0.f;
#pragma unroll
            for (int j = 0; j < 8; ++j) ss += f[j] * f[j];
            ss += __shfl_xor(ss, 1); ss += __shfl_xor(ss, 2); ss += __shfl_xor(ss, 4);
            const float rs = rsqrtf(ss * (1.f / 64.f) + EPS);
            const f32x4 ga = kga[br], gb = kgb[br];
            u32x4 o; o.x = pk2(f[0] * rs * ga.x, f[1] * rs * ga.y); o.y = pk2(f[2] * rs * ga.z, f[3] * rs * ga.w); o.z = pk2(f[4] * rs * gb.x, f[5] * rs * gb.y); o.w = pk2(f[6] * rs * gb.z, f[7] * rs * gb.w);
            unsigned char* img = ws + WS_KIMG + (br ? KI_KW : KI_KS) + ((size_t)(b * 4 + g) * 32 + tl) * 8192;
            *(GAS u32x4*)(img + c * 1024 + r * 16) = o;
        }
    }
    { LAS bf16_t* vt = (LAS bf16_t*)F.lds;
      const int c = tid & 7, r = tid >> 3;
      u32x4 vv[8];
#pragma unroll
      for (int k = 0; k < 8; ++k) { const int br = k >> 2, g = k & 3; vv[k] = *(const GAS u32x4*)(Z + (tok0 + r) * ZW + (br ? ZC_VW : ZC_VS) + g * 64 + c * 8); }
      asm volatile("" : "+v"(vv[0]), "+v"(vv[1]), "+v"(vv[2]), "+v"(vv[3]), "+v"(vv[4]), "+v"(vv[5]), "+v"(vv[6]), "+v"(vv[7]));
#pragma unroll
      for (int k = 0; k < 8; ++k) *(LAS u32x4*)(vt + k * 4608 + r * 72 + c * 8) = vv[k];
      __syncthreads();
#pragma unroll
      for (int k = 0; k < 8; ++k) { const int br = k >> 2, g = k & 3;
          unsigned char* img = ws + WS_KIMG + (br ? KI_VW : KI_VS) + ((size_t)(b * 4 + g) * 32 + tl) * 8192;
#pragma unroll
          for (int hlf = 0; hlf < 2; ++hlf) { const int un = hlf * 512 + tid, kc = un >> 6, d = un & 63;
              const LAS bf16_t* s = vt + k * 4608 + (4 * kc) * 72 + d;
              u32x2 o; o.x = (unsigned)s[0] | ((unsigned)s[72] << 16); o.y = (unsigned)s[144] | ((unsigned)s[216] << 16);
              *(GAS u32x2*)(img + kc * 512 + d * 8) = o; } }
      __syncthreads(); }
}
__device__ __forceinline__ void compress_item(Frame& F, const Args& A, int item) {
    const int which = item & 1, cg = (item >> 1) & 7, g = (item >> 4) & 3, b = item >> 6;
    const int lane = F.lane, l15 = lane & 15, q = lane >> 4, c0 = cg * 16;
    unsigned char* ws = F.ws; const bf16_t* Z = (const bf16_t*)(ws + WS_Z);
    const bf16_t* WT = (const bf16_t*)(ws + WS_SMALL + (which ? SM_WCV : SM_WCK));
    const int zc = (which ? ZC_VC : ZC_KC) + g * 64;
    f32x4 acc[4];
#pragma unroll
    for (int nt = 0; nt < 4; ++nt) acc[nt] = (f32x4){0.f, 0.f, 0.f, 0.f};
    size_t tb = (size_t)b * SEQ + 16 * (c0 + l15);
#pragma unroll 1
    for (int s0 = 0; s0 < 64; s0 += 4) {
        bf16x8 xv[4], wv[4][4];
#pragma unroll
        for (int ss = 0; ss < 4; ++ss) { const int s = s0 + ss;
            size_t trow = tb + (s >> 1); if (trow > (size_t)b * SEQ + SEQ - 1) trow = (size_t)b * SEQ + SEQ - 1;
            xv[ss] = *(const GAS bf16x8*)(Z + trow * ZW + zc + 32 * (s & 1) + 8 * q);
#pragma unroll
            for (int nt = 0; nt < 4; ++nt) wv[ss][nt] = *(const GAS bf16x8*)(WT + (size_t)(16 * nt + l15) * DM + 32 * s + 8 * q); }
        asm volatile("" : "+v"(xv[0]), "+v"(xv[1]), "+v"(wv[0][0]), "+v"(wv[0][1]), "+v"(wv[0][2]), "+v"(wv[0][3]), "+v"(wv[1][0]), "+v"(wv[1][1]), "+v"(wv[1][2]), "+v"(wv[1][3]) :: "memory");
        asm volatile("" : "+v"(xv[2]), "+v"(xv[3]), "+v"(wv[2][0]), "+v"(wv[2][1]), "+v"(wv[2][2]), "+v"(wv[2][3]), "+v"(wv[3][0]), "+v"(wv[3][1]), "+v"(wv[3][2]), "+v"(wv[3][3]) :: "memory");
#pragma unroll
        for (int ss = 0; ss < 4; ++ss)
#pragma unroll
            for (int nt = 0; nt < 4; ++nt) {
                if (which == 0) acc[nt] = __builtin_amdgcn_mfma_f32_16x16x32_bf16(wv[ss][nt], xv[ss], acc[nt], 0, 0, 0);
                else            acc[nt] = __builtin_amdgcn_mfma_f32_16x16x32_bf16(xv[ss], wv[ss][nt], acc[nt], 0, 0, 0); }
    }
    if (which == 0) {
        const float* bias = (const float*)(ws + WS_SMALL + SM_BIASK);
        float ss = 0.f;
#pragma unroll
        for (int nt = 0; nt < 4; ++nt) { const f32x4 bv = *(const GAS f32x4*)(bias + 16 * nt + 4 * q); acc[nt] += bv; ss += (acc[nt].x * acc[nt].x + acc[nt].y * acc[nt].y) + (acc[nt].z * acc[nt].z + acc[nt].w * acc[nt].w); }
        ss += __shfl_xor(ss, 16); ss += __shfl_xor(ss, 32);
        const float rs = rsqrtf(ss * (1.f / 64.f) + EPS);
        const int c = c0 + l15, T = c >> 6, r = c & 63;
        unsigned char* img = ws + WS_KIMG + KI_KC + ((size_t)(b * 4 + g) * 2 + T) * 8192;
#pragma unroll
        for (int nt = 0; nt < 4; ++nt) { const f32x4 kg = *(const GAS f32x4*)(A.in[11] + 16 * nt + 4 * q);
            u32x2 o; o.x = pk2(acc[nt].x * rs * kg.x, acc[nt].y * rs * kg.y); o.y = pk2(acc[nt].z * rs * kg.z, acc[nt].w * rs * kg.w);
            if (c == 127) { o.x = 0u; o.y = 0u; }
            *(GAS u32x2*)(img + (2 * nt + (q >> 1)) * 1024 + r * 16 + (q & 1) * 8) = o; }
    } else {
        const float* bias = (const float*)(ws + WS_SMALL + SM_BIASV);
        const int cb = c0 + 4 * q, T = cb >> 6, kc = (cb & 63) >> 2;
        unsigned char* img = ws + WS_KIMG + KI_VC + ((size_t)(b * 4 + g) * 2 + T) * 8192;
#pragma unroll
        for (int nt = 0; nt < 4; ++nt) { const float bv = bias[16 * nt + l15];
            float v3 = acc[nt].w + bv; if (cb + 3 == 127) v3 = 0.f;
            u32x2 o; o.x = pk2(acc[nt].x + bv, acc[nt].y + bv); o.y = pk2(acc[nt].z + bv, v3);
            *(GAS u32x2*)(img + kc * 512 + (16 * nt + l15) * 8) = o; }
    }
}

constexpr int AT_SLOT = 16384, AT_IMP = 65536, AT_OT = 98304, AT_SEL = TILETAB_OFF, AT_SS = TILETAB_OFF + 256, AT_OST = 0;
__device__ __forceinline__ void at_stage(LAS unsigned char* lds, int slot, const unsigned char* kimg, const unsigned char* vimg, int wave, int lane) {
    __builtin_amdgcn_global_load_lds((const unsigned*)(kimg + wave * 1024 + lane * 16), (LAS unsigned*)(lds + slot * AT_SLOT + wave * 1024), 16, 0, 0);
    __builtin_amdgcn_global_load_lds((const unsigned*)(vimg + wave * 1024 + lane * 16), (LAS unsigned*)(lds + slot * AT_SLOT + 8192 + wave * 1024), 16, 0, 0);
}
__device__ __forceinline__ void at_qkt(f32x16& p0, f32x16& p1, const LAS unsigned char* ks, const bf16x8 (&qr)[4], const f32x16& cin, int r32, int hi) {
#pragma unroll
    for (int d0 = 0; d0 < 4; ++d0) {
        const bf16x8 k0 = *(const LAS bf16x8*)(ks + (2 * d0 + hi) * 1024 + r32 * 16), k1 = *(const LAS bf16x8*)(ks + (2 * d0 + hi) * 1024 + 512 + r32 * 16);
        if (d0 == 0) { p0 = __builtin_amdgcn_mfma_f32_32x32x16_bf16(k0, qr[0], cin, 0, 0, 0); p1 = __builtin_amdgcn_mfma_f32_32x32x16_bf16(k1, qr[0], cin, 0, 0, 0); }
        else { p0 = __builtin_amdgcn_mfma_f32_32x32x16_bf16(k0, qr[d0], p0, 0, 0, 0); p1 = __builtin_amdgcn_mfma_f32_32x32x16_bf16(k1, qr[d0], p1, 0, 0, 0); }
    }
}
__device__ __forceinline__ bf16x8 at_pack8(const f32x16& p, int base) {
    u32x4 w; w.x = cvt_pk_bf16(p[base], p[base + 1]); w.y = cvt_pk_bf16(p[base + 2], p[base + 3]); w.z = cvt_pk_bf16(p[base + 4], p[base + 5]); w.w = cvt_pk_bf16(p[base + 6], p[base + 7]);
    return __builtin_bit_cast(bf16x8, w);
}
__device__ __forceinline__ void at_pvp(f32x16 (&o)[2], bf16x8 pa0, bf16x8 pa1, bf16x8 pa2, bf16x8 pa3, const LAS unsigned char* vs, int r32, int hi) {
#pragma unroll
    for (int d0 = 0; d0 < 2; ++d0) {
        const LAS unsigned char* vb = vs + (32 * d0 + r32) * 8 + hi * 512;
#pragma unroll
        for (int s = 0; s < 4; ++s) {
            const s16x4 lo = *(const LAS s16x4*)(vb + (4 * s) * 512), h4 = *(const LAS s16x4*)(vb + (4 * s + 2) * 512);
            const bf16x8 vf = (bf16x8){lo[0], lo[1], lo[2], lo[3], h4[0], h4[1], h4[2], h4[3]};
            o[d0] = __builtin_amdgcn_mfma_f32_32x32x16_bf16(s == 0 ? pa0 : s == 1 ? pa1 : s == 2 ? pa2 : pa3, vf, o[d0], 0, 0, 0);
        }
    }
}
__device__ __forceinline__ void at_pv(f32x16 (&o)[2], const f32x16& p0, const f32x16& p1, const LAS unsigned char* vs, int r32, int hi) {
    at_pvp(o, at_pack8(p0, 0), at_pack8(p0, 8), at_pack8(p1, 0), at_pack8(p1, 8), vs, r32, hi);
}
__device__ __forceinline__ void at_tile(const LAS unsigned char* slot, const LAS unsigned char* ql, f32x16 (&o)[2], float& l, bool usekill, bool kill, bool masked, int kvlo, int kvhi, int r32, int hi) {
    bf16x8 kf[8];
#pragma unroll
    for (int d0 = 0; d0 < 4; ++d0) { kf[2 * d0] = *(const LAS bf16x8*)(slot + (2 * d0 + hi) * 1024 + r32 * 16); kf[2 * d0 + 1] = *(const LAS bf16x8*)(slot + (2 * d0 + hi) * 1024 + 512 + r32 * 16); }
    bf16x8 q4[4];
#pragma unroll
    for (int d0 = 0; d0 < 4; ++d0) q4[d0] = *(const LAS bf16x8*)(ql + d0 * 1024);
    const f32x16 zero16 = (f32x16){0.f, 0.f, 0.f, 0.f, 0.f, 0.f, 0.f, 0.f, 0.f, 0.f, 0.f, 0.f, 0.f, 0.f, 0.f, 0.f};
    f32x16 p0 = __builtin_amdgcn_mfma_f32_32x32x16_bf16(kf[0], q4[0], zero16, 0, 0, 0), p1 = __builtin_amdgcn_mfma_f32_32x32x16_bf16(kf[1], q4[0], zero16, 0, 0, 0);
#pragma unroll
    for (int d0 = 1; d0 < 4; ++d0) { p0 = __builtin_amdgcn_mfma_f32_32x32x16_bf16(kf[2 * d0], q4[d0], p0, 0, 0, 0); p1 = __builtin_amdgcn_mfma_f32_32x32x16_bf16(kf[2 * d0 + 1], q4[d0], p1, 0, 0, 0); }
    s16x4 vlo[2][4], vhi[2][4];
    const LAS unsigned char* vs = slot + 8192;
#pragma unroll
    for (int d0 = 0; d0 < 2; ++d0) { const LAS unsigned char* vb = vs + (32 * d0 + r32) * 8 + hi * 512;
#pragma unroll
        for (int s = 0; s < 4; ++s) { vlo[d0][s] = *(const LAS s16x4*)(vb + (4 * s) * 512); vhi[d0][s] = *(const LAS s16x4*)(vb + (4 * s + 2) * 512); } }
    if (masked) {
#pragma unroll
        for (int r = 0; r < 16; ++r) { const int kv = crow(r, hi);
            if (kv < kvlo || kv > kvhi) p0[r] = -INFINITY;
            if (kv + 32 < kvlo || kv + 32 > kvhi) p1[r] = -INFINITY; }
    }
    float s = 0.f;
#pragma unroll
    for (int r = 0; r < 16; ++r) { p0[r] = __builtin_amdgcn_exp2f(p0[r]); p1[r] = __builtin_amdgcn_exp2f(p1[r]); s += p0[r] + p1[r]; }
    u32x4 w0, w1, w2, w3;
    w0.x = cvt_pk_bf16(p0[0], p0[1]); w0.y = cvt_pk_bf16(p0[2], p0[3]); w0.z = cvt_pk_bf16(p0[4], p0[5]); w0.w = cvt_pk_bf16(p0[6], p0[7]);
    w1.x = cvt_pk_bf16(p0[8], p0[9]); w1.y = cvt_pk_bf16(p0[10], p0[11]); w1.z = cvt_pk_bf16(p0[12], p0[13]); w1.w = cvt_pk_bf16(p0[14], p0[15]);
    w2.x = cvt_pk_bf16(p1[0], p1[1]); w2.y = cvt_pk_bf16(p1[2], p1[3]); w2.z = cvt_pk_bf16(p1[4], p1[5]); w2.w = cvt_pk_bf16(p1[6], p1[7]);
    w3.x = cvt_pk_bf16(p1[8], p1[9]); w3.y = cvt_pk_bf16(p1[10], p1[11]); w3.z = cvt_pk_bf16(p1[12], p1[13]); w3.w = cvt_pk_bf16(p1[14], p1[15]);
    if (usekill) { const unsigned km = kill ? 0u : 0xffffffffu; s = kill ? 0.f : s;
        w0 = w0 & km; w1 = w1 & km; w2 = w2 & km; w3 = w3 & km; }
    l += s;
#pragma unroll
    for (int d0 = 0; d0 < 2; ++d0)
#pragma unroll
        for (int s4 = 0; s4 < 4; ++s4) { const bf16x8 vf = (bf16x8){vlo[d0][s4][0], vlo[d0][s4][1], vlo[d0][s4][2], vlo[d0][s4][3], vhi[d0][s4][0], vhi[d0][s4][1], vhi[d0][s4][2], vhi[d0][s4][3]};
            o[d0] = __builtin_amdgcn_mfma_f32_32x32x16_bf16(__builtin_bit_cast(bf16x8, s4 == 0 ? w0 : s4 == 1 ? w1 : s4 == 2 ? w2 : w3), vf, o[d0], 0, 0, 0); }
}

__device__ __forceinline__ void attn_unit(Frame& F, const Args& A, int b, int g, int qblk) {
    const int tid = F.tid, lane = F.lane, r32 = lane & 31, hi = lane >> 5, wid = F.wave, hh = wid >> 1, th = wid & 1, h = 4 * g + hh;
    unsigned char* ws = F.ws; const bf16_t* Z = (const bf16_t*)(ws + WS_Z);
    LAS unsigned char* lds = F.lds;
    const int qs = qblk * 64, tq = 32 * th + r32, t = qs + tq; const size_t tok = (size_t)b * SEQ + t;
    const unsigned char* kimg_c = ws + WS_KIMG + KI_KC + (size_t)(b * 4 + g) * 2 * 8192;
    const int j0 = (qblk >= 8) ? qblk - 8 : 0, total = (qblk + 1) + (qblk - j0 + 1);
#define AT_STAGE_IT(itx) do { int _i = (itx); if (_i > total - 1) _i = total - 1; const bool _br = _i > qblk; const int _j = _br ? j0 + (_i - qblk - 1) : _i; \
        const unsigned char* _ki = ws + WS_KIMG + (_br ? KI_KW : KI_KS) + ((size_t)(b * 4 + g) * 32 + _j) * 8192; at_stage(lds, ((itx) + 2) & 3, _ki, _ki + (KI_VS - KI_KS), wid, lane); } while (0)
    at_stage(lds, 0, kimg_c, kimg_c + (KI_VC - KI_KC), wid, lane); at_stage(lds, 1, kimg_c + 8192, kimg_c + 8192 + (KI_VC - KI_KC), wid, lane);
    AT_STAGE_IT(0); AT_STAGE_IT(1);
    bf16x8 qr[4];
#pragma unroll
    for (int d0 = 0; d0 < 4; ++d0) qr[d0] = *(const GAS bf16x8*)(Z + tok * ZW + h * 64 + 16 * d0 + 8 * hi);
    const bf16_t* glp = Z + tok * ZW + ZC_GL + h * 3;
    const float g0 = fast_sigmoid(bf2f(glp[0])), g1 = fast_sigmoid(bf2f(glp[1])), g2 = fast_sigmoid(bf2f(glp[2]));
    asm volatile("s_waitcnt vmcnt(0)" ::: "memory"); __builtin_amdgcn_s_barrier();
    {
        const int cmax = (t >= 31) ? ((t - 31) >> 4) : -1;
        f32x16 oc[2];
#pragma unroll
        for (int r = 0; r < 16; ++r) { oc[0][r] = 0.f; oc[1][r] = 0.f; }
        float l = 0.f, xprev = 0.f;
        LAS float* impw = (LAS float*)(lds + AT_IMP) + (size_t)(hh * 64 + tq) * 32;
#pragma unroll 1
        for (int T = 0; T < 2; ++T) {
            f32x16 p0, p1;
            { const f32x16 zero = (f32x16){0.f, 0.f, 0.f, 0.f, 0.f, 0.f, 0.f, 0.f, 0.f, 0.f, 0.f, 0.f, 0.f, 0.f, 0.f, 0.f}; at_qkt(p0, p1, lds + T * AT_SLOT, qr, zero, r32, hi); }
            float s = 0.f;
#pragma unroll
            for (int r = 0; r < 16; ++r) { const int c = 64 * T + crow(r, hi); if (c > cmax) p0[r] = -INFINITY; if (c + 32 > cmax) p1[r] = -INFINITY;
                p0[r] = __builtin_amdgcn_exp2f(p0[r]); p1[r] = __builtin_amdgcn_exp2f(p1[r]); s += p0[r] + p1[r]; }
            l += s;
#pragma unroll
            for (int u = 0; u < 2; ++u)
#pragma unroll
                for (int rr = 0; rr < 4; ++rr) {
                    const float a0 = u ? p1[4 * rr] : p0[4 * rr], a1 = u ? p1[4 * rr + 1] : p0[4 * rr + 1], a2 = u ? p1[4 * rr + 2] : p0[4 * rr + 2], a3 = u ? p1[4 * rr + 3] : p0[4 * rr + 3];
                    const float xc = __shfl_xor(a3, 32);
                    impw[2 * (8 * T + 4 * u + rr) + hi] = ((a0 + a1) + (a2 + a3)) + (hi ? xc : xprev);
                    xprev = xc;
                }
            at_pv(oc, p0, p1, lds + T * AT_SLOT + 8192, r32, hi);
        }
        l += __shfl_xor(l, 32);
        const float inv = (l > 0.f) ? 1.f / l : 0.f;
#pragma unroll
        for (int i = 0; i < 16; ++i) impw[2 * i + hi] *= inv;
        const float sc = g0 * inv;
        { LAS unsigned* otp = (LAS unsigned*)(lds + AT_OT + wid * 4096) + lane;
#pragma unroll
          for (int r = 0; r < 16; r += 2) { const float f0 = __shfl(sc, crow(r, hi)), f1 = __shfl(sc, crow(r + 1, hi));
              otp[(r >> 1) * 64] = cvt_pk_bf16(oc[0][r] * f0, oc[0][r + 1] * f1); otp[(8 + (r >> 1)) * 64] = cvt_pk_bf16(oc[1][r] * f0, oc[1][r + 1] * f1); } }
    }
    asm volatile("s_waitcnt lgkmcnt(0)" ::: "memory"); __builtin_amdgcn_s_barrier();
    AT_STAGE_IT(2);
    if (tid < 64) {
        const LAS float* ip = (const LAS float*)(lds + AT_IMP) + tid * 32;
        float v[32];
#pragma unroll
        for (int j = 0; j < 32; ++j) v[j] = ((ip[j] + ip[64 * 32 + j]) + ip[2 * 64 * 32 + j]) + ip[3 * 64 * 32 + j];
        unsigned mask;
        if (qblk < 8) mask = (2u << qblk) - 1u;
        else {
#pragma unroll
            for (int j = 0; j < 32; ++j) { const bool forced = (j == 0) || (j == qblk) || (j == qblk - 1); v[j] = forced ? 1e30f : ((j <= qblk) ? v[j] : -1e30f); }
            mask = 0u;
#pragma unroll 1
            for (int k = 0; k < 8; ++k) {
                float bv = -INFINITY; int bi = 0;
#pragma unroll
                for (int j = 0; j < 32; ++j) if (v[j] > bv) { bv = v[j]; bi = j; }
                mask |= 1u << bi;
#pragma unroll
                for (int j = 0; j < 32; ++j) if (j == bi) v[j] = -INFINITY;
            }
        }
        ((LAS unsigned*)(lds + AT_SEL))[tid] = mask;
    }
    asm volatile("s_waitcnt vmcnt(0) lgkmcnt(0)" ::: "memory"); __builtin_amdgcn_s_barrier();
    const unsigned selm = ((const LAS unsigned*)(lds + AT_SEL))[tq];
    const LAS unsigned char* ql = lds + AT_IMP + wid * 4096 + lane * 16;
#pragma unroll
    for (int d0 = 0; d0 < 4; ++d0) *(LAS bf16x8*)(lds + AT_IMP + wid * 4096 + d0 * 1024 + lane * 16) = qr[d0];
    asm volatile("s_waitcnt lgkmcnt(0)" ::: "memory");
    f32x16 o[2];
    {
#pragma unroll
        for (int r = 0; r < 16; ++r) { o[0][r] = 0.f; o[1][r] = 0.f; }
        float l = 0.f;
#pragma unroll 1
        for (int it = 0; it < total; ++it) {
            const int cur = (it + 2) & 3; const bool br = it > qblk; const int j = br ? j0 + (it - qblk - 1) : it;
            AT_STAGE_IT(it + 3);
            bool masked, kill; int kvlo, kvhi;
            if (!br) { masked = (j == qblk); kvlo = 0; kvhi = tq; kill = !((selm >> j) & 1u); }
            else { const bool first = (qblk >= 8) && (j == j0), lastt = (j == qblk); masked = first || lastt; kvlo = first ? tq + 1 : 0; kvhi = lastt ? tq : 63; kill = false; }
            at_tile(lds + cur * AT_SLOT, ql, o, l, !br, kill, masked, kvlo, kvhi, r32, hi);
            asm volatile("s_waitcnt vmcnt(4) lgkmcnt(0)" ::: "memory"); __builtin_amdgcn_s_barrier();
            if (it == qblk || it == total - 1) {
                l += __shfl_xor(l, 32);
                const float sc = (br ? g2 : g1) / l;
                LAS unsigned* otp = (LAS unsigned*)(lds + AT_OT + wid * 4096) + lane;
                if (!br) {
#pragma unroll
                    for (int r = 0; r < 16; r += 2) { const float f0 = __shfl(sc, crow(r, hi)), f1 = __shfl(sc, crow(r + 1, hi));
                        const unsigned a = otp[(r >> 1) * 64], c = otp[(8 + (r >> 1)) * 64];
                        otp[(r >> 1) * 64] = cvt_pk_bf16(bflo(a) + o[0][r] * f0, bfhi(a) + o[0][r + 1] * f1); otp[(8 + (r >> 1)) * 64] = cvt_pk_bf16(bflo(c) + o[1][r] * f0, bfhi(c) + o[1][r + 1] * f1);
                        o[0][r] = 0.f; o[0][r + 1] = 0.f; o[1][r] = 0.f; o[1][r + 1] = 0.f; }
                } else {
#pragma unroll
                    for (int r = 0; r < 16; r += 2) { const float f0 = __shfl(sc, crow(r, hi)), f1 = __shfl(sc, crow(r + 1, hi));
                        const unsigned a = otp[(r >> 1) * 64], c = otp[(8 + (r >> 1)) * 64];
                        o[0][r] = bflo(a) + o[0][r] * f0; o[0][r + 1] = bfhi(a) + o[0][r + 1] * f1; o[1][r] = bflo(c) + o[1][r] * f0; o[1][r + 1] = bfhi(c) + o[1][r + 1] * f1; }
                }
                l = 0.f;
            }
        }
    }
    asm volatile("s_waitcnt vmcnt(0)" ::: "memory"); __builtin_amdgcn_s_barrier();
#undef AT_STAGE_IT
    {
        LAS bf16_t* stg = (LAS bf16_t*)(lds + AT_OST + wid * 4096);
#pragma unroll
        for (int r = 0; r < 16; ++r) { const int orow = crow(r, hi); stg[orow * 64 + r32] = (bf16_t)f2bf(o[0][r]); stg[orow * 64 + 32 + r32] = (bf16_t)f2bf(o[1][r]); }
        asm volatile("s_waitcnt lgkmcnt(0)" ::: "memory");
        unsigned char* A2 = ws + WS_A2;
        const int ch = lane & 7;
        const f32x4 ga = *(const GAS f32x4*)(A.in[19] + h * 64 + ch * 8), gb = *(const GAS f32x4*)(A.in[19] + h * 64 + ch * 8 + 4);
        LAS float* ssl = (LAS float*)(lds + AT_SS);
#pragma unroll
        for (int i = 0; i < 4; ++i) { const int row = i * 8 + (lane >> 3);
            const u32x4 v = *(const LAS u32x4*)(stg + row * 64 + ch * 8);
            const float f[8] = {bflo(v.x), bfhi(v.x), bflo(v.y), bfhi(v.y), bflo(v.z), bfhi(v.z), bflo(v.w), bfhi(v.w)};
            float ss = 0.f;
#pragma unroll
            for (int j = 0; j < 8; ++j) ss += f[j] * f[j];
            ss += __shfl_xor(ss, 1); ss += __shfl_xor(ss, 2); ss += __shfl_xor(ss, 4);
            if (ch == 0) ssl[hh * 64 + 32 * th + row] = ss;
            u32x2 o; o.x = pk4_fp8c(f[0] * ga.x * A2_SCALE, f[1] * ga.y * A2_SCALE, f[2] * ga.z * A2_SCALE, f[3] * ga.w * A2_SCALE); o.y = pk4_fp8c(f[4] * gb.x * A2_SCALE, f[5] * gb.y * A2_SCALE, f[6] * gb.z * A2_SCALE, f[7] * gb.w * A2_SCALE);
            *(GAS u32x2*)(A2 + ((size_t)b * SEQ + qs + 32 * th + row) * DM + h * 64 + ch * 8) = o; }
        asm volatile("s_waitcnt lgkmcnt(0)" ::: "memory"); __builtin_amdgcn_s_barrier();
        if (tid < 64) ((float*)(ws + WS_SSN))[((size_t)b * SEQ + qs + tid) * 4 + g] = ((ssl[tid] + ssl[64 + tid]) + ssl[128 + tid]) + ssl[192 + tid];
        asm volatile("s_waitcnt lgkmcnt(0)" ::: "memory"); __builtin_amdgcn_s_barrier();
    }
}
constexpr bool W2_LATE = false;
constexpr int NCX = 10, JOIN_PH = 4, CONV_SPLIT = 3072;
__global__ void __launch_bounds__(NWAVES * 64, 2) mega(Args args) {
    extern __shared__ __attribute__((aligned(16))) unsigned char lds_raw[];
    Frame F;
    F.lds = (LAS unsigned char*)lds_raw;
    F.tid = threadIdx.x; F.lane = F.tid & 63; F.wave = __builtin_amdgcn_readfirstlane(F.tid >> 6);
    F.ws = args.ws; F.ctl = (gu32*)(args.ws + WS_CTL);
    unsigned char* ws = args.ws;
    for (int u = F.tid; u < (LDS_BYTES - LDSCTL_OFF) / 4; u += NWAVES * 64) ((LAS unsigned*)(F.lds + LDSCTL_OFF))[u] = 0u;
    __syncthreads();
    volatile LAS unsigned* MISC = (volatile LAS unsigned*)(F.lds + MISC_OFF);
    const int lo = args.ph_lo, hi = args.ph_hi;
    const int G0 = gridDim.x, bx0 = blockIdx.x;
    const int vcu0 = (G0 % 8 == 0) ? (bx0 % 8) * (G0 / 8) + bx0 / 8 : bx0;
    const bool part = (G0 == 256) && lo < JOIN_PH && hi > JOIN_PH;
    const int xl = vcu0 & 31, xx = vcu0 >> 5;
    const bool is_conv = part && xl >= 32 - NCX;
    const int GB = part ? G0 - 8 * NCX : G0, vcuB = part ? xx * (32 - NCX) + xl : vcu0, bxB = part ? xl * 8 + xx : bx0;
    const int cv = (xl - (32 - NCX)) * 8 + xx;
    const bool w2_late = W2_LATE && (G0 == 256) && lo == 0 && hi > 5;
    const bool conv5 = w2_late && xl >= 32 - NCX;
    XcdBarrier bar = xcd_barrier_post((unsigned*)(F.ctl + CW_BAR) + args.li * XCD_BAR_WORDS, MISC + 8, (unsigned)G0, true);
    XcdBarrier barB = xcd_barrier_post((unsigned*)(F.ctl + CW_BAR) + (8 + args.li) * XCD_BAR_WORDS, MISC + 10, (unsigned)GB, part && !is_conv);
#define IN(k) (lo <= (k) && (k) < hi)
#define BOTH(k) (IN(k) && IN((k) + 1))
#define GRID_BAR(k) do { if (part && (k) + 1 < JOIN_PH) xcd_barrier(barB); else xcd_barrier(bar); } while (0)
#define SET_ID(k) do { const bool sub_ = part && (k) < JOIN_PH; F.G = sub_ ? GB : G0; F.vcu = sub_ ? vcuB : vcu0; F.bx = sub_ ? bxB : bx0; gw = F.vcu * NWAVES + F.wave; NGW = F.G * NWAVES; gw2 = F.wave * F.G + F.vcu; } while (0)
    int gw, NGW, gw2;
    SET_ID(lo);
    const float* mod = (const float*)(ws + WS_MOD);

    if (IN(0)) {
        p0_experts(F, args, is_conv ? cv : F.vcu, is_conv ? 8 * NCX : F.G, is_conv ? CONV_SPLIT : 0, (part && !is_conv) ? CONV_SPLIT : (w2_late ? CONV_NIT1 : CONV_NITX));
        if (!is_conv) p0_prologue(F, args);
        if (!is_conv && BOTH(0)) GRID_BAR(0);
    }
    if (is_conv) { xcd_barrier(bar); }
    const bool skip_pre = is_conv;
    if (IN(1) && !(skip_pre && 1 < JOIN_PH)) {
        const float* modp = (const float*)(ws + WS_MODPART); float* modw = (float*)(ws + WS_MOD);
        if (F.bx == 0 && F.wave < 2) pebias_reduce((const float*)(ws + WS_PEPART) + F.wave * 2048, (float*)(ws + WS_SMALL + (F.wave ? SM_BIASV : SM_BIASK)), F.lane);
        for (int idx = F.bx * (NWAVES * 64) + F.tid; idx < NB * 6 * DM; idx += F.G * NWAVES * 64) modw[idx] = mod_reduce1(modp, args.in[3], idx);
        LAS float* lmod = (LAS float*)F.lds;
        const int rpb = ((NTOK + F.G - 1) / F.G + 7) & ~7, r0 = F.bx * rpb, r1 = (r0 + rpb < NTOK) ? r0 + rpb : NTOK;
        int curb = -1;
        f32x4 g1v[8];
#pragma unroll
        for (int j = 0; j < 8; ++j) g1v[j] = *((const GAS f32x4*)args.in[4] + F.lane + 64 * j);
        for (int rb = r0; rb < r1; rb += 8) {
            const int b = rb / SEQ;
            if (b != curb) { __syncthreads(); for (int i = F.tid; i < 2 * DM; i += NWAVES * 64) lmod[i] = mod_reduce1(modp, args.in[3], b * 6 * DM + i); curb = b; __syncthreads(); }
            const int row = rb + F.wave;
            if (row < r1) {
                const GAS f32x4* xr = (const GAS f32x4*)(args.in[0] + (size_t)row * DM) + F.lane;
                f32x4 v[8]; float s = 0.f;
#pragma unroll
                for (int j = 0; j < 8; ++j) { v[j] = xr[64 * j]; s += (v[j].x * v[j].x + v[j].y * v[j].y) + (v[j].z * v[j].z + v[j].w * v[j].w); }
                const float rstd = rsqrtf(wsum(s) * (1.f / DM) + EPS);
                GAS unsigned long long* o8 = (GAS unsigned long long*)((bf16_t*)(ws + WS_H) + (size_t)row * DM) + F.lane;
#pragma unroll
                for (int j = 0; j < 8; ++j) {
                    const f32x4 gg = g1v[j], sh = *((const LAS f32x4*)lmod + F.lane + 64 * j), sc = *((const LAS f32x4*)(lmod + DM) + F.lane + 64 * j);
                    const f32x4 hv = v[j] * rstd * gg * (sc + 1.f) + sh;
                    o8[64 * j] = (unsigned long long)pk2(hv.x, hv.y) | ((unsigned long long)pk2(hv.z, hv.w) << 32);
                }
            }
        }
        __syncthreads();
        if (BOTH(1)) GRID_BAR(1);
    }
    if (IN(2)) SET_ID(2);
    if (IN(2) && !(skip_pre && 2 < JOIN_PH)) {
        ProbZ P; P.ord.init(NTOK, ZW, F.G, F.bx); P.A = (const bf16_t*)(ws + WS_H); P.Bt = (const bf16_t*)(ws + WS_WIN); P.Z = (bf16_t*)(ws + WS_Z);
        g8::gemm_phase<ProbZ>(F.lds, P);
        if (BOTH(2)) GRID_BAR(2);
    }
    if (IN(3)) SET_ID(3);
    if (IN(3) && !(skip_pre && 3 < JOIN_PH)) {
        for (int it = F.bx; it < NB * 32; it += F.G) prep_item(F, args, it);
        for (int it = gw2; it < NB * 4 * 8 * 2; it += NGW) compress_item(F, args, it);
        for (int it = gw; it < NB * 32 * 16; it += NGW) lru_item<false>(F, args, it);
        if (BOTH(3)) GRID_BAR(3);
    }
    if (IN(4)) SET_ID(4);
    if (IN(4)) {
        {
            const bool bal = (F.G == 256); const int nu = bal ? 4 : (NB * 4 * 32 + F.G - 1 - F.bx) / F.G;
#pragma unroll 1
            for (int i = 0; i < nu; ++i) {
                int bg, qb;
                if (bal) { const int s = F.vcu & 7; bg = F.vcu >> 3; qb = (i == 0) ? 31 - s : (i == 1) ? 16 + s : (i == 2) ? 15 - s : s; }
                else { const int u = F.bx + i * F.G; bg = u & 31; qb = 31 - (u >> 5); }
                attn_unit(F, args, bg >> 2, bg & 3, qb);
            }
        }
        for (int it = gw; it < NB * 32 * 16; it += NGW) lru_item<true>(F, args, it);
        if (BOTH(4)) GRID_BAR(4);
    }
    if (IN(5) && conv5) { p0_experts(F, args, cv, 8 * NCX, CONV_NIT1, CONV_NIT); if (BOTH(5)) GRID_BAR(5); }
    if (IN(5) && !conv5) {
        if (w2_late) { F.G = GB; F.vcu = vcuB; F.bx = bxB; }
        ProbMix8 P; P.ord.init(NTOK, DM, F.G, F.bx); P.A8 = ws + WS_A2; P.W8 = ws + WS_WOUT; P.x = args.in[0]; P.mod = mod; P.x1b = (bf16_t*)(ws + WS_X1B);
        P.rs = (const LAS float*)(F.lds + RSTAB_OFF);
        p5_build_rstab(F, P.ord, (const float*)(ws + WS_SSN), (const float*)(ws + WS_SSL));
        g8::gemm8_phase<ProbMix8>(F.lds, P);
        if (BOTH(5)) GRID_BAR(5);
    }
    if (IN(6)) SET_ID(6);
    if (IN(6)) { p6_route(F, args, mod); if (BOTH(6)) GRID_BAR(6); }
    if (IN(7)) {
        build_tile_table(F);
        ProbM1F P; P.ord.tab = (const LAS int*)(F.lds + TILETAB_OFF); P.ord.G = F.G; P.ord.c = F.bx; P.ord.NPN = 16;
        P.H8 = ws + WS_H8; P.W1T8 = ws + WS_W1; P.b1 = args.in[26]; P.rowtok = (const int*)(ws + WS_ROUTE + RT_ROWTOK); P.ACT8 = ws + WS_ACT;
        g8::gemm8_phase<ProbM1F>(F.lds, P);
        if (BOTH(7)) GRID_BAR(7);
    }
    if (IN(8)) {
        build_tile_table(F);
        ProbM2F P; P.ord.tab = (const LAS int*)(F.lds + TILETAB_OFF); P.ord.G = F.G; P.ord.c = F.bx; P.ord.NPN = 8;
        P.ACT8 = ws + WS_ACT; P.W2T8 = ws + WS_W2; P.b2 = args.in[28]; P.rowg = (const float*)(ws + WS_ROUTE + RT_ROWG); P.Y8 = ws + WS_Y;
        g8::gemm8_phase<ProbM2F>(F.lds, P);
        if (BOTH(8)) GRID_BAR(8);
    }
    if (IN(9)) { build_tile_table(F); p9_combine(F, args, mod); }
#undef IN
#undef BOTH
#undef GRID_BAR
#undef SET_ID
}

extern "C" void kernel_launch(void* const* d_in, const int* in_sizes, int n_in, void* d_out, int out_size, void* d_ws, size_t ws_size, hipStream_t stream) {
    float* out = (float*)d_out;
    static int grid = 0;
    if (grid == 0) {
        int dev = 0, cus = 0;
        (void)hipGetDevice(&dev); (void)hipDeviceGetAttribute(&cus, hipDeviceAttributeMultiprocessorCount, dev);
        (void)hipFuncSetAttribute((const void*)mega, hipFuncAttributeMaxDynamicSharedMemorySize, LDS_BYTES);
        int per_cu = 0;
        (void)hipOccupancyMaxActiveBlocksPerMultiprocessor(&per_cu, (const void*)mega, NWAVES * 64, LDS_BYTES);
        (void)hipGetLastError();
        grid = (cus > 0 ? cus : 256) * (per_cu >= 1 ? 1 : 1);
    }
    char* ws = (char*)d_ws;
    (void)ws_size; (void)in_sizes; (void)n_in; (void)out_size;

    (void)hipMemsetAsync(ws + WS_CTL, 0, CTL_ZERO_BYTES, stream);
    Args a{};
    for (int i = 0; i < 29; ++i) a.in[i] = (const float*)d_in[i];
    a.out = out; a.ws = (unsigned char*)d_ws; a.ph_lo = 0; a.ph_hi = 10; a.li = 0; a.pad = 0;
    hipLaunchKernelGGL(mega, dim3(grid), dim3(NWAVES * 64), LDS_BYTES, stream, a);
}
```

```cpp
#include <hip/hip_runtime.h>
#include <stdint.h>
#include <math.h>

constexpr int DM = 2048, NB = 8, SEQ = 2048, NTOK = NB * SEQ;
constexpr int INW = 4656;
constexpr int NE = 32, TOPK = 4, NSLOT = NTOK * TOPK;
constexpr float EPS = 1e-6f;
#define LAS __attribute__((address_space(3)))
#define GAS __attribute__((address_space(1)))
typedef unsigned short bf16_t;
typedef short bf16x8 __attribute__((ext_vector_type(8)));
typedef short s16x4 __attribute__((ext_vector_type(4)));
typedef float f32x4 __attribute__((ext_vector_type(4)));
typedef float f32x16 __attribute__((ext_vector_type(16)));
typedef float f32x2 __attribute__((ext_vector_type(2)));
typedef unsigned u32x4 __attribute__((ext_vector_type(4)));
typedef unsigned u32x2 __attribute__((ext_vector_type(2)));
typedef GAS unsigned gu32;

constexpr int ZW = 4864;
constexpr int ZC_Q = 0, ZC_KC = 1024, ZC_VC = 1280, ZC_KS = 1536, ZC_VS = 1792, ZC_KW = 2048, ZC_VW = 2304, ZC_XR = 2560, ZC_XG = 3584, ZC_GL = 4608;
constexpr int PMAXT = 288, PMAXROWS = PMAXT * 256;

constexpr size_t MiB = 1u << 20;
constexpr size_t WS_CTL = 0, CTL_ZERO_BYTES = 1 * MiB;
constexpr int CW_TMO = 0, CW_CNT = 1024, CW_BAR = 4096;
constexpr size_t CTL_MOD_B = 256 * 1024;
constexpr size_t CTL_ROWSS_B = 640 * 1024;
constexpr size_t WS_WIN = 2 * MiB, WS_WOUT = 22 * MiB, WS_SMALL = 30 * MiB, WS_W1 = 32 * MiB, WS_W2 = 544 * MiB;
constexpr size_t SM_WR = 0, SM_WCK = 128 * 1024, SM_WCV = 384 * 1024, SM_WRG = 640 * 1024, SM_WIG = 768 * 1024, SM_BIASK = 896 * 1024, SM_BIASV = 897 * 1024;
constexpr float A2_SCALE = 16.f;
constexpr size_t WS_X1B = 864 * MiB;
constexpr size_t WS_MODPART = 1700 * MiB, WS_MOD = 1707 * MiB, WS_SSN = 1708 * MiB, WS_SSL = 1709 * MiB, WS_PEPART = 1710 * MiB;
constexpr size_t WS_H8 = 288 * MiB;
constexpr size_t WS_H = 800 * MiB, WS_Z = 864 * MiB, WS_KIMG = 1016 * MiB, WS_LRUS = 1050 * MiB, WS_A2 = 1052 * MiB, WS_ROUTE = 1116 * MiB, WS_ACT = 1122 * MiB, WS_Y = 1410 * MiB, WS_FAST_END = 1710 * MiB;
constexpr size_t KI_KS = 0, KI_KW = 8 * MiB, KI_VS = 16 * MiB, KI_VW = 24 * MiB, KI_KC = 32 * MiB, KI_VC = 32 * MiB + 512 * 1024;
constexpr size_t RT_ROWTOK = 0, RT_ROWG = 2 * MiB, RT_TOKSLOT = 4 * MiB;

constexpr int RING_BYTES = 131072, LDSCTL_OFF = RING_BYTES, MISC_OFF = LDSCTL_OFF + 320, TILETAB_OFF = LDSCTL_OFF + 1024, LDS_BYTES = 163840;
constexpr int NWAVES = 8;

#define RLX_AGENT __ATOMIC_RELAXED, __HIP_MEMORY_SCOPE_AGENT
#define LDS_WAIT() asm volatile("s_waitcnt lgkmcnt(0)" ::: "memory")
#define VM_WAIT() asm volatile("s_waitcnt vmcnt(0)" ::: "memory")
__device__ __forceinline__ unsigned f2bf(float f) { unsigned u = __builtin_bit_cast(unsigned, f); return (u + 0x7fffu + ((u >> 16) & 1u)) >> 16; }
__device__ __forceinline__ unsigned pk2(float lo, float hi) { return f2bf(lo) | (f2bf(hi) << 16); }
__device__ __forceinline__ float bf2f(unsigned short b) { return __builtin_bit_cast(float, (unsigned)b << 16); }
__device__ __forceinline__ float bflo(unsigned w) { return __builtin_bit_cast(float, w << 16); }
__device__ __forceinline__ float bfhi(unsigned w) { return __builtin_bit_cast(float, w & 0xffff0000u); }
__device__ __forceinline__ unsigned cvt_pk_bf16(float lo, float hi) { unsigned r; asm volatile("v_cvt_pk_bf16_f32 %0, %1, %2" : "=v"(r) : "v"(lo), "v"(hi)); return r; }

__device__ __forceinline__ float clamp448(float v) { return fminf(fmaxf(v, -448.f), 448.f); }
__device__ __forceinline__ unsigned pk4_fp8(float a, float b, float c, float d);
__device__ __forceinline__ unsigned pk4_fp8c(float a, float b, float c, float d) { return pk4_fp8(clamp448(a), clamp448(b), clamp448(c), clamp448(d)); }
__device__ __forceinline__ unsigned pk4_fp8(float a, float b, float c, float d) {
    unsigned w = 0u; w = __builtin_amdgcn_cvt_pk_fp8_f32(a, b, w, false); w = __builtin_amdgcn_cvt_pk_fp8_f32(c, d, w, true); return w; }

#define XB_TMO      128
#define XB_XCNT(j)  (256  + 64 * (j))
#define XB_XSUB(j)  (1280 + 64 * (j))
#define XB_XGEN(j)  (2304 + 64 * (j))
#define XB_TOP      3328
#define XB_TOPGEN   3392
#define XCD_BAR_WORDS 3456
#define XB_SPIN_CAP (1u << 18)
__device__ __forceinline__ unsigned xb_ld(unsigned* p)              { return __hip_atomic_load(p, __ATOMIC_RELAXED, __HIP_MEMORY_SCOPE_AGENT); }
__device__ __forceinline__ unsigned xb_add(unsigned* p, unsigned v) { return __hip_atomic_fetch_add(p, v, __ATOMIC_RELAXED, __HIP_MEMORY_SCOPE_AGENT); }
__device__ __forceinline__ unsigned xb_xcc_id() { return (unsigned)__builtin_amdgcn_s_getreg((3 << 11) | 20) & 0xFu; }
#define XB_SPIN(cond, bar) do { unsigned _sp = 0; while (cond) { __builtin_amdgcn_s_sleep(1); \
    if ((++_sp & 255u) == 0u) { if (xb_ld(&(bar)[XB_TMO])) break; if (_sp > XB_SPIN_CAP) { atomicAdd(&(bar)[XB_TMO], 1u); break; } } } } while (0)
struct XcdBarrier { unsigned* bar; unsigned x; volatile LAS unsigned* st; unsigned total; };
__device__ __forceinline__ XcdBarrier xcd_barrier_post(unsigned* bar, volatile LAS unsigned* st, unsigned total, bool member) {
    XcdBarrier b; b.bar = bar; b.x = xb_xcc_id(); b.st = st; b.total = total;
    if (member && threadIdx.x == 0) (void)xb_add(&bar[XB_XCNT(b.x)], 1u);
    return b;
}
__device__ __forceinline__ void xcd_barrier_complete(unsigned* bar, unsigned x, unsigned G, unsigned& nloc, unsigned& nx) {
    unsigned sum, cnt, mine, sp = 0u;
    for (;;) {
        sum = 0u; cnt = 0u; mine = 0u;
#pragma unroll
        for (unsigned j = 0; j < 16; ++j) { const unsigned c = xb_ld(&bar[XB_XCNT(j)]); sum += c; cnt += (c > 0u) ? 1u : 0u; mine = (j == x) ? c : mine; }
        if (sum == G) break;
        __builtin_amdgcn_s_sleep(1);
        if ((++sp & 255u) == 0u) { if (xb_ld(&bar[XB_TMO])) break; if (sp > XB_SPIN_CAP) { atomicAdd(&bar[XB_TMO], 1u); break; } }
    }
    nloc = mine > 0u ? mine : 1u; nx = cnt > 0u ? cnt : 1u;
}
__device__ __forceinline__ void xcd_barrier(const XcdBarrier& b) {
    asm volatile("s_waitcnt vmcnt(0)" ::: "memory");
    __syncthreads();
    if (threadIdx.x == 0) {
        unsigned* bar = b.bar;
        __builtin_amdgcn_s_waitcnt(0);
        unsigned nloc = b.st[0], nx = b.st[1];
        if (nloc == 0u) { xcd_barrier_complete(bar, b.x, b.total, nloc, nx); b.st[0] = nloc; b.st[1] = nx; }
        const unsigned old = xb_add(&bar[XB_XSUB(b.x)], 1u);
        const unsigned gen = old / nloc;
        if (old + 1u == (gen + 1u) * nloc) {
            __builtin_amdgcn_fence(__ATOMIC_RELEASE, "agent");
            asm volatile("s_waitcnt vmcnt(0)" ::: "memory");
            const unsigned og = xb_add(&bar[XB_TOP], 1u);
            const unsigned tg = og / nx;
            if (og + 1u == (tg + 1u) * nx) xb_add(&bar[XB_TOPGEN], 1u);
            else XB_SPIN(xb_ld(&bar[XB_TOPGEN]) == tg, bar);
            __builtin_amdgcn_fence(__ATOMIC_ACQUIRE, "agent");
            xb_add(&bar[XB_XGEN(b.x)], 1u);
            asm volatile("s_waitcnt vmcnt(0)" ::: "memory");
        } else {
            XB_SPIN(xb_ld(&bar[XB_XGEN(b.x)]) == gen, bar);
            __builtin_amdgcn_fence(__ATOMIC_ACQUIRE, "agent");
            asm volatile("s_waitcnt vmcnt(0)" ::: "memory");
        }
    }
    __syncthreads();
}

namespace g8 {
constexpr int BM = 256, BK = 64, HALF = 128, HTB = HALF * BK * 2, STAGE_BYTES = 8 * HTB;
__host__ __device__ __forceinline__ int lds_byte(int r, int c) { const int st = (r >> 4) * 2 + (c >> 5), rr = r & 15, cc = c & 31, ob = rr * 64 + cc * 2; return st * 1024 + (ob ^ (((ob >> 9) & 1) << 5)); }
__host__ __device__ __forceinline__ void stage_rc(int b, int& R, int& C) { const int st = b / 1024, sb = b % 1024, swz = sb ^ (((sb >> 9) & 1) << 5); R = (st >> 1) * 16 + swz / 64; C = (st & 1) * 32 + (swz % 64) / 2; }
__host__ __device__ __forceinline__ int perm32(int rho) { const int n = rho >> 4, i = rho & 15; return 8 * (i >> 2) + 4 * n + (i & 3); }
struct Unit { int pm, pn, e, row0, p0; };
typedef f32x4 Acc[2][2][4][2];

template <class P>
__device__ __forceinline__ void gemm_phase(LAS unsigned char* lds, const P& S) {
    const int tid = threadIdx.x, wid = __builtin_amdgcn_readfirstlane(tid >> 6), lane = tid & 63, wr = wid >> 2, wc = wid & 3, fr = lane & 15, fq = lane >> 4;
    constexpr int K = P::K, nt = K / BK;
    int R0, C0, R1, C1; stage_rc(tid * 16, R0, C0); stage_rc(tid * 16 + 8192, R1, C1);
    const int Rb0 = P::PERM ? ((R0 & ~31) + perm32(R0 & 31)) : R0, Rb1 = P::PERM ? ((R1 & ~31) + perm32(R1 & 31)) : R1;
    const unsigned voffB0 = (unsigned)(Rb0 * K + C0) * 2u, voffB1 = (unsigned)(Rb1 * K + C1) * 2u;
    constexpr size_t kstep = (size_t)(BK * 2);
    constexpr unsigned hstep = (unsigned)HALF * K * 2u;
    const unsigned ldsw = (unsigned)wid * 1024u;
    const int aoff = lds_byte(wr * 64 + fr, fq * 8), boff = lds_byte(wc * 32 + fr, fq * 8);
#define G8_SA(b, h) (((b) * 2 + (h)) * HTB)
#define G8_SB(b, h) ((4 + (b) * 2 + (h)) * HTB)
#define G8_STAGE(bufoff, gbase, o0, o1) do { \
        __builtin_amdgcn_global_load_lds((const unsigned*)((const char*)(gbase) + (o0)), (LAS unsigned*)(lds + (bufoff) + ldsw), 16, 0, 0); \
        __builtin_amdgcn_global_load_lds((const unsigned*)((const char*)(gbase) + (o1)), (LAS unsigned*)(lds + (bufoff) + ldsw + 8192), 16, 0, 0); } while (0)
#define G8_STAGEB(bufoff, gbase, h) G8_STAGE(bufoff, gbase, voffB0 + (h) * hstep, voffB1 + (h) * hstep)
#define G8_LDA(dst, b, h) do { _Pragma("unroll") for (int m = 0; m < 4; ++m) _Pragma("unroll") for (int k = 0; k < 2; ++k) dst[m][k] = *(const LAS bf16x8*)(lds + G8_SA(b, h) + aoff + m * 2048 + k * 1024); } while (0)
#define G8_LDB(dst, b, h) do { _Pragma("unroll") for (int n = 0; n < 2; ++n) _Pragma("unroll") for (int k = 0; k < 2; ++k) dst[n][k] = *(const LAS bf16x8*)(lds + G8_SB(b, h) + boff + n * 2048 + k * 1024); } while (0)
#define G8_MMA(ai, bj, At, Bt) do { __builtin_amdgcn_s_setprio(1); _Pragma("unroll") for (int m = 0; m < 4; ++m) _Pragma("unroll") for (int n = 0; n < 2; ++n) _Pragma("unroll") for (int k = 0; k < 2; ++k) \
        acc[ai][bj][m][n] = __builtin_amdgcn_mfma_f32_16x16x32_bf16(Bt[n][k], At[m][k], acc[ai][bj][m][n], 0, 0, 0); __builtin_amdgcn_s_setprio(0); } while (0)
#define G8_WAIT_V(n) asm volatile("s_waitcnt vmcnt(" #n ")" ::: "memory")
#define G8_WAIT_L(n) asm volatile("s_waitcnt lgkmcnt(" #n ")" ::: "memory")
#define G8_BAR __builtin_amdgcn_s_barrier()
#define G8_SCHED __builtin_amdgcn_sched_barrier(0)
    Unit cur, nxt; int ui = 0;
    if (!S.next(0, cur)) return;
    Acc acc;
#pragma unroll
    for (int a = 0; a < 2; ++a)
#pragma unroll
        for (int b = 0; b < 2; ++b)
#pragma unroll
            for (int m = 0; m < 4; ++m)
#pragma unroll
                for (int n = 0; n < 2; ++n) acc[a][b][m][n] = (f32x4){0.f, 0.f, 0.f, 0.f};
    bf16x8 At[4][2], B0[2][2], B1[2][2];
    unsigned c00, c01, c10, c11, n00, n01, n10, n11;
    S.a_voff(cur, R0, C0, R1, C1, c00, c01, c10, c11);
    n00 = c00; n01 = c01; n10 = c10; n11 = c11;
    const char* cA = S.a_base(cur); const char* cB = S.b_base(cur);
    G8_STAGEB(G8_SB(0, 0), cB, 0); G8_STAGEB(G8_SB(0, 1), cB, 1); G8_STAGE(G8_SA(0, 0), cA, c00, c01); G8_STAGE(G8_SA(0, 1), cA, c10, c11);
    if (wr == 1) G8_BAR;
    G8_WAIT_V(2); G8_BAR;
    G8_STAGEB(G8_SB(1, 0), cB + kstep, 0); G8_STAGE(G8_SA(1, 0), cA + kstep, c00, c01); G8_STAGEB(G8_SB(1, 1), cB + kstep, 1);
    G8_WAIT_V(6); G8_BAR;
    for (;;) {
        const bool has_next = S.next(ui + 1, nxt);
        const char* nA = has_next ? S.a_base(nxt) : cA; const char* nB = has_next ? S.b_base(nxt) : cB;
        if (P::GATHER) { if (has_next) S.a_voff(nxt, R0, C0, R1, C1, n00, n01, n10, n11); else { n00 = c00; n01 = c01; n10 = c10; n11 = c11; } }
        for (int t = 0; t < nt; t += 2) {
            const bool last = (t == nt - 2);
            if (P::MIDK) { if (t == nt / 2) S.midk(acc, cur, wr, fr); }
            const char* a1 = cA + (size_t)(t + 1) * kstep;
            const char* a2 = last ? nA : cA + (size_t)(t + 2) * kstep; const char* b2 = last ? nB : cB + (size_t)(t + 2) * kstep;
            const char* a3 = a2 + kstep; const char* b3 = b2 + kstep;
            const unsigned x00 = (P::GATHER && last) ? n00 : c00, x01 = (P::GATHER && last) ? n01 : c01, x10 = (P::GATHER && last) ? n10 : c10, x11 = (P::GATHER && last) ? n11 : c11;
            G8_LDB(B0, 0, 0); G8_LDB(B1, 0, 1); G8_SCHED; G8_LDA(At, 0, 0); G8_STAGE(G8_SA(1, 1), a1, c10, c11);
            G8_WAIT_V(8); G8_WAIT_L(0); G8_BAR; G8_MMA(0, 0, At, B0); G8_MMA(0, 1, At, B1); G8_BAR; G8_SCHED;
            G8_LDA(At, 0, 1); G8_STAGEB(G8_SB(0, 0), b2, 0); G8_STAGEB(G8_SB(0, 1), b2, 1); G8_STAGE(G8_SA(0, 0), a2, x00, x01);
            G8_WAIT_V(8); G8_WAIT_L(0); G8_BAR; G8_MMA(1, 0, At, B0); G8_MMA(1, 1, At, B1); G8_BAR; G8_SCHED;
            G8_LDB(B0, 1, 0); G8_LDB(B1, 1, 1); G8_SCHED; G8_LDA(At, 1, 0); G8_STAGE(G8_SA(0, 1), a2, x10, x11);
            G8_WAIT_V(8); G8_WAIT_L(0); G8_BAR; G8_MMA(0, 0, At, B0); G8_MMA(0, 1, At, B1); G8_BAR; G8_SCHED;
            G8_LDA(At, 1, 1); G8_STAGEB(G8_SB(1, 0), b3, 0); G8_STAGEB(G8_SB(1, 1), b3, 1); G8_STAGE(G8_SA(1, 0), a3, x00, x01);
            G8_WAIT_V(8); G8_WAIT_L(0); G8_BAR; G8_MMA(1, 0, At, B0); G8_MMA(1, 1, At, B1); G8_BAR; G8_SCHED;
        }
        if (wr == 0) G8_BAR;
        S.epi(acc, cur, wr, wc, fr, fq);
        if (!has_next) break;
#pragma unroll
        for (int a = 0; a < 2; ++a)
#pragma unroll
            for (int b = 0; b < 2; ++b)
#pragma unroll
                for (int m = 0; m < 4; ++m)
#pragma unroll
                    for (int n = 0; n < 2; ++n) acc[a][b][m][n] = (f32x4){0.f, 0.f, 0.f, 0.f};
        cur = nxt; cA = nA; cB = nB; ++ui;
        if (P::GATHER) { c00 = n00; c01 = n01; c10 = n10; c11 = n11; }
        if (wr == 1) G8_BAR;
    }
    G8_WAIT_V(0);
    G8_BAR;
#undef G8_SA
#undef G8_SB
#undef G8_STAGE
#undef G8_STAGEB
#undef G8_LDA
#undef G8_LDB
#undef G8_MMA
#undef G8_WAIT_V
#undef G8_WAIT_L
#undef G8_BAR
#undef G8_SCHED
}

struct DenseOrder {
    int nM, nN, nwg, G, c;
    __device__ __forceinline__ void init(int M, int N, int G_, int c_) { nM = M / BM; nN = N / BM; nwg = nM * nN; G = G_; c = c_; }
    __device__ __forceinline__ bool next(int i, Unit& u) const {
        const long L = (long)i * G + c; if (L >= nwg) return false;
        int wgid = (int)L; { const int q = nwg / 8, r = nwg % 8, xcd = wgid % 8, off = wgid / 8; wgid = (xcd < r ? xcd * (q + 1) : r * (q + 1) + (xcd - r) * q) + off; }
        const int nig = 8 * nN, gid = wgid / nig, fm = gid * 8, gsz = (nM - fm) < 8 ? (nM - fm) : 8;
        u.pm = fm + ((wgid % nig) % gsz); u.pn = (wgid % nig) / gsz; u.e = 0; u.row0 = u.pm * BM; u.p0 = 0; return true;
    }
};
}

struct Args { const float* in[29]; float* out; unsigned char* ws; int ph_lo, ph_hi, li, pad; };
struct Frame {
    LAS unsigned char* lds;
    gu32* ctl;
    int tid, lane, wave, vcu, G, bx;
    unsigned char* ws;
};
__device__ __forceinline__ float wsum(float v) {
#pragma unroll
    for (int o = 1; o < 64; o <<= 1) v += __shfl_xor(v, o);
    return v;
}

__device__ __forceinline__ void conv_item(const float* W, int ldw, int n_src0, int nvalid, int k0, bf16_t* WT, int dst_row0, int Kd, LAS float* scr, int lane) {
    const int ln = lane & 31;
#pragma unroll
    for (int i = 0; i < 32; ++i) { const int kk = 2 * i + (lane >> 5); scr[kk * 33 + ln] = (ln < nvalid) ? W[(size_t)(k0 + kk) * ldw + n_src0 + ln] : 0.f; }
    LDS_WAIT(); asm volatile("" ::: "memory");
    const int c = lane & 7;
#pragma unroll
    for (int j = 0; j < 4; ++j) { const int n = (lane >> 3) + 8 * j; const LAS float* s = scr + (8 * c) * 33 + n;
        u32x4 o; o.x = pk2(s[0 * 33], s[1 * 33]); o.y = pk2(s[2 * 33], s[3 * 33]); o.z = pk2(s[4 * 33], s[5 * 33]); o.w = pk2(s[6 * 33], s[7 * 33]);
        *(GAS u32x4*)(WT + (size_t)(dst_row0 + n) * Kd + k0 + 8 * c) = o; }
    LDS_WAIT(); asm volatile("" ::: "memory");
}
__device__ __forceinline__ void mod_item(const float* c, const float* w, float* modp, int item, int lane, LAS float* scr) {
    const int cb = item % 48, ks = item / 48, j0 = cb * 256 + lane * 4, k0 = ks * 128;
#pragma unroll
    for (int i = 0; i < 16; ++i) { const int idx = i * 64 + lane, kk = idx >> 3, b = idx & 7; const float cv = c[b * DM + k0 + kk]; scr[idx] = cv / (1.f + __expf(-cv)); }
    LDS_WAIT(); asm volatile("" ::: "memory");
    f32x4 acc[NB];
#pragma unroll
    for (int b = 0; b < NB; ++b) acc[b] = (f32x4){0.f, 0.f, 0.f, 0.f};
#pragma unroll 1
    for (int kb = 0; kb < 128; kb += 8) {
        f32x4 wv[8];
#pragma unroll
        for (int k = 0; k < 8; ++k) wv[k] = *(const GAS f32x4*)(w + (size_t)(k0 + kb + k) * (6 * DM) + j0);
        asm volatile("" : "+v"(wv[0]), "+v"(wv[1]), "+v"(wv[2]), "+v"(wv[3]), "+v"(wv[4]), "+v"(wv[5]), "+v"(wv[6]), "+v"(wv[7]) :: "memory");
#pragma unroll
        for (int k = 0; k < 8; ++k) {
            const f32x4 s0 = *(const LAS f32x4*)(scr + (kb + k) * 8), s1 = *(const LAS f32x4*)(scr + (kb + k) * 8 + 4);
            acc[0] += wv[k] * s0.x; acc[1] += wv[k] * s0.y; acc[2] += wv[k] * s0.z; acc[3] += wv[k] * s0.w; acc[4] += wv[k] * s1.x; acc[5] += wv[k] * s1.y; acc[6] += wv[k] * s1.z; acc[7] += wv[k] * s1.w;
        }
    }
#pragma unroll
    for (int b = 0; b < NB; ++b) *(GAS f32x4*)(modp + ((size_t)ks * NB + b) * 6 * DM + j0) = acc[b];
    LDS_WAIT(); asm volatile("" ::: "memory");
}
__device__ __forceinline__ float mod_reduce1(const float* modp, const float* bias, int idx) {
    const int b = idx / (6 * DM), j = idx % (6 * DM);
    float s = bias[j];
#pragma unroll
    for (int ks = 0; ks < 16; ++ks) s += modp[((size_t)ks * NB + b) * 6 * DM + j];
    return s;
}
__device__ __forceinline__ void pebias_part(const float* pe, const float* w, float* part, int kc, int lane) {
    const float* wp = w + (size_t)(kc * 64) * 64 + lane; const float* pp = pe + kc * 64;
    float a0 = 0.f, a1 = 0.f, a2 = 0.f, a3 = 0.f;
#pragma unroll
    for (int b = 0; b < 4; ++b) {
        float v[16];
#pragma unroll
        for (int j = 0; j < 16; ++j) v[j] = wp[(size_t)(b * 16 + j) * 64];
        asm volatile("" : "+v"(v[0]), "+v"(v[1]), "+v"(v[2]), "+v"(v[3]), "+v"(v[4]), "+v"(v[5]), "+v"(v[6]), "+v"(v[7]),
                          "+v"(v[8]), "+v"(v[9]), "+v"(v[10]), "+v"(v[11]), "+v"(v[12]), "+v"(v[13]), "+v"(v[14]), "+v"(v[15]));
#pragma unroll
        for (int j = 0; j < 16; j += 4) { a0 += pp[b * 16 + j] * v[j]; a1 += pp[b * 16 + j + 1] * v[j + 1]; a2 += pp[b * 16 + j + 2] * v[j + 2]; a3 += pp[b * 16 + j + 3] * v[j + 3]; }
    }
    part[kc * 64 + lane] = (a0 + a1) + (a2 + a3);
}
__device__ __forceinline__ void pebias_reduce(const float* part, float* outb, int lane) {
    float v[32];
#pragma unroll
    for (int j = 0; j < 32; ++j) v[j] = part[j * 64 + lane];
    float a = 0.f;
#pragma unroll
    for (int j = 0; j < 32; ++j) a += v[j];
    outb[lane] = a;
}

__device__ __forceinline__ void p0_prologue(Frame& F, const Args& A) {
    LAS float* scr = (LAS float*)(F.lds + F.wave * 16384);
    const int gw = F.wave * F.G + F.vcu, NGW = F.G * NWAVES;
    unsigned char* ws = F.ws;
    float* modp = (float*)(ws + WS_MODPART);
    constexpr int I_MOD = 768;
    constexpr int I_WIN = 32 * (ZW / 32);
    constexpr int I_WOUT = 0;
    constexpr int I_WR = 32, I_WCK = 64, I_WCV = 64, I_WRG = 32, I_WIG = 32, I_PE = 64;
    constexpr int NITEMS = I_MOD + I_WIN + I_WOUT + I_WR + I_WCK + I_WCV + I_WRG + I_WIG + I_PE;
    for (int it = gw; it < NITEMS; it += NGW) {
        int ln = F.lane; asm volatile("" : "+v"(ln));
        int r = it;
        if (r < I_MOD) { mod_item(A.in[1], A.in[2], modp, r, F.lane, scr); continue; } r -= I_MOD;
        if (r < I_WIN) {
            const int nb = r % (ZW / 32), kb = r / (ZW / 32), zc = nb * 32;
            int src, nv = 32;
            if (zc < 2560) src = zc; else if (zc < 4608) src = zc + 48; else { src = zc - 2048; nv = 4656 - zc; if (nv > 32) nv = 32; if (nv < 0) nv = 0; }
            if (nv == 0) src = 0;
            conv_item(A.in[5], INW, src, nv, kb * 64, (bf16_t*)(ws + WS_WIN), zc, DM, scr, ln); continue; } r -= I_WIN;
        if (r < I_WOUT) { const int nb = r % 64, kb = r / 64; conv_item(A.in[21], DM, nb * 32, 32, kb * 64, (bf16_t*)(ws + WS_WOUT), nb * 32, DM, scr, ln); continue; } r -= I_WOUT;
        if (r < I_WR) { conv_item(A.in[23], 32, 0, 32, r * 64, (bf16_t*)(ws + WS_SMALL + SM_WR), 0, DM, scr, ln); continue; } r -= I_WR;
        if (r < I_WCK) { const int nb = r % 2, kb = r / 2; conv_item(A.in[8], 64, nb * 32, 32, kb * 64, (bf16_t*)(ws + WS_SMALL + SM_WCK), nb * 32, DM, scr, ln); continue; } r -= I_WCK;
        if (r < I_WCV) { const int nb = r % 2, kb = r / 2; conv_item(A.in[9], 64, nb * 32, 32, kb * 64, (bf16_t*)(ws + WS_SMALL + SM_WCV), nb * 32, DM, scr, ln); continue; } r -= I_WCV;
        if (r < I_WRG) { const int nb = r % 2, blk = r / 2; conv_item(A.in[14] + (size_t)blk * 4096, 64, nb * 32, 32, 0, (bf16_t*)(ws + WS_SMALL + SM_WRG) + (size_t)blk * 4096, nb * 32, 64, scr, ln); continue; } r -= I_WRG;
        if (r < I_WIG) { const int nb = r % 2, blk = r / 2; conv_item(A.in[16] + (size_t)blk * 4096, 64, nb * 32, 32, 0, (bf16_t*)(ws + WS_SMALL + SM_WIG) + (size_t)blk * 4096, nb * 32, 64, scr, ln); continue; } r -= I_WIG;
        if (r < I_PE) { const int which = r >> 5; pebias_part(A.in[6 + which], A.in[8 + which], (float*)(ws + WS_PEPART) + which * 2048, r & 31, ln); continue; }
        (void)r;
    }
}

struct ProbZ {
    static constexpr int K = DM; static constexpr bool GATHER = false, PERM = true, MIDK = false;
    g8::DenseOrder ord; const bf16_t* A; const bf16_t* Bt; bf16_t* Z;
    __device__ __forceinline__ bool next(int i, g8::Unit& u) const { return ord.next(i, u); }
    __device__ __forceinline__ const char* a_base(const g8::Unit& u) const { return (const char*)A + (size_t)u.pm * 256 * K * 2; }
    __device__ __forceinline__ const char* b_base(const g8::Unit& u) const { return (const char*)Bt + (size_t)u.pn * 256 * K * 2; }
    __device__ __forceinline__ void a_voff(const g8::Unit&, int R0, int C0, int R1, int C1, unsigned& v00, unsigned& v01, unsigned& v10, unsigned& v11) const {
        v00 = (unsigned)(R0 * K + C0) * 2u; v01 = (unsigned)(R1 * K + C1) * 2u; v10 = v00 + 128u * K * 2u; v11 = v01 + 128u * K * 2u; }
    __device__ __forceinline__ void midk(g8::Acc&, const g8::Unit&, int, int) const {}
    __device__ __forceinline__ void epi(const g8::Acc& acc, const g8::Unit& u, int wr, int wc, int fr, int fq) const {
        const int row0 = u.row0 + wr * 64 + fr, col0 = u.pn * 256 + wc * 32 + 8 * fq;
#pragma unroll
        for (int ai = 0; ai < 2; ++ai)
#pragma unroll
            for (int m = 0; m < 4; ++m) { bf16_t* rowp = Z + (size_t)(row0 + ai * 128 + m * 16) * ZW + col0;
#pragma unroll
                for (int bj = 0; bj < 2; ++bj) { const f32x4 v0 = acc[ai][bj][m][0], v1 = acc[ai][bj][m][1];
                    u32x4 w; w.x = cvt_pk_bf16(v0[0], v0[1]); w.y = cvt_pk_bf16(v0[2], v0[3]); w.z = cvt_pk_bf16(v1[0], v1[1]); w.w = cvt_pk_bf16(v1[2], v1[3]);
                    *(u32x4*)(rowp + bj * 128) = w; } }
    }
};
__device__ __forceinline__ void build_tile_table(Frame& F) {
    LAS int* tab = (LAS int*)(F.lds + TILETAB_OFF);
    if (F.wave == 0) {
        const int lane = F.lane;
        const int* cnt = (const int*)(F.ctl + CW_CNT);
        const int c = (lane < NE) ? cnt[lane] : 0;
        const int t = (c + 255) >> 8;
        int ps = t;
#pragma unroll
        for (int o = 1; o < 32; o <<= 1) { const int v = __shfl_up(ps, o); if (lane >= o) ps += v; }
        const int t0 = ps - t;
        if (lane < NE) { tab[8 + lane] = c; tab[40 + lane] = t0 * 256;
            for (int j = 0; j < t; ++j) { tab[128 + t0 + j] = lane; tab[416 + t0 + j] = j * 256; } }
        if (lane == NE - 1) tab[0] = ps;
    }
    __syncthreads();
}
struct MoeOrder {
    const LAS int* tab; int G, c, NPN;
    __device__ __forceinline__ bool next(int i, g8::Unit& u) const {
        const int nt = tab[0], nunits = nt * NPN; const long L = (long)i * G + c; if (L >= nunits) return false;
        int w = (int)L; { const int q = nunits / 8, r = nunits % 8, xcd = w % 8, off = w / 8; w = (xcd < r ? xcd * (q + 1) : r * (q + 1) + (xcd - r) * q) + off; }
        const int gs = 4 * NPN, grp = w / gs, fm = grp * 4, gsz = (nt - fm) < 4 ? (nt - fm) : 4, rem = w % gs;
        u.pm = fm + rem % gsz; u.pn = rem / gsz; u.e = tab[128 + u.pm]; u.p0 = tab[416 + u.pm]; u.row0 = tab[40 + u.e] + u.p0; return true;
    }
};
__device__ __forceinline__ float fast_sigmoid(float x) { return __builtin_amdgcn_rcpf(1.f + __builtin_amdgcn_exp2f(-1.4426950408889634f * x)); }


__device__ __forceinline__ void p6_row(const u32x2 (&vb)[8], const f32x4 (&Ag)[8], const f32x4 (&Sh)[8], bf16_t* orow, unsigned char* orow8, int lane) {
    f32x4 v[8];
#pragma unroll
    for (int j = 0; j < 8; ++j) v[j] = (f32x4){bflo(vb[j].x), bfhi(vb[j].x), bflo(vb[j].y), bfhi(vb[j].y)};
    float s = 0.f;
#pragma unroll
    for (int j = 0; j < 8; ++j) s += (v[j].x * v[j].x + v[j].y * v[j].y) + (v[j].z * v[j].z + v[j].w * v[j].w);
    const float rstd = rsqrtf(wsum(s) * (1.f / DM) + EPS);
    GAS unsigned long long* o8 = (GAS unsigned long long*)orow + lane; GAS unsigned* o4 = (GAS unsigned*)orow8 + lane;
#pragma unroll
    for (int j = 0; j < 8; ++j) { const f32x4 hv = v[j] * rstd * Ag[j] + Sh[j];
        o8[64 * j] = (unsigned long long)pk2(hv.x, hv.y) | ((unsigned long long)pk2(hv.z, hv.w) << 32);
        o4[64 * j] = pk4_fp8(hv.x, hv.y, hv.z, hv.w); }
}
__device__ __forceinline__ void p6_route(Frame& F, const Args& A, const float* mod) {
    unsigned char* ws = F.ws;
    bf16_t* H2 = (bf16_t*)(ws + WS_H); const bf16_t* WrT = (const bf16_t*)(ws + WS_SMALL + SM_WR);
    int* cnt = (int*)(F.ctl + CW_CNT); int* rowtok = (int*)(ws + WS_ROUTE + RT_ROWTOK); float* rowg = (float*)(ws + WS_ROUTE + RT_ROWG); int* tokslot = (int*)(ws + WS_ROUTE + RT_TOKSLOT);
    const float* br = A.in[24];
    const int lane = F.lane, ar = lane & 15, kq = lane >> 4, tid = F.tid;
    LAS unsigned char* wl = F.lds;
    LAS int* ch_e = (LAS int*)(F.lds + TILETAB_OFF);
    LAS float* ch_g = (LAS float*)(ch_e + 256);
    LAS int* wcnt = (LAS int*)(ch_g + 256);
    LAS int* wbase = wcnt + 128;
    {
#pragma unroll
        for (int i = 0; i < 16; ++i) { const int q = F.wave * 16 + i, n = q >> 2, p = (q & 3) * 64 + lane;
            __builtin_amdgcn_global_load_lds((const unsigned*)((const char*)WrT + (size_t)n * 4096 + ((p ^ (n & 15)) << 4)), (LAS unsigned*)(wl + q * 1024), 16, 0, 0); }
    }
    for (int chunk = F.bx; chunk < NTOK / 64; chunk += F.G) {
        const int row0 = chunk * 64 + F.wave * 8, b = row0 / SEQ; const float* mb = mod + (size_t)b * 6 * DM;
        f32x4 Ag[8], Sh[8];
#pragma unroll
        for (int j = 0; j < 8; ++j) { const f32x4 gg = *((const GAS f32x4*)A.in[22] + lane + 64 * j), sc = *((const GAS f32x4*)(mb + 4 * DM) + lane + 64 * j);
            Ag[j] = gg * (sc + 1.f); Sh[j] = *((const GAS f32x4*)(mb + 3 * DM) + lane + 64 * j); }
        u32x2 xa[8], xb[8];
        const bf16_t* X1B = (const bf16_t*)(ws + WS_X1B);
#pragma unroll
        for (int j = 0; j < 8; ++j) xa[j] = *((const GAS u32x2*)(X1B + (size_t)row0 * DM) + lane + 64 * j);
#pragma unroll 1
        for (int r = 0; r < 8; r += 2) {
#pragma unroll
            for (int j = 0; j < 8; ++j) xb[j] = *((const GAS u32x2*)(X1B + (size_t)(row0 + r + 1) * DM) + lane + 64 * j);
            p6_row(xa, Ag, Sh, H2 + (size_t)(row0 + r) * DM, ws + WS_H8 + (size_t)(row0 + r) * DM, lane);
            if (r + 2 < 8) {
#pragma unroll
                for (int j = 0; j < 8; ++j) xa[j] = *((const GAS u32x2*)(X1B + (size_t)(row0 + r + 2) * DM) + lane + 64 * j); }
            p6_row(xb, Ag, Sh, H2 + (size_t)(row0 + r + 1) * DM, ws + WS_H8 + (size_t)(row0 + r + 1) * DM, lane);
        }
        VM_WAIT();
        __syncthreads();
        f32x4 acc0 = (f32x4){0.f, 0.f, 0.f, 0.f}, acc1 = acc0;
        const bf16_t* ap = H2 + (size_t)(row0 + (ar & 7)) * DM + kq * 8;
        const LAS unsigned char* w0 = wl + ar * 4096, *w1 = wl + (16 + ar) * 4096;
#pragma unroll 16
        for (int s = 0; s < 64; ++s) {
            const bf16x8 a = *(const GAS bf16x8*)(ap + 32 * s);
            const bf16x8 b0 = *(const LAS bf16x8*)(w0 + (((4 * s + kq) ^ ar) << 4)), b1 = *(const LAS bf16x8*)(w1 + (((4 * s + kq) ^ ar) << 4));
            acc0 = __builtin_amdgcn_mfma_f32_16x16x32_bf16(b0, a, acc0, 0, 0, 0);
            acc1 = __builtin_amdgcn_mfma_f32_16x16x32_bf16(b1, a, acc1, 0, 0, 0);
        }
        {
            const f32x4 bb0 = *(const GAS f32x4*)(br + 4 * kq), bb1 = *(const GAS f32x4*)(br + 16 + 4 * kq);
            float v[8] = {acc0[0] + bb0.x, acc0[1] + bb0.y, acc0[2] + bb0.z, acc0[3] + bb0.w, acc1[0] + bb1.x, acc1[1] + bb1.y, acc1[2] + bb1.z, acc1[3] + bb1.w};
            float tv[4]; int te[4];
#pragma unroll
            for (int k = 0; k < 4; ++k) {
                float bv = v[0]; int bi = 4 * kq;
#pragma unroll
                for (int q = 1; q < 8; ++q) { const int eq = (q < 4) ? 4 * kq + q : 16 + 4 * kq + (q - 4); if (v[q] > bv) { bv = v[q]; bi = eq; } }
#pragma unroll
                for (int o = 16; o < 64; o <<= 1) { const float ov = __shfl_xor(bv, o); const int oi = __shfl_xor(bi, o); if (ov > bv || (ov == bv && oi < bi)) { bv = ov; bi = oi; } }
                tv[k] = bv; te[k] = bi;
#pragma unroll
                for (int q = 0; q < 8; ++q) { const int eq = (q < 4) ? 4 * kq + q : 16 + 4 * kq + (q - 4); if (eq == bi) v[q] = -INFINITY; }
            }
            const float e1 = __expf(tv[1] - tv[0]), e2 = __expf(tv[2] - tv[0]), e3 = __expf(tv[3] - tv[0]); const float inv = 1.f / (1.f + e1 + e2 + e3);
            if (kq == 0 && ar < 8) { const int li = (F.wave * 8 + ar) * 4;
                ch_e[li] = te[0]; ch_e[li + 1] = te[1]; ch_e[li + 2] = te[2]; ch_e[li + 3] = te[3];
                ch_g[li] = inv; ch_g[li + 1] = e1 * inv; ch_g[li + 2] = e2 * inv; ch_g[li + 3] = e3 * inv; }
        }
        __syncthreads();
        int my_e = 0, my_rank = 0;
        if (F.wave < 4) { my_e = ch_e[tid];
#pragma unroll 4
            for (int e = 0; e < NE; ++e) { const unsigned long long mk = __ballot(my_e == e);
                if (my_e == e) my_rank = __popcll(mk & ((1ull << lane) - 1ull));
                if (lane == 0) wcnt[F.wave * 32 + e] = __popcll(mk); } }
        __syncthreads();
        if (tid < 32) { const int c0 = wcnt[tid], c1 = wcnt[32 + tid], c2 = wcnt[64 + tid], c3 = wcnt[96 + tid], tot = c0 + c1 + c2 + c3;
            const int base = tot ? atomicAdd(&cnt[tid], tot) : 0;
            wbase[tid] = base; wbase[32 + tid] = base + c0; wbase[64 + tid] = base + c0 + c1; wbase[96 + tid] = base + c0 + c1 + c2; }
        __syncthreads();
        if (F.wave < 4) { const int pos = wbase[F.wave * 32 + my_e] + my_rank, row = chunk * 64 + (tid >> 2);
            rowtok[(size_t)my_e * NTOK + pos] = row; rowg[(size_t)my_e * NTOK + pos] = ch_g[tid]; tokslot[row * 4 + (tid & 3)] = my_e * NTOK + pos; }
        __syncthreads();
    }
    VM_WAIT();
    __syncthreads();
}
__device__ __forceinline__ void p9_combine(Frame& F, const Args& A, const float* mod) {
    unsigned char* ws = F.ws; const LAS int* tab = (const LAS int*)(F.lds + TILETAB_OFF);
    const unsigned char* Y8 = ws + WS_Y; const int* tokslot = (const int*)(ws + WS_ROUTE + RT_TOKSLOT);
    const int lane = F.lane; const int gw = F.vcu * NWAVES + F.wave, NGW = F.G * NWAVES;
    for (int tok = gw; tok < NTOK; tok += NGW) {
        const int b = tok / SEQ; const float* g2 = mod + (size_t)b * 6 * DM + 5 * DM;
        const int4 sl = *(const int4*)(tokslot + tok * 4);
        const int s4[4] = {sl.x, sl.y, sl.z, sl.w};
        const unsigned char* yr[4];
#pragma unroll
        for (int k = 0; k < 4; ++k) { const int e = s4[k] / NTOK, p = s4[k] % NTOK; yr[k] = Y8 + (size_t)(tab[40 + e] + p) * DM + lane * 16; }
        float* orow = A.out + (size_t)tok * DM + lane * 16;
        const bf16_t* xrow = (const bf16_t*)(ws + WS_X1B) + (size_t)tok * DM + lane * 16;
#pragma unroll
        for (int j = 0; j < 2; ++j) {
            float s[16];
#pragma unroll
            for (int q = 0; q < 16; ++q) s[q] = 0.f;
#pragma unroll
            for (int k = 0; k < 4; ++k) { const u32x4 v = *(const GAS u32x4*)(yr[k] + 1024 * j);
                const unsigned w[4] = {v.x, v.y, v.z, v.w};
#pragma unroll
                for (int q = 0; q < 4; ++q) { const f32x2 lo = __builtin_amdgcn_cvt_pk_f32_fp8(w[q], false), hi2 = __builtin_amdgcn_cvt_pk_f32_fp8(w[q], true);
                    s[4 * q] += lo.x; s[4 * q + 1] += lo.y; s[4 * q + 2] += hi2.x; s[4 * q + 3] += hi2.y; } }
            const u32x4 xw0 = *(const GAS u32x4*)(xrow + 1024 * j), xw1 = *(const GAS u32x4*)(xrow + 1024 * j + 8);
            const unsigned xw[8] = {xw0.x, xw0.y, xw0.z, xw0.w, xw1.x, xw1.y, xw1.z, xw1.w};
#pragma unroll
            for (int q = 0; q < 4; ++q) { const f32x4 x0 = (f32x4){bflo(xw[2 * q]), bfhi(xw[2 * q]), bflo(xw[2 * q + 1]), bfhi(xw[2 * q + 1])}; const f32x4 ga = *(const GAS f32x4*)(g2 + lane * 16 + 1024 * j + 4 * q);
                *(GAS f32x4*)(orow + 1024 * j + 4 * q) = x0 + ga * ((f32x4){s[4 * q], s[4 * q + 1], s[4 * q + 2], s[4 * q + 3]} * 0.125f); }
        }
    }
}
constexpr int RSTAB_OFF = TILETAB_OFF + 4096;
struct ProbMix {
    static constexpr int K = DM; static constexpr bool GATHER = false, PERM = false, MIDK = true;
    g8::DenseOrder ord; const bf16_t* A; const bf16_t* Bt; const float* x; const float* mod; bf16_t* x1b; const LAS float* rs;
    __device__ __forceinline__ bool next(int i, g8::Unit& u) const { const bool ok = ord.next(i, u); u.p0 = i; return ok; }
    __device__ __forceinline__ const char* a_base(const g8::Unit& u) const { return (const char*)A + (size_t)u.pm * 256 * K * 2; }
    __device__ __forceinline__ const char* b_base(const g8::Unit& u) const { return (const char*)Bt + (size_t)u.pn * 256 * K * 2; }
    __device__ __forceinline__ void a_voff(const g8::Unit&, int R0, int C0, int R1, int C1, unsigned& v00, unsigned& v01, unsigned& v10, unsigned& v11) const {
        v00 = (unsigned)(R0 * K + C0) * 2u; v01 = (unsigned)(R1 * K + C1) * 2u; v10 = v00 + 128u * K * 2u; v11 = v01 + 128u * K * 2u; }
    __device__ __forceinline__ void midk(g8::Acc& acc, const g8::Unit& u, int wr, int fr) const {
        const LAS float* t = rs + (size_t)u.p0 * 512;
#pragma unroll
        for (int ai = 0; ai < 2; ++ai)
#pragma unroll
            for (int m = 0; m < 4; ++m) { const float r = t[(ai * 128 + wr * 64 + m * 16 + fr) * 2];
#pragma unroll
                for (int bj = 0; bj < 2; ++bj)
#pragma unroll
                    for (int n = 0; n < 2; ++n) acc[ai][bj][m][n] *= r; }
    }
    __device__ __forceinline__ void epi(const g8::Acc& acc, const g8::Unit& u, int wr, int wc, int fr, int fq) const {
        const LAS float* t = rs + (size_t)u.p0 * 512;
        const int lr0 = wr * 64 + fr, col0 = u.pn * 256 + wc * 32 + 4 * fq; const int b = u.row0 / SEQ;
        const float* g1 = mod + (size_t)b * 6 * DM + 2 * DM + col0;
        f32x4 gv[2][2];
#pragma unroll
        for (int bj = 0; bj < 2; ++bj)
#pragma unroll
            for (int n = 0; n < 2; ++n) gv[bj][n] = *(const f32x4*)(g1 + bj * 128 + n * 16);
#pragma unroll
        for (int ai = 0; ai < 2; ++ai) {
            f32x4 xv[4][2][2];
#pragma unroll
            for (int m = 0; m < 4; ++m) { const size_t off = (size_t)(u.row0 + lr0 + ai * 128 + m * 16) * DM + col0;
#pragma unroll
                for (int bj = 0; bj < 2; ++bj)
#pragma unroll
                    for (int n = 0; n < 2; ++n) xv[m][bj][n] = *(const f32x4*)(x + off + bj * 128 + n * 16); }
#pragma unroll
            for (int m = 0; m < 4; ++m) { const int lr = lr0 + ai * 128 + m * 16; const float rl = t[lr * 2 + 1]; const size_t off = (size_t)(u.row0 + lr) * DM + col0;
#pragma unroll
                for (int bj = 0; bj < 2; ++bj)
#pragma unroll
                    for (int n = 0; n < 2; ++n) { const f32x4 r = xv[m][bj][n] + gv[bj][n] * (acc[ai][bj][m][n] * rl);
                        *(u32x2*)(x1b + off + bj * 128 + n * 16) = (u32x2){pk2(r.x, r.y), pk2(r.z, r.w)}; } }
            asm volatile("" ::: "memory");
        }
    }
};
__device__ __forceinline__ void p5_build_rstab(Frame& F, const g8::DenseOrder& ord, const float* ssn, const float* ssl) {
    LAS float* rs = (LAS float*)(F.lds + RSTAB_OFF);
    g8::Unit u;
    for (int i = 0; i < 4 && ord.next(i, u); ++i) {
        for (int r = F.tid; r < 256; r += NWAVES * 64) { const int row = u.row0 + r;
            const f32x4 a = *(const GAS f32x4*)(ssn + (size_t)row * 4); float sn = (a.x + a.y) + (a.z + a.w);
            float sl = 0.f;
#pragma unroll
            for (int q = 0; q < 4; ++q) { const f32x4 c = *(const GAS f32x4*)(ssl + (size_t)row * 16 + 4 * q); sl += (c.x + c.y) + (c.z + c.w); }
            const float rn = rsqrtf(sn * (1.f / 1024.f) + EPS), rl = rsqrtf(sl * (1.f / 1024.f) + EPS);
            rs[(i * 256 + r) * 2] = rn / rl; rs[(i * 256 + r) * 2 + 1] = rl; }
    }
    __syncthreads();
}
constexpr int TOKBUF_OFF = TILETAB_OFF + 3072;
namespace g8 {
typedef int v8i __attribute__((ext_vector_type(8)));
typedef int v4i __attribute__((ext_vector_type(4)));
__host__ __device__ __forceinline__ int sw8(int row) { const int P = (row >> 1) & 7; return P ^ ((((P >> 2) ^ (P >> 1)) & 1) << 1); }
__device__ __forceinline__ void mfma16_fp8(f32x4& acc, const v8i& a, const v8i& b, int scl) {
    asm volatile("v_mfma_scale_f32_16x16x128_f8f6f4 %0, %1, %2, %0, %3, %3 op_sel_hi:[0,0,0]" : "+v"(acc) : "v"(a), "v"(b), "v"(scl)); }

template <class P>
__device__ __forceinline__ void gemm8_phase(LAS unsigned char* lds, const P& S) {
    const int tid = threadIdx.x, wid = __builtin_amdgcn_readfirstlane(tid >> 6), lane = tid & 63, wr = wid >> 2, wc = wid & 3, fr = lane & 15, fq = lane >> 4;
    constexpr int KB = P::KB, nt = KB / 128;
    const int R0 = wid * 8 + (lane >> 3), R1 = R0 + 64;
    const unsigned cs = (unsigned)(((lane & 7) ^ sw8(R0)) * 16);
    const int Rb0 = (R0 & ~31) + perm32(R0 & 31), Rb1 = (R1 & ~31) + perm32(R1 & 31);
    const unsigned voffB0 = (unsigned)Rb0 * KB + cs, voffB1 = (unsigned)Rb1 * KB + cs;
    constexpr size_t kstep = 128;
    constexpr unsigned hstep = 128u * KB;
    const unsigned ldsw = (unsigned)wid * 1024u;
    const int xr = sw8(fr);
    int aoff[2], boff[2];
#pragma unroll
    for (int c = 0; c < 2; ++c) { const int sl = ((2 * fq + c) ^ xr) << 4; aoff[c] = (64 * wr + fr) * 128 + sl; boff[c] = (32 * wc + fr) * 128 + sl; }
    int scl = 0x7f7f7f7f;
    asm volatile("" : "+v"(scl));
#define G8_SA(b, h) (((b) * 2 + (h)) * HTB)
#define G8_SB(b, h) ((4 + (b) * 2 + (h)) * HTB)
#define G8_STAGE(bufoff, gbase, o0, o1) do { \
        __builtin_amdgcn_global_load_lds((const unsigned*)((const char*)(gbase) + (o0)), (LAS unsigned*)(lds + (bufoff) + ldsw), 16, 0, 0); \
        __builtin_amdgcn_global_load_lds((const unsigned*)((const char*)(gbase) + (o1)), (LAS unsigned*)(lds + (bufoff) + ldsw + 8192), 16, 0, 0); } while (0)
#define G8_STAGEB(bufoff, gbase, h) G8_STAGE(bufoff, gbase, voffB0 + (h) * hstep, voffB1 + (h) * hstep)
#define G8_LDA(dst, b, h) do { _Pragma("unroll") for (int m = 0; m < 4; ++m) { \
        const v4i _lo = *(const LAS v4i*)(lds + G8_SA(b, h) + aoff[0] + m * 2048), _hi = *(const LAS v4i*)(lds + G8_SA(b, h) + aoff[1] + m * 2048); \
        dst[m] = __builtin_shufflevector(_lo, _hi, 0, 1, 2, 3, 4, 5, 6, 7); } } while (0)
#define G8_LDB(dst, b, h) do { _Pragma("unroll") for (int n = 0; n < 2; ++n) { \
        const v4i _lo = *(const LAS v4i*)(lds + G8_SB(b, h) + boff[0] + n * 2048), _hi = *(const LAS v4i*)(lds + G8_SB(b, h) + boff[1] + n * 2048); \
        dst[n] = __builtin_shufflevector(_lo, _hi, 0, 1, 2, 3, 4, 5, 6, 7); } } while (0)
#define G8_MMA(ai, bj, At, Bt) do { __builtin_amdgcn_s_setprio(1); _Pragma("unroll") for (int m = 0; m < 4; ++m) _Pragma("unroll") for (int n = 0; n < 2; ++n) \
        mfma16_fp8(acc[ai][bj][m][n], Bt[n], At[m], scl); __builtin_amdgcn_s_setprio(0); } while (0)
#define G8_WAIT_V(n) asm volatile("s_waitcnt vmcnt(" #n ")" ::: "memory")
#define G8_WAIT_L(n) asm volatile("s_waitcnt lgkmcnt(" #n ")" ::: "memory")
#define G8_BAR __builtin_amdgcn_s_barrier()
#define G8_SCHED __builtin_amdgcn_sched_barrier(0)
    Unit cur, nxt; int ui = 0;
    if (!S.next(0, cur)) return;
    Acc acc;
#pragma unroll
    for (int a = 0; a < 2; ++a)
#pragma unroll
        for (int b = 0; b < 2; ++b)
#pragma unroll
            for (int m = 0; m < 4; ++m)
#pragma unroll
                for (int n = 0; n < 2; ++n) acc[a][b][m][n] = (f32x4){0.f, 0.f, 0.f, 0.f};
    v8i At[4], B0[2], B1[2];
    unsigned c00, c01, c10, c11, n00, n01, n10, n11;
    S.a_voff(cur, R0, R1, cs, c00, c01, c10, c11);
    n00 = c00; n01 = c01; n10 = c10; n11 = c11;
    const char* cA = S.a_base(cur); const char* cB = S.b_base(cur);
    if (P::ROWPF) S.tok_prefetch(lds, cur, 0, wid, lane);
    G8_STAGEB(G8_SB(0, 0), cB, 0); G8_STAGEB(G8_SB(0, 1), cB, 1); G8_STAGE(G8_SA(0, 0), cA, c00, c01); G8_STAGE(G8_SA(0, 1), cA, c10, c11);
    if (wr == 1) G8_BAR;
    G8_WAIT_V(2); G8_BAR;
    G8_STAGEB(G8_SB(1, 0), cB + kstep, 0); G8_STAGE(G8_SA(1, 0), cA + kstep, c00, c01); G8_STAGEB(G8_SB(1, 1), cB + kstep, 1);
    G8_WAIT_V(6); G8_BAR;
    for (;;) {
        const bool has_next = S.next(ui + 1, nxt);
        const char* nA = has_next ? S.a_base(nxt) : cA; const char* nB = has_next ? S.b_base(nxt) : cB;
        if (P::GATHER || P::ROWPF) { if (has_next) S.tok_prefetch(lds, nxt, ui + 1, wid, lane); }
        if (P::GATHER) { n00 = c00; n01 = c01; n10 = c10; n11 = c11; }
        for (int t = 0; t < nt; t += 2) {
            const bool last = (t == nt - 2);
            if (P::MIDK) { if (t == nt / 2) S.midk(acc, cur, wr, fr); }
            if (P::GATHER) { if (last && has_next) S.a_voff_lds(lds, nxt, ui + 1, R0, R1, cs, n00, n01, n10, n11); }
            const char* a1 = cA + (size_t)(t + 1) * kstep;
            const char* a2 = last ? nA : cA + (size_t)(t + 2) * kstep; const char* b2 = last ? nB : cB + (size_t)(t + 2) * kstep;
            const char* a3 = a2 + kstep; const char* b3 = b2 + kstep;
            const unsigned x00 = (P::GATHER && last) ? n00 : c00, x01 = (P::GATHER && last) ? n01 : c01, x10 = (P::GATHER && last) ? n10 : c10, x11 = (P::GATHER && last) ? n11 : c11;
            G8_LDB(B0, 0, 0); G8_LDB(B1, 0, 1); G8_SCHED; G8_LDA(At, 0, 0); G8_STAGE(G8_SA(1, 1), a1, c10, c11);
            G8_WAIT_V(8); G8_WAIT_L(0); G8_BAR; G8_WAIT_L(0); G8_SCHED; G8_MMA(0, 0, At, B0); G8_MMA(0, 1, At, B1); G8_BAR; G8_SCHED;
            G8_LDA(At, 0, 1); G8_STAGEB(G8_SB(0, 0), b2, 0); G8_STAGEB(G8_SB(0, 1), b2, 1); G8_STAGE(G8_SA(0, 0), a2, x00, x01);
            G8_WAIT_V(8); G8_WAIT_L(0); G8_BAR; G8_WAIT_L(0); G8_SCHED; G8_MMA(1, 0, At, B0); G8_MMA(1, 1, At, B1); G8_BAR; G8_SCHED;
            G8_LDB(B0, 1, 0); G8_LDB(B1, 1, 1); G8_SCHED; G8_LDA(At, 1, 0); G8_STAGE(G8_SA(0, 1), a2, x10, x11);
            G8_WAIT_V(8); G8_WAIT_L(0); G8_BAR; G8_WAIT_L(0); G8_SCHED; G8_MMA(0, 0, At, B0); G8_MMA(0, 1, At, B1); G8_BAR; G8_SCHED;
            G8_LDA(At, 1, 1); G8_STAGEB(G8_SB(1, 0), b3, 0); G8_STAGEB(G8_SB(1, 1), b3, 1); G8_STAGE(G8_SA(1, 0), a3, x00, x01);
            G8_WAIT_V(8); G8_WAIT_L(0); G8_BAR; G8_WAIT_L(0); G8_SCHED; G8_MMA(1, 0, At, B0); G8_MMA(1, 1, At, B1); G8_BAR; G8_SCHED;
        }
        asm volatile("s_nop 15\n\ts_nop 15" ::: "memory");
        if (wr == 0) G8_BAR;
        { int tz = threadIdx.x; asm volatile("" : "+v"(tz));
          const int lz = tz & 63; S.epi(acc, cur, wr, wc, lz & 15, lz >> 4, lds, ui); }
        if (!has_next) break;
#pragma unroll
        for (int a = 0; a < 2; ++a)
#pragma unroll
            for (int b = 0; b < 2; ++b)
#pragma unroll
                for (int m = 0; m < 4; ++m)
#pragma unroll
                    for (int n = 0; n < 2; ++n) acc[a][b][m][n] = (f32x4){0.f, 0.f, 0.f, 0.f};
        cur = nxt; cA = nA; cB = nB; ++ui;
        if (P::GATHER) { c00 = n00; c01 = n01; c10 = n10; c11 = n11; }
        if (wr == 1) G8_BAR;
    }
    G8_WAIT_V(0);
    G8_BAR;
#undef G8_SA
#undef G8_SB
#undef G8_STAGE
#undef G8_STAGEB
#undef G8_LDA
#undef G8_LDB
#undef G8_MMA
#undef G8_WAIT_V
#undef G8_WAIT_L
#undef G8_BAR
#undef G8_SCHED
}
}


struct Conv8Src { const float* W; int ldw, n_src0, k0; unsigned char* WT8; int dst_row0; };
__device__ __forceinline__ void conv8_load(const Conv8Src& s, f32x4 (&v)[8], int tid) {
    const int c4 = tid & 15, kr = tid >> 4;
#pragma unroll
    for (int i = 0; i < 8; ++i) v[i] = *(const GAS f32x4*)(s.W + (size_t)(s.k0 + i * 32 + kr) * s.ldw + s.n_src0 + 4 * c4);
}
__device__ __forceinline__ void conv8_to_lds(const f32x4 (&v)[8], LAS float* scr, int tid) {
    const int c4 = tid & 15, kr = tid >> 4;
#pragma unroll
    for (int i = 0; i < 8; ++i) { const int k = i * 32 + kr; const int g = 4 * ((k >> 4) & 7) + 2 * (k >> 7);
        *(LAS f32x2*)(scr + k * 64 + ((4 * c4) ^ g)) = (f32x2){v[i].x, v[i].y}; *(LAS f32x2*)(scr + k * 64 + ((4 * c4 + 2) ^ g)) = (f32x2){v[i].z, v[i].w}; }
}
__device__ __forceinline__ void conv8_store(const Conv8Src& sd, const LAS float* scr, int tid) {
    const int kc = tid & 15, ns = tid >> 4; const int g = 4 * (kc & 7) + 2 * (kc >> 3);
#pragma unroll
    for (int p = 0; p < 2; ++p) { const int n = ns + 32 * p; const LAS float* s = scr + (16 * kc) * 64 + (n ^ g);
        u32x4 o;
        o.x = pk4_fp8(s[0 * 64] * 32.f, s[1 * 64] * 32.f, s[2 * 64] * 32.f, s[3 * 64] * 32.f);     o.y = pk4_fp8(s[4 * 64] * 32.f, s[5 * 64] * 32.f, s[6 * 64] * 32.f, s[7 * 64] * 32.f);
        o.z = pk4_fp8(s[8 * 64] * 32.f, s[9 * 64] * 32.f, s[10 * 64] * 32.f, s[11 * 64] * 32.f);   o.w = pk4_fp8(s[12 * 64] * 32.f, s[13 * 64] * 32.f, s[14 * 64] * 32.f, s[15 * 64] * 32.f);
        *(GAS u32x4*)(sd.WT8 + (size_t)(sd.dst_row0 + n) * DM + sd.k0 + 16 * kc) = o; }
}

struct ProbM1F {
    static constexpr int KB = DM; static constexpr bool GATHER = true, ROWPF = false, MIDK = false;
    MoeOrder ord; const unsigned char* H8; const unsigned char* W1T8; const float* b1; const int* rowtok; unsigned char* ACT8;
    __device__ __forceinline__ bool next(int i, g8::Unit& u) const { return ord.next(i, u); }
    __device__ __forceinline__ const char* a_base(const g8::Unit&) const { return (const char*)H8; }
    __device__ __forceinline__ const char* b_base(const g8::Unit& u) const { return (const char*)W1T8 + ((size_t)u.e * 4096 + (size_t)u.pn * 256) * KB; }
    __device__ __forceinline__ void a_voff(const g8::Unit& u, int R0, int R1, unsigned cs, unsigned& v00, unsigned& v01, unsigned& v10, unsigned& v11) const {
        const int cntE = ord.tab[8 + u.e]; const int* rt = rowtok + (size_t)u.e * NTOK + u.p0; const int lim = cntE - u.p0;
        const int t00 = (R0 < lim) ? rt[R0] : 0, t01 = (R1 < lim) ? rt[R1] : 0, t10 = (128 + R0 < lim) ? rt[128 + R0] : 0, t11 = (128 + R1 < lim) ? rt[128 + R1] : 0;
        v00 = (unsigned)t00 * KB + cs; v01 = (unsigned)t01 * KB + cs; v10 = (unsigned)t10 * KB + cs; v11 = (unsigned)t11 * KB + cs; }
    __device__ __forceinline__ void tok_prefetch(LAS unsigned char* lds, const g8::Unit& u, int ui, int wid, int lane) const {
        if (wid == 0) __builtin_amdgcn_global_load_lds((const unsigned*)(rowtok + (size_t)u.e * NTOK + u.p0 + lane * 4), (LAS unsigned*)(lds + TOKBUF_OFF + (ui & 1) * 1024), 16, 0, 0); }
    __device__ __forceinline__ void a_voff_lds(const LAS unsigned char* lds, const g8::Unit& u, int ui, int R0, int R1, unsigned cs, unsigned& v00, unsigned& v01, unsigned& v10, unsigned& v11) const {
        const LAS int* rt = (const LAS int*)(lds + TOKBUF_OFF + (ui & 1) * 1024); const int lim = ord.tab[8 + u.e] - u.p0;
        const int t00 = (R0 < lim) ? rt[R0] : 0, t01 = (R1 < lim) ? rt[R1] : 0, t10 = (128 + R0 < lim) ? rt[128 + R0] : 0, t11 = (128 + R1 < lim) ? rt[128 + R1] : 0;
        v00 = (unsigned)t00 * KB + cs; v01 = (unsigned)t01 * KB + cs; v10 = (unsigned)t10 * KB + cs; v11 = (unsigned)t11 * KB + cs; }
    __device__ __forceinline__ void midk(g8::Acc&, const g8::Unit&, int, int) const {}
    __device__ __forceinline__ void epi(const g8::Acc& acc, const g8::Unit& u, int wr, int wc, int fr, int fq, const LAS unsigned char* lds, int ui) const {
        const int cc = u.pn * 128 + wc * 32 + 8 * fq;
        const float* bg = b1 + (size_t)u.e * 4096 + cc; const float* bl = bg + 2048;
        f32x4 bgv[2], blv[2];
#pragma unroll
        for (int n = 0; n < 2; ++n) { bgv[n] = *(const f32x4*)(bg + 4 * n); blv[n] = *(const f32x4*)(bl + 4 * n) + 1.f; }
#pragma unroll
        for (int ai = 0; ai < 2; ++ai)
#pragma unroll
            for (int m = 0; m < 4; ++m) {
                unsigned w[2];
#pragma unroll
                for (int n = 0; n < 2; ++n) { f32x2 o2[2];
#pragma unroll
                    for (int h2 = 0; h2 < 2; ++h2) {
                        const f32x2 ag = (f32x2){acc[ai][0][m][n][2 * h2], acc[ai][0][m][n][2 * h2 + 1]}, al = (f32x2){acc[ai][1][m][n][2 * h2], acc[ai][1][m][n][2 * h2 + 1]};
                        const f32x2 bgg = (f32x2){bgv[n][2 * h2], bgv[n][2 * h2 + 1]}, bll = (f32x2){blv[n][2 * h2], blv[n][2 * h2 + 1]};
                        f32x2 ug = ag * 0.03125f + bgg, ul = al * 0.03125f + bll;
                        ug.x = fminf(ug.x, 7.f); ug.y = fminf(ug.y, 7.f); ul.x = fminf(fmaxf(ul.x, -6.f), 8.f); ul.y = fminf(fmaxf(ul.y, -6.f), 8.f);
                        const f32x2 ea = ug * (-1.702f * 1.4426950408889634f);
                        f32x2 den; den.x = __builtin_amdgcn_exp2f(ea.x); den.y = __builtin_amdgcn_exp2f(ea.y); den = den + 1.f;
                        f32x2 sg; sg.x = __builtin_amdgcn_rcpf(den.x); sg.y = __builtin_amdgcn_rcpf(den.y);
                        o2[h2] = (ug * sg) * ul; }
                    w[n] = pk4_fp8(o2[0].x, o2[0].y, o2[1].x, o2[1].y); }
                *(u32x2*)(ACT8 + (size_t)(u.row0 + ai * 128 + wr * 64 + m * 16 + fr) * DM + cc) = (u32x2){w[0], w[1]}; }
    }
};
struct ProbM2F {
    static constexpr int KB = DM; static constexpr bool GATHER = false, ROWPF = true, MIDK = false;
    MoeOrder ord; const unsigned char* ACT8; const unsigned char* W2T8; const float* b2; const float* rowg; unsigned char* Y8;
    __device__ __forceinline__ bool next(int i, g8::Unit& u) const { return ord.next(i, u); }
    __device__ __forceinline__ const char* a_base(const g8::Unit& u) const { return (const char*)ACT8 + (size_t)u.row0 * KB; }
    __device__ __forceinline__ const char* b_base(const g8::Unit& u) const { return (const char*)W2T8 + ((size_t)u.e * DM + (size_t)u.pn * 256) * KB; }
    __device__ __forceinline__ void a_voff(const g8::Unit&, int R0, int R1, unsigned cs, unsigned& v00, unsigned& v01, unsigned& v10, unsigned& v11) const {
        v00 = (unsigned)R0 * KB + cs; v01 = (unsigned)R1 * KB + cs; v10 = v00 + 128u * KB; v11 = v01 + 128u * KB; }
    __device__ __forceinline__ void tok_prefetch(LAS unsigned char* lds, const g8::Unit& u, int ui, int wid, int lane) const {
        if (wid == 0) __builtin_amdgcn_global_load_lds((const unsigned*)(rowg + (size_t)u.e * NTOK + u.p0 + lane * 4), (LAS unsigned*)(lds + RSTAB_OFF + (ui % 3) * 1024), 16, 0, 0); }
    __device__ __forceinline__ void a_voff_lds(const LAS unsigned char*, const g8::Unit&, int, int, int, unsigned, unsigned&, unsigned&, unsigned&, unsigned&) const {}
    __device__ __forceinline__ void midk(g8::Acc&, const g8::Unit&, int, int) const {}
    __device__ __forceinline__ void epi(const g8::Acc& acc, const g8::Unit& u, int wr, int wc, int fr, int fq, const LAS unsigned char* lds, int ui) const {
        const int lr0 = wr * 64 + fr, col0 = u.pn * 256 + wc * 32 + 8 * fq;
        const LAS float* rg = (const LAS float*)(lds + RSTAB_OFF + (ui % 3) * 1024) + lr0;
        f32x4 bv[2][2];
#pragma unroll
        for (int bj = 0; bj < 2; ++bj)
#pragma unroll
            for (int n = 0; n < 2; ++n) bv[bj][n] = *(const f32x4*)(b2 + (size_t)u.e * DM + col0 + bj * 128 + 4 * n);
#pragma unroll
        for (int ai = 0; ai < 2; ++ai)
#pragma unroll
            for (int m = 0; m < 4; ++m) { const float gsc = rg[ai * 128 + m * 16] * 8.f; unsigned char* rowp = Y8 + (size_t)(u.row0 + lr0 + ai * 128 + m * 16) * DM + col0;
#pragma unroll
                for (int bj = 0; bj < 2; ++bj) { const f32x4 v0 = (acc[ai][bj][m][0] * 0.03125f + bv[bj][0]) * gsc, v1 = (acc[ai][bj][m][1] * 0.03125f + bv[bj][1]) * gsc;
                    *(u32x2*)(rowp + bj * 128) = (u32x2){pk4_fp8(v0[0], v0[1], v0[2], v0[3]), pk4_fp8(v1[0], v1[1], v1[2], v1[3])}; } }
    }
};

struct ProbMix8 {
    static constexpr int KB = DM; static constexpr bool GATHER = false, ROWPF = false, MIDK = true;
    g8::DenseOrder ord; const unsigned char* A8; const unsigned char* W8; const float* x; const float* mod; bf16_t* x1b; const LAS float* rs;
    __device__ __forceinline__ bool next(int i, g8::Unit& u) const { const bool ok = ord.next(i, u); u.p0 = i; return ok; }
    __device__ __forceinline__ const char* a_base(const g8::Unit& u) const { return (const char*)A8 + (size_t)u.pm * 256 * KB; }
    __device__ __forceinline__ const char* b_base(const g8::Unit& u) const { return (const char*)W8 + (size_t)u.pn * 256 * KB; }
    __device__ __forceinline__ void a_voff(const g8::Unit&, int R0, int R1, unsigned cs, unsigned& v00, unsigned& v01, unsigned& v10, unsigned& v11) const {
        v00 = (unsigned)R0 * KB + cs; v01 = (unsigned)R1 * KB + cs; v10 = v00 + 128u * KB; v11 = v01 + 128u * KB; }
    __device__ __forceinline__ void tok_prefetch(LAS unsigned char*, const g8::Unit&, int, int, int) const {}
    __device__ __forceinline__ void a_voff_lds(const LAS unsigned char*, const g8::Unit&, int, int, int, unsigned, unsigned&, unsigned&, unsigned&, unsigned&) const {}
    __device__ __forceinline__ void midk(g8::Acc& acc, const g8::Unit& u, int wr, int fr) const {
        const LAS float* t = rs + (size_t)u.p0 * 512;
#pragma unroll
        for (int ai = 0; ai < 2; ++ai)
#pragma unroll
            for (int m = 0; m < 4; ++m) { const float r = t[(ai * 128 + wr * 64 + m * 16 + fr) * 2];
#pragma unroll
                for (int bj = 0; bj < 2; ++bj)
#pragma unroll
                    for (int n = 0; n < 2; ++n) acc[ai][bj][m][n] *= r; }
    }
    __device__ __forceinline__ void epi(const g8::Acc& acc, const g8::Unit& u, int wr, int wc, int fr, int fq, const LAS unsigned char*, int) const {
        const LAS float* t = rs + (size_t)u.p0 * 512;
        const int lr0 = wr * 64 + fr, col0 = u.pn * 256 + wc * 32 + 8 * fq; const int b = u.row0 / SEQ;
        const float* g1 = mod + (size_t)b * 6 * DM + 2 * DM + col0;
        f32x4 gv[2][2];
#pragma unroll
        for (int bj = 0; bj < 2; ++bj)
#pragma unroll
            for (int n = 0; n < 2; ++n) gv[bj][n] = *(const f32x4*)(g1 + bj * 128 + 4 * n) * (1.f / (32.f * A2_SCALE));
#pragma unroll
        for (int ai = 0; ai < 2; ++ai) {
            f32x4 xv[4][2][2];
#pragma unroll
            for (int m = 0; m < 4; ++m) { const size_t off = (size_t)(u.row0 + lr0 + ai * 128 + m * 16) * DM + col0;
#pragma unroll
                for (int bj = 0; bj < 2; ++bj)
#pragma unroll
                    for (int n = 0; n < 2; ++n) xv[m][bj][n] = *(const f32x4*)(x + off + bj * 128 + 4 * n); }
#pragma unroll
            for (int m = 0; m < 4; ++m) { const int lr = lr0 + ai * 128 + m * 16; const float rl = t[lr * 2 + 1]; const size_t off = (size_t)(u.row0 + lr) * DM + col0;
#pragma unroll
                for (int bj = 0; bj < 2; ++bj) { const f32x4 r0 = xv[m][bj][0] + gv[bj][0] * (acc[ai][bj][m][0] * rl), r1 = xv[m][bj][1] + gv[bj][1] * (acc[ai][bj][m][1] * rl);
                    *(u32x4*)(x1b + off + bj * 128) = (u32x4){pk2(r0.x, r0.y), pk2(r0.z, r0.w), pk2(r1.x, r1.y), pk2(r1.z, r1.w)}; } }
            asm volatile("" ::: "memory");
        }
    }
};

constexpr int CONV_NIT1 = NE * 16 * 64, CONV_NIT = CONV_NIT1 + NE * 16 * 32, CONV_NITX = CONV_NIT + 16 * 32;
struct Conv8Item { const float* W; int ldw, n_src0, k0; unsigned char* WT8; int dst_row0; };
__device__ __forceinline__ Conv8Item conv8_item_of(const Args& A, unsigned char* ws, int it) {
    constexpr int I1 = NE * 16 * 64;
    Conv8Item s;
    if (it < I1) { const int nb = it & 63, kb = (it >> 6) & 15, e = it >> 10; const int d0 = nb * 64, pn = d0 >> 8, rr = d0 & 255;
        s.W = A.in[25] + (size_t)e * DM * 4096; s.ldw = 4096; s.n_src0 = (rr < 128) ? (pn * 128 + rr) : (2048 + pn * 128 + rr - 128); s.k0 = kb * 128; s.WT8 = ws + WS_W1 + (size_t)e * 4096 * DM; s.dst_row0 = d0; }
    else if (it < CONV_NIT) { const int r = it - I1; const int nb = r & 31, kb = (r >> 5) & 15, e = r >> 9;
        s.W = A.in[27] + (size_t)e * DM * DM; s.ldw = DM; s.n_src0 = nb * 64; s.k0 = kb * 128; s.WT8 = ws + WS_W2 + (size_t)e * DM * DM; s.dst_row0 = nb * 64; }
    else { const int r = it - CONV_NIT; const int nb = r & 31, kb = r >> 5;
        s.W = A.in[21]; s.ldw = DM; s.n_src0 = nb * 64; s.k0 = kb * 128; s.WT8 = ws + WS_WOUT; s.dst_row0 = nb * 64; }
    return s;
}
__device__ __forceinline__ void conv8_dma(const Conv8Item& s, LAS unsigned char* buf, int wave, int lane) {
#pragma unroll
    for (int i = 0; i < 4; ++i) { const int q = wave * 4 + i, k = 4 * q + (lane >> 4), c = lane & 15;
        const float* src = s.W + (size_t)(s.k0 + k) * s.ldw + s.n_src0 + ((c ^ ((k >> 4) & 7)) << 2);
        __builtin_amdgcn_global_load_lds((const unsigned*)src, (LAS unsigned*)(buf + q * 1024), 16, 0, 2); }
}
__device__ __forceinline__ void conv8_out(const Conv8Item& sd, const LAS float* scr, int tid) {
    const int kc = tid & 7, n = tid >> 3; const LAS float* s = scr + (16 * kc) * 64 + ((((n >> 2) ^ kc)) << 2) + (n & 3);
    u32x4 o;
    o.x = pk4_fp8(s[0 * 64] * 32.f, s[1 * 64] * 32.f, s[2 * 64] * 32.f, s[3 * 64] * 32.f);     o.y = pk4_fp8(s[4 * 64] * 32.f, s[5 * 64] * 32.f, s[6 * 64] * 32.f, s[7 * 64] * 32.f);
    o.z = pk4_fp8(s[8 * 64] * 32.f, s[9 * 64] * 32.f, s[10 * 64] * 32.f, s[11 * 64] * 32.f);   o.w = pk4_fp8(s[12 * 64] * 32.f, s[13 * 64] * 32.f, s[14 * 64] * 32.f, s[15 * 64] * 32.f);
    *(GAS u32x4*)(sd.WT8 + (size_t)(sd.dst_row0 + n) * DM + sd.k0 + 16 * kc) = o;
}
__device__ __forceinline__ void p0_experts(Frame& F, const Args& A, int cv, int cG, int it_lo, int it_hi) {
    unsigned char* ws = F.ws;
    const int npb = (it_hi - it_lo + cG - 1) / cG, first = it_lo + cv * npb, n = (first + npb <= it_hi) ? npb : (it_hi - first);
    if (n <= 0) return;
#define P0_ITEM(j) conv8_item_of(A, ws, first + (((j) < n) ? (j) : n - 1))
    Conv8Item cur = P0_ITEM(0);
    conv8_dma(cur, F.lds, F.wave, F.lane);
#pragma unroll 1
    for (int j = 1; j < 4; ++j) { const Conv8Item t = P0_ITEM(j); conv8_dma(t, F.lds + j * 32768, F.wave, F.lane); }
    int bi = 0, bn = 4;
#pragma unroll 1
    for (int i = 0; i < n; ++i) {
        if (i < 3) asm volatile("s_waitcnt vmcnt(12)" ::: "memory"); else asm volatile("s_waitcnt vmcnt(15)" ::: "memory");
        asm volatile("s_waitcnt lgkmcnt(0)" ::: "memory"); __builtin_amdgcn_s_barrier(); asm volatile("" ::: "memory");
        { const Conv8Item t4 = P0_ITEM(i + 4); conv8_dma(t4, F.lds + bn * 32768, F.wave, F.lane); }
        conv8_out(cur, (const LAS float*)(F.lds + bi * 32768), F.tid);
        cur = P0_ITEM(i + 1);
        bi = (bi == 4) ? 0 : bi + 1; bn = (bn == 4) ? 0 : bn + 1;
    }
#undef P0_ITEM
    asm volatile("s_waitcnt vmcnt(0)" ::: "memory");
    __syncthreads();
    for (int u = F.tid; u < (LDS_BYTES - LDSCTL_OFF) / 4; u += NWAVES * 64) ((LAS unsigned*)(F.lds + LDSCTL_OFF))[u] = 0u;
    __syncthreads();
}
constexpr int LRU_LDS_PER_WAVE = 16384, LRU_XG_OFF = 9728;
__device__ __forceinline__ float gelu_tanh_f(float x) { return x * fast_sigmoid(1.5957691216057308f * (x + 0.044715f * x * x * x)); }
template <bool PASSB>
__device__ __forceinline__ void lru_item(Frame& F, const Args& A, int item) {
    const int n = item & 15, ck = (item >> 4) & 31, b = item >> 9;
    const int lane = F.lane, l15 = lane & 15, q = lane >> 4;
    unsigned char* ws = F.ws;
    const bf16_t* Z = (const bf16_t*)(ws + WS_Z);
    LAS bf16_t* xl = (LAS bf16_t*)(F.lds + F.wave * LRU_LDS_PER_WAVE);
    LAS bf16_t* xgl = (LAS bf16_t*)(F.lds + F.wave * LRU_LDS_PER_WAVE + LRU_XG_OFF);
    const int t0 = ck * 64; const size_t tokbase = (size_t)b * SEQ;
    float* AS = (float*)(ws + WS_LRUS); float* HS = AS + (size_t)NB * 32 * 1024;
#pragma unroll
    for (int j0 = 0; j0 < 72; j0 += 8) { const int j = j0 + (lane >> 3), t = t0 - 3 + j;
        u32x4 v = (u32x4){0u, 0u, 0u, 0u};
        if (j < 67 && t >= 0) v = *(const GAS u32x4*)(Z + (tokbase + t) * ZW + ZC_XR + n * 64 + (lane & 7) * 8);
        if (j < 67) *(LAS u32x4*)(xl + j * 72 + (lane & 7) * 8) = v; }
    u32x4 xg0[4], xg1[4];
    if (PASSB) {
#pragma unroll
        for (int i = 0; i < 4; ++i) { const int r = 8 * i + (lane >> 3);
            xg0[i] = *(const GAS u32x4*)(Z + (tokbase + t0 + r) * ZW + ZC_XG + n * 64 + (lane & 7) * 8);
            xg1[i] = *(const GAS u32x4*)(Z + (tokbase + t0 + 32 + r) * ZW + ZC_XG + n * 64 + (lane & 7) * 8); }
#pragma unroll
        for (int i = 0; i < 4; ++i) *(LAS u32x4*)(xgl + (8 * i + (lane >> 3)) * 72 + (lane & 7) * 8) = xg0[i];
    }
    const bf16_t* wrg = (const bf16_t*)(ws + WS_SMALL + SM_WRG) + (size_t)n * 4096; const bf16_t* wig = (const bf16_t*)(ws + WS_SMALL + SM_WIG) + (size_t)n * 4096;
    bf16x8 fr_[4][2], fi_[4][2]; float brg[4], big[4], c8[4];
#pragma unroll
    for (int nt = 0; nt < 4; ++nt) {
#pragma unroll
        for (int s = 0; s < 2; ++s) { fr_[nt][s] = *(const GAS bf16x8*)(wrg + (16 * nt + l15) * 64 + 32 * s + 8 * q); fi_[nt][s] = *(const GAS bf16x8*)(wig + (16 * nt + l15) * 64 + 32 * s + 8 * q); }
        const int ch = n * 64 + 16 * nt + l15; brg[nt] = A.in[15][ch]; big[nt] = A.in[17][ch];
        const float L = A.in[18][ch]; const float sp = (L < 0.f) ? (-L + log1pf(__expf(L))) : log1pf(__expf(-L)); c8[nt] = -8.f * sp; }
    LDS_WAIT();
    { const int ch = n * 64 + lane; const float w0 = A.in[12][ch], w1 = A.in[12][1024 + ch], w2 = A.in[12][2048 + ch], w3 = A.in[12][3072 + ch], cb = A.in[13][ch];
      float x0 = bf2f(xl[lane]), x1 = bf2f(xl[72 + lane]), x2 = bf2f(xl[144 + lane]);
#pragma unroll 8
      for (int t = 0; t < 64; ++t) { const float x3 = bf2f(xl[(t + 3) * 72 + lane]); const float xc = cb + w0 * x0 + w1 * x1 + w2 * x2 + w3 * x3; xl[t * 72 + lane] = (bf16_t)f2bf(xc); x0 = x1; x1 = x2; x2 = x3; } }
    LDS_WAIT();
    float carry[4], atot[4];
#pragma unroll
    for (int nt = 0; nt < 4; ++nt) { carry[nt] = 0.f; atot[nt] = 1.f; }
    if (PASSB) {
#pragma unroll 1
        for (int j0 = 0; j0 < ck; j0 += 8) {
            float ta[8][4], th[8][4];
#pragma unroll
            for (int jj = 0; jj < 8; ++jj) { const int j = (j0 + jj < ck) ? j0 + jj : ck - 1;
#pragma unroll
                for (int nt = 0; nt < 4; ++nt) { const size_t o = ((size_t)b * 32 + j) * 1024 + n * 64 + 16 * nt + l15; ta[jj][nt] = AS[o]; th[jj][nt] = HS[o]; } }
#pragma unroll
            for (int jj = 0; jj < 8; ++jj) { if (j0 + jj < ck) {
#pragma unroll
                for (int nt = 0; nt < 4; ++nt) carry[nt] = ta[jj][nt] * carry[nt] + th[jj][nt]; } }
        }
    }
    float gout[4];
#pragma unroll
    for (int nt = 0; nt < 4; ++nt) gout[nt] = PASSB ? A.in[20][n * 64 + 16 * nt + l15] : 0.f;
#pragma unroll 1
    for (int mt = 0; mt < 4; ++mt) {
        const bf16x8 a0 = *(const LAS bf16x8*)(xl + (16 * mt + l15) * 72 + 8 * q), a1 = *(const LAS bf16x8*)(xl + (16 * mt + l15) * 72 + 32 + 8 * q);
        float xg[4][4];
        if (PASSB) {
            if (mt == 2) {
                LDS_WAIT();
#pragma unroll
                for (int i = 0; i < 4; ++i) *(LAS u32x4*)(xgl + (8 * i + (lane >> 3)) * 72 + (lane & 7) * 8) = xg1[i];
                LDS_WAIT();
            }
#pragma unroll
            for (int nt = 0; nt < 4; ++nt)
#pragma unroll
                for (int r = 0; r < 4; ++r) xg[nt][r] = bf2f(xgl[(16 * (mt & 1) + 4 * q + r) * 72 + 16 * nt + l15]);
        }
        float ss[4] = {0.f, 0.f, 0.f, 0.f};
#pragma unroll
        for (int nt = 0; nt < 4; ++nt) {
            f32x4 ar = (f32x4){0.f, 0.f, 0.f, 0.f}, ai = ar;
            ar = __builtin_amdgcn_mfma_f32_16x16x32_bf16(a0, fr_[nt][0], ar, 0, 0, 0); ar = __builtin_amdgcn_mfma_f32_16x16x32_bf16(a1, fr_[nt][1], ar, 0, 0, 0);
            ai = __builtin_amdgcn_mfma_f32_16x16x32_bf16(a0, fi_[nt][0], ai, 0, 0, 0); ai = __builtin_amdgcn_mfma_f32_16x16x32_bf16(a1, fi_[nt][1], ai, 0, 0, 0);
            float av[4], uv[4];
#pragma unroll
            for (int r = 0; r < 4; ++r) {
                const float rg = fast_sigmoid(ar[r] + brg[nt]), ig = fast_sigmoid(ai[r] + big[nt]);
                const float la = c8[nt] * rg; av[r] = __expf(la);
                uv[r] = sqrtf(fmaxf(1.f - av[r] * av[r], 0.f)) * ig * bf2f(xl[(16 * mt + 4 * q + r) * 72 + 16 * nt + l15]);
            }
            const float A4 = (av[0] * av[1]) * (av[2] * av[3]);
            const float H4 = ((uv[0] * av[1] + uv[1]) * av[2] + uv[2]) * av[3] + uv[3];
            float hin = carry[nt], hc = carry[nt], ap = 1.f;
#pragma unroll
            for (int qq = 0; qq < 4; ++qq) { const float Aq = __shfl(A4, l15 + 16 * qq), Hq = __shfl(H4, l15 + 16 * qq);
                hc = Aq * hc + Hq; ap *= Aq; if (qq < q) hin = Aq * hin + Hq; }
            carry[nt] = hc; atot[nt] *= ap;
            if (PASSB) {
                float h = hin;
#pragma unroll
                for (int r = 0; r < 4; ++r) { h = av[r] * h + uv[r]; const float o = h * gelu_tanh_f(xg[nt][r]); ss[r] += o * o;
                    (ws + WS_A2)[(tokbase + t0 + 16 * mt + 4 * q + r) * DM + 1024 + n * 64 + 16 * nt + l15] = (unsigned char)(pk4_fp8c(o * gout[nt] * A2_SCALE, 0.f, 0.f, 0.f) & 0xffu); }
            }
        }
        if (PASSB) {
#pragma unroll
            for (int r = 0; r < 4; ++r) { float v = ss[r]; v += __shfl_xor(v, 1); v += __shfl_xor(v, 2); v += __shfl_xor(v, 4); v += __shfl_xor(v, 8);
                if (l15 == 0) ((float*)(ws + WS_SSL))[(tokbase + t0 + 16 * mt + 4 * q + r) * 16 + n] = v; }
        }
    }
    if (!PASSB) { if (q == 0) {
#pragma unroll
        for (int nt = 0; nt < 4; ++nt) { const size_t o = ((size_t)b * 32 + ck) * 1024 + n * 64 + 16 * nt + l15; AS[o] = atot[nt]; HS[o] = carry[nt]; } } }
    LDS_WAIT();
}
constexpr float C2 = 0.125f * 1.4426950408889634f;
__device__ __forceinline__ int crow(int r, int hi) { return (r & 3) + 8 * (r >> 2) + 4 * hi; }

__device__ __forceinline__ void prep_item(Frame& F, const Args& A, int item) {
    const int b = item >> 5, tl = item & 31; const size_t tok0 = (size_t)b * SEQ + tl * 64;
    unsigned char* ws = F.ws; bf16_t* Z = (bf16_t*)(ws + WS_Z);
    const int tid = F.tid;
    u32x4 qv[16];
    const f32x4 qga = *(const GAS f32x4*)(A.in[10] + (tid & 7) * 8), qgb = *(const GAS f32x4*)(A.in[10] + (tid & 7) * 8 + 4);
#pragma unroll
    for (int it = 0; it < 16; ++it) { const int u = it * 512 + tid, c = u & 7, h = (u >> 3) & 15, r = u >> 7; qv[it] = *(const GAS u32x4*)(Z + (tok0 + r) * ZW + h * 64 + c * 8); }
#pragma unroll
    for (int it = 0; it < 16; ++it) {
        const int u = it * 512 + tid, c = u & 7, h = (u >> 3) & 15, r = u >> 7;
        bf16_t* p = Z + (tok0 + r) * ZW + h * 64 + c * 8;
        const u32x4 v = qv[it];
        float f[8] = {bflo(v.x), bfhi(v.x), bflo(v.y), bfhi(v.y), bflo(v.z), bfhi(v.z), bflo(v.w), bfhi(v.w)};
        float ss = 0.f;
#pragma unroll
        for (int j = 0; j < 8; ++j) ss += f[j] * f[j];
        ss += __shfl_xor(ss, 1); ss += __shfl_xor(ss, 2); ss += __shfl_xor(ss, 4);
        const float rs = rsqrtf(ss * (1.f / 64.f) + EPS) * C2;
        const f32x4 ga = qga, gb = qgb;
        u32x4 o; o.x = pk2(f[0] * rs * ga.x, f[1] * rs * ga.y); o.y = pk2(f[2] * rs * ga.z, f[3] * rs * ga.w); o.z = pk2(f[4] * rs * gb.x, f[5] * rs * gb.y); o.w = pk2(f[6] * rs * gb.z, f[7] * rs * gb.w);
        *(GAS u32x4*)p = o;
    }
    { const int c = tid & 7, r = tid >> 3;
      u32x4 kv[2][4]; f32x4 kga[2], kgb[2];
#pragma unroll
      for (int br = 0; br < 2; ++br) { const float* kg = A.in[11] + (1 + br) * 64 + c * 8; kga[br] = *(const GAS f32x4*)kg; kgb[br] = *(const GAS f32x4*)(kg + 4); }
#pragma unroll
      for (int br = 0; br < 2; ++br)
#pragma unroll
        for (int g = 0; g < 4; ++g) kv[br][g] = *(const GAS u32x4*)(Z + (tok0 + r) * ZW + (br ? ZC_KW : ZC_KS) + g * 64 + c * 8);
#pragma unroll
      for (int br = 0; br < 2; ++br)
#pragma unroll
        for (int g = 0; g < 4; ++g) {
            const u32x4 v = kv[br][g];
            float f[8] = {bflo(v.x), bfhi(v.x), bflo(v.y), bfhi(v.y), bflo(v.z), bfhi(v.z), bflo(v.w), bfhi(v.w)};
            float ss = 0.f;
#pragma unroll
            for (int j = 0; j < 8; ++j) ss += f[j] * f[j];
            ss += __shfl_xor(ss, 1); ss += __shfl_xor(ss, 2); ss += __shfl_xor(ss, 4);
            const float rs = rsqrtf(ss * (1.f / 64.f) + EPS);
            const f32x4 ga = kga[br], gb = kgb[br];
            u32x4 o; o.x = pk2(f[0] * rs * ga.x, f[1] * rs * ga.y); o.y = pk2(f[2] * rs * ga.z, f[3] * rs * ga.w); o.z = pk2(f[4] * rs * gb.x, f[5] * rs * gb.y); o.w = pk2(f[6] * rs * gb.z, f[7] * rs * gb.w);
            unsigned char* img = ws + WS_KIMG + (br ? KI_KW : KI_KS) + ((size_t)(b * 4 + g) * 32 + tl) * 8192;
            *(GAS u32x4*)(img + c * 1024 + r * 16) = o;
        }
    }
    { LAS bf16_t* vt = (LAS bf16_t*)F.lds;
      const int c = tid & 7, r = tid >> 3;
      u32x4 vv[8];
#pragma unroll
      for (int k = 0; k < 8; ++k) { const int br = k >> 2, g = k & 3; vv[k] = *(const GAS u32x4*)(Z + (tok0 + r) * ZW + (br ? ZC_VW : ZC_VS) + g * 64 + c * 8); }
      asm volatile("" : "+v"(vv[0]), "+v"(vv[1]), "+v"(vv[2]), "+v"(vv[3]), "+v"(vv[4]), "+v"(vv[5]), "+v"(vv[6]), "+v"(vv[7]));
#pragma unroll
      for (int k = 0; k < 8; ++k) *(LAS u32x4*)(vt + k * 4608 + r * 72 + c * 8) = vv[k];
      __syncthreads();
#pragma unroll
      for (int k = 0; k < 8; ++k) { const int br = k >> 2, g = k & 3;
          unsigned char* img = ws + WS_KIMG + (br ? KI_VW : KI_VS) + ((size_t)(b * 4 + g) * 32 + tl) * 8192;
#pragma unroll
          for (int hlf = 0; hlf < 2; ++hlf) { const int un = hlf * 512 + tid, kc = un >> 6, d = un & 63;
              const LAS bf16_t* s = vt + k * 4608 + (4 * kc) * 72 + d;
              u32x2 o; o.x = (unsigned)s[0] | ((unsigned)s[72] << 16); o.y = (unsigned)s[144] | ((unsigned)s[216] << 16);
              *(GAS u32x2*)(img + kc * 512 + d * 8) = o; } }
      __syncthreads(); }
}
__device__ __forceinline__ void compress_item(Frame& F, const Args& A, int item) {
    const int which = item & 1, cg = (item >> 1) & 7, g = (item >> 4) & 3, b = item >> 6;
    const int lane = F.lane, l15 = lane & 15, q = lane >> 4, c0 = cg * 16;
    unsigned char* ws = F.ws; const bf16_t* Z = (const bf16_t*)(ws + WS_Z);
    const bf16_t* WT = (const bf16_t*)(ws + WS_SMALL + (which ? SM_WCV : SM_WCK));
    const int zc = (which ? ZC_VC : ZC_KC) + g * 64;
    f32x4 acc[4];
#pragma unroll
    for (int nt = 0; nt < 4; ++nt) acc[nt] = (f32x4){0.f, 0.f, 0.f, 0.f};
    size_t tb = (size_t)b * SEQ + 16 * (c0 + l15);
#pragma unroll 1
    for (int s0 = 0; s0 < 64; s0 += 4) {
        bf16x8 xv[4], wv[4][4];
#pragma unroll
        for (int ss = 0; ss < 4; ++ss) { const int s = s0 + ss;
            size_t trow = tb + (s >> 1); if (trow > (size_t)b * SEQ + SEQ - 1) trow = (size_t)b * SEQ + SEQ - 1;
            xv[ss] = *(const GAS bf16x8*)(Z + trow * ZW + zc + 32 * (s & 1) + 8 * q);
#pragma unroll
            for (int nt = 0; nt < 4; ++nt) wv[ss][nt] = *(const GAS bf16x8*)(WT + (size_t)(16 * nt + l15) * DM + 32 * s + 8 * q); }
        asm volatile("" : "+v"(xv[0]), "+v"(xv[1]), "+v"(wv[0][0]), "+v"(wv[0][1]), "+v"(wv[0][2]), "+v"(wv[0][3]), "+v"(wv[1][0]), "+v"(wv[1][1]), "+v"(wv[1][2]), "+v"(wv[1][3]) :: "memory");
        asm volatile("" : "+v"(xv[2]), "+v"(xv[3]), "+v"(wv[2][0]), "+v"(wv[2][1]), "+v"(wv[2][2]), "+v"(wv[2][3]), "+v"(wv[3][0]), "+v"(wv[3][1]), "+v"(wv[3][2]), "+v"(wv[3][3]) :: "memory");
#pragma unroll
        for (int ss = 0; ss < 4; ++ss)
#pragma unroll
            for (int nt = 0; nt < 4; ++nt) {
                if (which == 0) acc[nt] = __builtin_amdgcn_mfma_f32_16x16x32_bf16(wv[ss][nt], xv[ss], acc[nt], 0, 0, 0);
                else            acc[nt] = __builtin_amdgcn_mfma_f32_16x16x32_bf16(xv[ss], wv[ss][nt], acc[nt], 0, 0, 0); }
    }
    if (which == 0) {
        const float* bias = (const float*)(ws + WS_SMALL + SM_BIASK);
        float ss = 0.f;
#pragma unroll
        for (int nt = 0; nt < 4; ++nt) { const f32x4 bv = *(const GAS f32x4*)(bias + 16 * nt + 4 * q); acc[nt] += bv; ss += (acc[nt].x * acc[nt].x + acc[nt].y * acc[nt].y) + (acc[nt].z * acc[nt].z + acc[nt].w * acc[nt].w); }
        ss += __shfl_xor(ss, 16); ss += __shfl_xor(ss, 32);
        const float rs = rsqrtf(ss * (1.f / 64.f) + EPS);
        const int c = c0 + l15, T = c >> 6, r = c & 63;
        unsigned char* img = ws + WS_KIMG + KI_KC + ((size_t)(b * 4 + g) * 2 + T) * 8192;
#pragma unroll
        for (int nt = 0; nt < 4; ++nt) { const f32x4 kg = *(const GAS f32x4*)(A.in[11] + 16 * nt + 4 * q);
            u32x2 o; o.x = pk2(acc[nt].x * rs * kg.x, acc[nt].y * rs * kg.y); o.y = pk2(acc[nt].z * rs * kg.z, acc[nt].w * rs * kg.w);
            if (c == 127) { o.x = 0u; o.y = 0u; }
            *(GAS u32x2*)(img + (2 * nt + (q >> 1)) * 1024 + r * 16 + (q & 1) * 8) = o; }
    } else {
        const float* bias = (const float*)(ws + WS_SMALL + SM_BIASV);
        const int cb = c0 + 4 * q, T = cb >> 6, kc = (cb & 63) >> 2;
        unsigned char* img = ws + WS_KIMG + KI_VC + ((size_t)(b * 4 + g) * 2 + T) * 8192;
#pragma unroll
        for (int nt = 0; nt < 4; ++nt) { const float bv = bias[16 * nt + l15];
            float v3 = acc[nt].w + bv; if (cb + 3 == 127) v3 = 0.f;
            u32x2 o; o.x = pk2(acc[nt].x + bv, acc[nt].y + bv); o.y = pk2(acc[nt].z + bv, v3);
            *(GAS u32x2*)(img + kc * 512 + (16 * nt + l15) * 8) = o; }
    }
}

constexpr int AT_SLOT = 16384, AT_IMP = 65536, AT_OT = 98304, AT_SEL = TILETAB_OFF, AT_SS = TILETAB_OFF + 256, AT_OST = 0;
__device__ __forceinline__ void at_stage(LAS unsigned char* lds, int slot, const unsigned char* kimg, const unsigned char* vimg, int wave, int lane) {
    __builtin_amdgcn_global_load_lds((const unsigned*)(kimg + wave * 1024 + lane * 16), (LAS unsigned*)(lds + slot * AT_SLOT + wave * 1024), 16, 0, 0);
    __builtin_amdgcn_global_load_lds((const unsigned*)(vimg + wave * 1024 + lane * 16), (LAS unsigned*)(lds + slot * AT_SLOT + 8192 + wave * 1024), 16, 0, 0);
}
__device__ __forceinline__ void at_qkt(f32x16& p0, f32x16& p1, const LAS unsigned char* ks, const bf16x8 (&qr)[4], const f32x16& cin, int r32, int hi) {
#pragma unroll
    for (int d0 = 0; d0 < 4; ++d0) {
        const bf16x8 k0 = *(const LAS bf16x8*)(ks + (2 * d0 + hi) * 1024 + r32 * 16), k1 = *(const LAS bf16x8*)(ks + (2 * d0 + hi) * 1024 + 512 + r32 * 16);
        if (d0 == 0) { p0 = __builtin_amdgcn_mfma_f32_32x32x16_bf16(k0, qr[0], cin, 0, 0, 0); p1 = __builtin_amdgcn_mfma_f32_32x32x16_bf16(k1, qr[0], cin, 0, 0, 0); }
        else { p0 = __builtin_amdgcn_mfma_f32_32x32x16_bf16(k0, qr[d0], p0, 0, 0, 0); p1 = __builtin_amdgcn_mfma_f32_32x32x16_bf16(k1, qr[d0], p1, 0, 0, 0); }
    }
}
__device__ __forceinline__ bf16x8 at_pack8(const f32x16& p, int base) {
    u32x4 w; w.x = cvt_pk_bf16(p[base], p[base + 1]); w.y = cvt_pk_bf16(p[base + 2], p[base + 3]); w.z = cvt_pk_bf16(p[base + 4], p[base + 5]); w.w = cvt_pk_bf16(p[base + 6], p[base + 7]);
    return __builtin_bit_cast(bf16x8, w);
}
__device__ __forceinline__ void at_pvp(f32x16 (&o)[2], bf16x8 pa0, bf16x8 pa1, bf16x8 pa2, bf16x8 pa3, const LAS unsigned char* vs, int r32, int hi) {
#pragma unroll
    for (int d0 = 0; d0 < 2; ++d0) {
        const LAS unsigned char* vb = vs + (32 * d0 + r32) * 8 + hi * 512;
#pragma unroll
        for (int s = 0; s < 4; ++s) {
            const s16x4 lo = *(const LAS s16x4*)(vb + (4 * s) * 512), h4 = *(const LAS s16x4*)(vb + (4 * s + 2) * 512);
            const bf16x8 vf = (bf16x8){lo[0], lo[1], lo[2], lo[3], h4[0], h4[1], h4[2], h4[3]};
            o[d0] = __builtin_amdgcn_mfma_f32_32x32x16_bf16(s == 0 ? pa0 : s == 1 ? pa1 : s == 2 ? pa2 : pa3, vf, o[d0], 0, 0, 0);
        }
    }
}
__device__ __forceinline__ void at_pv(f32x16 (&o)[2], const f32x16& p0, const f32x16& p1, const LAS unsigned char* vs, int r32, int hi) {
    at_pvp(o, at_pack8(p0, 0), at_pack8(p0, 8), at_pack8(p1, 0), at_pack8(p1, 8), vs, r32, hi);
}
__device__ __forceinline__ void at_tile(const LAS unsigned char* slot, const LAS unsigned char* ql, f32x16 (&o)[2], float& l, bool usekill, bool kill, bool masked, int kvlo, int kvhi, int r32, int hi) {
    bf16x8 kf[8];
#pragma unroll
    for (int d0 = 0; d0 < 4; ++d0) { kf[2 * d0] = *(const LAS bf16x8*)(slot + (2 * d0 + hi) * 1024 + r32 * 16); kf[2 * d0 + 1] = *(const LAS bf16x8*)(slot + (2 * d0 + hi) * 1024 + 512 + r32 * 16); }
    bf16x8 q4[4];
#pragma unroll
    for (int d0 = 0; d0 < 4; ++d0) q4[d0] = *(const LAS bf16x8*)(ql + d0 * 1024);
    const f32x16 zero16 = (f32x16){0.f, 0.f, 0.f, 0.f, 0.f, 0.f, 0.f, 0.f, 0.f, 0.f, 0.f, 0.f, 0.f, 0.f, 0.f, 0.f};
    f32x16 p0 = __builtin_amdgcn_mfma_f32_32x32x16_bf16(kf[0], q4[0], zero16, 0, 0, 0), p1 = __builtin_amdgcn_mfma_f32_32x32x16_bf16(kf[1], q4[0], zero16, 0, 0, 0);
#pragma unroll
    for (int d0 = 1; d0 < 4; ++d0) { p0 = __builtin_amdgcn_mfma_f32_32x32x16_bf16(kf[2 * d0], q4[d0], p0, 0, 0, 0); p1 = __builtin_amdgcn_mfma_f32_32x32x16_bf16(kf[2 * d0 + 1], q4[d0], p1, 0, 0, 0); }
    s16x4 vlo[2][4], vhi[2][4];
    const LAS unsigned char* vs = slot + 8192;
#pragma unroll
    for (int d0 = 0; d0 < 2; ++d0) { const LAS unsigned char* vb = vs + (32 * d0 + r32) * 8 + hi * 512;
#pragma unroll
        for (int s = 0; s < 4; ++s) { vlo[d0][s] = *(const LAS s16x4*)(vb + (4 * s) * 512); vhi[d0][s] = *(const LAS s16x4*)(vb + (4 * s + 2) * 512); } }
    if (masked) {
#pragma unroll
        for (int r = 0; r < 16; ++r) { const int kv = crow(r, hi);
            if (kv < kvlo || kv > kvhi) p0[r] = -INFINITY;
            if (kv + 32 < kvlo || kv + 32 > kvhi) p1[r] = -INFINITY; }
    }
    float s = 0.f;
#pragma unroll
    for (int r = 0; r < 16; ++r) { p0[r] = __builtin_amdgcn_exp2f(p0[r]); p1[r] = __builtin_amdgcn_exp2f(p1[r]); s += p0[r] + p1[r]; }
    u32x4 w0, w1, w2, w3;
    w0.x = cvt_pk_bf16(p0[0], p0[1]); w0.y = cvt_pk_bf16(p0[2], p0[3]); w0.z = cvt_pk_bf16(p0[4], p0[5]); w0.w = cvt_pk_bf16(p0[6], p0[7]);
    w1.x = cvt_pk_bf16(p0[8], p0[9]); w1.y = cvt_pk_bf16(p0[10], p0[11]); w1.z = cvt_pk_bf16(p0[12], p0[13]); w1.w = cvt_pk_bf16(p0[14], p0[15]);
    w2.x = cvt_pk_bf16(p1[0], p1[1]); w2.y = cvt_pk_bf16(p1[2], p1[3]); w2.z = cvt_pk_bf16(p1[4], p1[5]); w2.w = cvt_pk_bf16(p1[6], p1[7]);
    w3.x = cvt_pk_bf16(p1[8], p1[9]); w3.y = cvt_pk_bf16(p1[10], p1[11]); w3.z = cvt_pk_bf16(p1[12], p1[13]); w3.w = cvt_pk_bf16(p1[14], p1[15]);
    if (usekill) { const unsigned km = kill ? 0u : 0xffffffffu; s = kill ? 0.f : s;
        w0 = w0 & km; w1 = w1 & km; w2 = w2 & km; w3 = w3 & km; }
    l += s;
#pragma unroll
    for (int d0 = 0; d0 < 2; ++d0)
#pragma unroll
        for (int s4 = 0; s4 < 4; ++s4) { const bf16x8 vf = (bf16x8){vlo[d0][s4][0], vlo[d0][s4][1], vlo[d0][s4][2], vlo[d0][s4][3], vhi[d0][s4][0], vhi[d0][s4][1], vhi[d0][s4][2], vhi[d0][s4][3]};
            o[d0] = __builtin_amdgcn_mfma_f32_32x32x16_bf16(__builtin_bit_cast(bf16x8, s4 == 0 ? w0 : s4 == 1 ? w1 : s4 == 2 ? w2 : w3), vf, o[d0], 0, 0, 0); }
}

__device__ __forceinline__ void attn_unit(Frame& F, const Args& A, int b, int g, int qblk) {
    const int tid = F.tid, lane = F.lane, r32 = lane & 31, hi = lane >> 5, wid = F.wave, hh = wid >> 1, th = wid & 1, h = 4 * g + hh;
    unsigned char* ws = F.ws; const bf16_t* Z = (const bf16_t*)(ws + WS_Z);
    LAS unsigned char* lds = F.lds;
    const int qs = qblk * 64, tq = 32 * th + r32, t = qs + tq; const size_t tok = (size_t)b * SEQ + t;
    const unsigned char* kimg_c = ws + WS_KIMG + KI_KC + (size_t)(b * 4 + g) * 2 * 8192;
    const int j0 = (qblk >= 8) ? qblk - 8 : 0, total = (qblk + 1) + (qblk - j0 + 1);
#define AT_STAGE_IT(itx) do { int _i = (itx); if (_i > total - 1) _i = total - 1; const bool _br = _i > qblk; const int _j = _br ? j0 + (_i - qblk - 1) : _i; \
        const unsigned char* _ki = ws + WS_KIMG + (_br ? KI_KW : KI_KS) + ((size_t)(b * 4 + g) * 32 + _j) * 8192; at_stage(lds, ((itx) + 2) & 3, _ki, _ki + (KI_VS - KI_KS), wid, lane); } while (0)
    at_stage(lds, 0, kimg_c, kimg_c + (KI_VC - KI_KC), wid, lane); at_stage(lds, 1, kimg_c + 8192, kimg_c + 8192 + (KI_VC - KI_KC), wid, lane);
    AT_STAGE_IT(0); AT_STAGE_IT(1);
    bf16x8 qr[4];
#pragma unroll
    for (int d0 = 0; d0 < 4; ++d0) qr[d0] = *(const GAS bf16x8*)(Z + tok * ZW + h * 64 + 16 * d0 + 8 * hi);
    const bf16_t* glp = Z + tok * ZW + ZC_GL + h * 3;
    const float g0 = fast_sigmoid(bf2f(glp[0])), g1 = fast_sigmoid(bf2f(glp[1])), g2 = fast_sigmoid(bf2f(glp[2]));
    asm volatile("s_waitcnt vmcnt(0)" ::: "memory"); __builtin_amdgcn_s_barrier();
    {
        const int cmax = (t >= 31) ? ((t - 31) >> 4) : -1;
        f32x16 oc[2];
#pragma unroll
        for (int r = 0; r < 16; ++r) { oc[0][r] = 0.f; oc[1][r] = 0.f; }
        float l = 0.f, xprev = 0.f;
        LAS float* impw = (LAS float*)(lds + AT_IMP) + (size_t)(hh * 64 + tq) * 32;
#pragma unroll 1
        for (int T = 0; T < 2; ++T) {
            f32x16 p0, p1;
            { const f32x16 zero = (f32x16){0.f, 0.f, 0.f, 0.f, 0.f, 0.f, 0.f, 0.f, 0.f, 0.f, 0.f, 0.f, 0.f, 0.f, 0.f, 0.f}; at_qkt(p0, p1, lds + T * AT_SLOT, qr, zero, r32, hi); }
            float s = 0.f;
#pragma unroll
            for (int r = 0; r < 16; ++r) { const int c = 64 * T + crow(r, hi); if (c > cmax) p0[r] = -INFINITY; if (c + 32 > cmax) p1[r] = -INFINITY;
                p0[r] = __builtin_amdgcn_exp2f(p0[r]); p1[r] = __builtin_amdgcn_exp2f(p1[r]); s += p0[r] + p1[r]; }
            l += s;
#pragma unroll
            for (int u = 0; u < 2; ++u)
#pragma unroll
                for (int rr = 0; rr < 4; ++rr) {
                    const float a0 = u ? p1[4 * rr] : p0[4 * rr], a1 = u ? p1[4 * rr + 1] : p0[4 * rr + 1], a2 = u ? p1[4 * rr + 2] : p0[4 * rr + 2], a3 = u ? p1[4 * rr + 3] : p0[4 * rr + 3];
                    const float xc = __shfl_xor(a3, 32);
                    impw[2 * (8 * T + 4 * u + rr) + hi] = ((a0 + a1) + (a2 + a3)) + (hi ? xc : xprev);
                    xprev = xc;
                }
            at_pv(oc, p0, p1, lds + T * AT_SLOT + 8192, r32, hi);
        }
        l += __shfl_xor(l, 32);
        const float inv = (l > 0.f) ? 1.f / l : 0.f;
#pragma unroll
        for (int i = 0; i < 16; ++i) impw[2 * i + hi] *= inv;
        const float sc = g0 * inv;
        { LAS unsigned* otp = (LAS unsigned*)(lds + AT_OT + wid * 4096) + lane;
#pragma unroll
          for (int r = 0; r < 16; r += 2) { const float f0 = __shfl(sc, crow(r, hi)), f1 = __shfl(sc, crow(r + 1, hi));
              otp[(r >> 1) * 64] = cvt_pk_bf16(oc[0][r] * f0, oc[0][r + 1] * f1); otp[(8 + (r >> 1)) * 64] = cvt_pk_bf16(oc[1][r] * f0, oc[1][r + 1] * f1); } }
    }
    asm volatile("s_waitcnt lgkmcnt(0)" ::: "memory"); __builtin_amdgcn_s_barrier();
    AT_STAGE_IT(2);
    {
        const int tk = tid >> 3, sub = tid & 7;
        const LAS float* ip = (const LAS float*)(lds + AT_IMP) + tk * 32 + 4 * sub;
        const f32x4 i0 = *(const LAS f32x4*)ip, i1 = *(const LAS f32x4*)(ip + 64 * 32), i2 = *(const LAS f32x4*)(ip + 2 * 64 * 32), i3 = *(const LAS f32x4*)(ip + 3 * 64 * 32);
        const f32x4 vs = ((i0 + i1) + i2) + i3;
        float v[4] = {vs.x, vs.y, vs.z, vs.w};
        unsigned mask;
        if (qblk < 8) mask = (2u << qblk) - 1u;
        else {
#pragma unroll
            for (int jj = 0; jj < 4; ++jj) { const int j = 4 * sub + jj; const bool forced = (j == 0) || (j == qblk) || (j == qblk - 1); v[jj] = forced ? 1e30f : ((j <= qblk) ? v[jj] : -1e30f); }
            mask = 0u;
#pragma unroll 1
            for (int k = 0; k < 8; ++k) {
                float bv = v[0]; int bi = 4 * sub;
#pragma unroll
                for (int jj = 1; jj < 4; ++jj) if (v[jj] > bv) { bv = v[jj]; bi = 4 * sub + jj; }
#pragma unroll
                for (int o = 1; o < 8; o <<= 1) { const float ov = __shfl_xor(bv, o); const int oi = __shfl_xor(bi, o); if (ov > bv || (ov == bv && oi < bi)) { bv = ov; bi = oi; } }
                mask |= 1u << bi;
#pragma unroll
                for (int jj = 0; jj < 4; ++jj) if (bi == 4 * sub + jj) v[jj] = -INFINITY;
            }
        }
        if (sub == 0) ((LAS unsigned*)(lds + AT_SEL))[tk] = mask;
    }
    asm volatile("s_waitcnt vmcnt(0) lgkmcnt(0)" ::: "memory"); __builtin_amdgcn_s_barrier();
    const unsigned selm = ((const LAS unsigned*)(lds + AT_SEL))[tq];
    const LAS unsigned char* ql = lds + AT_IMP + wid * 4096 + lane * 16;
#pragma unroll
    for (int d0 = 0; d0 < 4; ++d0) *(LAS bf16x8*)(lds + AT_IMP + wid * 4096 + d0 * 1024 + lane * 16) = qr[d0];
    asm volatile("s_waitcnt lgkmcnt(0)" ::: "memory");
    f32x16 o[2];
    {
#pragma unroll
        for (int r = 0; r < 16; ++r) { o[0][r] = 0.f; o[1][r] = 0.f; }
        float l = 0.f;
#pragma unroll 1
        for (int it = 0; it < total; ++it) {
            const int cur = (it + 2) & 3; const bool br = it > qblk; const int j = br ? j0 + (it - qblk - 1) : it;
            AT_STAGE_IT(it + 3);
            bool masked, kill; int kvlo, kvhi;
            if (!br) { masked = (j == qblk); kvlo = 0; kvhi = tq; kill = !((selm >> j) & 1u); }
            else { const bool first = (qblk >= 8) && (j == j0), lastt = (j == qblk); masked = first || lastt; kvlo = first ? tq + 1 : 0; kvhi = lastt ? tq : 63; kill = false; }
            at_tile(lds + cur * AT_SLOT, ql, o, l, !br, kill, masked, kvlo, kvhi, r32, hi);
            asm volatile("s_waitcnt vmcnt(4) lgkmcnt(0)" ::: "memory"); __builtin_amdgcn_s_barrier();
            if (it == qblk || it == total - 1) {
                l += __shfl_xor(l, 32);
                const float sc = (br ? g2 : g1) / l;
                LAS unsigned* otp = (LAS unsigned*)(lds + AT_OT + wid * 4096) + lane;
                if (!br) {
#pragma unroll
                    for (int r = 0; r < 16; r += 2) { const float f0 = __shfl(sc, crow(r, hi)), f1 = __shfl(sc, crow(r + 1, hi));
                        const unsigned a = otp[(r >> 1) * 64], c = otp[(8 + (r >> 1)) * 64];
                        otp[(r >> 1) * 64] = cvt_pk_bf16(bflo(a) + o[0][r] * f0, bfhi(a) + o[0][r + 1] * f1); otp[(8 + (r >> 1)) * 64] = cvt_pk_bf16(bflo(c) + o[1][r] * f0, bfhi(c) + o[1][r + 1] * f1);
                        o[0][r] = 0.f; o[0][r + 1] = 0.f; o[1][r] = 0.f; o[1][r + 1] = 0.f; }
                } else {
#pragma unroll
                    for (int r = 0; r < 16; r += 2) { const float f0 = __shfl(sc, crow(r, hi)), f1 = __shfl(sc, crow(r + 1, hi));
                        const unsigned a = otp[(r >> 1) * 64], c = otp[(8 + (r >> 1)) * 64];
                        o[0][r] = bflo(a) + o[0][r] * f0; o[0][r + 1] = bfhi(a) + o[0][r + 1] * f1; o[1][r] = bflo(c) + o[1][r] * f0; o[1][r + 1] = bfhi(c) + o[1][r + 1] * f1; }
                }
                l = 0.f;
            }
        }
    }
    asm volatile("s_waitcnt vmcnt(0)" ::: "memory"); __builtin_amdgcn_s_barrier();
#undef AT_STAGE_IT
    {
        LAS bf16_t* stg = (LAS bf16_t*)(lds + AT_OST + wid * 4096);
#pragma unroll
        for (int r = 0; r < 16; ++r) { const int orow = crow(r, hi); stg[orow * 64 + r32] = (bf16_t)f2bf(o[0][r]); stg[orow * 64 + 32 + r32] = (bf16_t)f2bf(o[1][r]); }
        asm volatile("s_waitcnt lgkmcnt(0)" ::: "memory");
        unsigned char* A2 = ws + WS_A2;
        const int ch = lane & 7;
        const f32x4 ga = *(const GAS f32x4*)(A.in[19] + h * 64 + ch * 8), gb = *(const GAS f32x4*)(A.in[19] + h * 64 + ch * 8 + 4);
        LAS float* ssl = (LAS float*)(lds + AT_SS);
#pragma unroll
        for (int i = 0; i < 4; ++i) { const int row = i * 8 + (lane >> 3);
            const u32x4 v = *(const LAS u32x4*)(stg + row * 64 + ch * 8);
            const float f[8] = {bflo(v.x), bfhi(v.x), bflo(v.y), bfhi(v.y), bflo(v.z), bfhi(v.z), bflo(v.w), bfhi(v.w)};
            float ss = 0.f;
#pragma unroll
            for (int j = 0; j < 8; ++j) ss += f[j] * f[j];
            ss += __shfl_xor(ss, 1); ss += __shfl_xor(ss, 2); ss += __shfl_xor(ss, 4);
            if (ch == 0) ssl[hh * 64 + 32 * th + row] = ss;
            u32x2 o; o.x = pk4_fp8c(f[0] * ga.x * A2_SCALE, f[1] * ga.y * A2_SCALE, f[2] * ga.z * A2_SCALE, f[3] * ga.w * A2_SCALE); o.y = pk4_fp8c(f[4] * gb.x * A2_SCALE, f[5] * gb.y * A2_SCALE, f[6] * gb.z * A2_SCALE, f[7] * gb.w * A2_SCALE);
            *(GAS u32x2*)(A2 + ((size_t)b * SEQ + qs + 32 * th + row) * DM + h * 64 + ch * 8) = o; }
        asm volatile("s_waitcnt lgkmcnt(0)" ::: "memory"); __builtin_amdgcn_s_barrier();
        if (tid < 64) ((float*)(ws + WS_SSN))[((size_t)b * SEQ + qs + tid) * 4 + g] = ((ssl[tid] + ssl[64 + tid]) + ssl[128 + tid]) + ssl[192 + tid];
        asm volatile("s_waitcnt lgkmcnt(0)" ::: "memory"); __builtin_amdgcn_s_barrier();
    }
}
constexpr bool W2_LATE = false;
constexpr int NCX = 10, JOIN_PH = 4, CONV_SPLIT = 3072;
__global__ void __launch_bounds__(NWAVES * 64, 2) mega(Args args) {
    extern __shared__ __attribute__((aligned(16))) unsigned char lds_raw[];
    Frame F;
    F.lds = (LAS unsigned char*)lds_raw;
    F.tid = threadIdx.x; F.lane = F.tid & 63; F.wave = __builtin_amdgcn_readfirstlane(F.tid >> 6);
    F.ws = args.ws; F.ctl = (gu32*)(args.ws + WS_CTL);
    unsigned char* ws = args.ws;
    for (int u = F.tid; u < (LDS_BYTES - LDSCTL_OFF) / 4; u += NWAVES * 64) ((LAS unsigned*)(F.lds + LDSCTL_OFF))[u] = 0u;
    __syncthreads();
    volatile LAS unsigned* MISC = (volatile LAS unsigned*)(F.lds + MISC_OFF);
    const int lo = args.ph_lo, hi = args.ph_hi;
    const int G0 = gridDim.x, bx0 = blockIdx.x;
    const int vcu0 = (G0 % 8 == 0) ? (bx0 % 8) * (G0 / 8) + bx0 / 8 : bx0;
    const bool part = (G0 == 256) && lo < JOIN_PH && hi > JOIN_PH;
    const int xl = vcu0 & 31, xx = vcu0 >> 5;
    const bool is_conv = part && xl >= 32 - NCX;
    const int GB = part ? G0 - 8 * NCX : G0, vcuB = part ? xx * (32 - NCX) + xl : vcu0, bxB = part ? xl * 8 + xx : bx0;
    const int cv = (xl - (32 - NCX)) * 8 + xx;
    const bool w2_late = W2_LATE && (G0 == 256) && lo == 0 && hi > 5;
    const bool conv5 = w2_late && xl >= 32 - NCX;
    XcdBarrier bar = xcd_barrier_post((unsigned*)(F.ctl + CW_BAR) + args.li * XCD_BAR_WORDS, MISC + 8, (unsigned)G0, true);
    XcdBarrier barB = xcd_barrier_post((unsigned*)(F.ctl + CW_BAR) + (8 + args.li) * XCD_BAR_WORDS, MISC + 10, (unsigned)GB, part && !is_conv);
#define IN(k) (lo <= (k) && (k) < hi)
#define BOTH(k) (IN(k) && IN((k) + 1))
#define GRID_BAR(k) do { if (part && (k) + 1 < JOIN_PH) xcd_barrier(barB); else xcd_barrier(bar); } while (0)
#define SET_ID(k) do { const bool sub_ = part && (k) < JOIN_PH; F.G = sub_ ? GB : G0; F.vcu = sub_ ? vcuB : vcu0; F.bx = sub_ ? bxB : bx0; gw = F.vcu * NWAVES + F.wave; NGW = F.G * NWAVES; gw2 = F.wave * F.G + F.vcu; } while (0)
    int gw, NGW, gw2;
    SET_ID(lo);
    const float* mod = (const float*)(ws + WS_MOD);

    if (IN(0)) {
        p0_experts(F, args, is_conv ? cv : F.vcu, is_conv ? 8 * NCX : F.G, is_conv ? CONV_SPLIT : 0, (part && !is_conv) ? CONV_SPLIT : (w2_late ? CONV_NIT1 : CONV_NITX));
        if (!is_conv) p0_prologue(F, args);
        if (!is_conv && BOTH(0)) GRID_BAR(0);
    }
    if (is_conv) { xcd_barrier(bar); }
    const bool skip_pre = is_conv;
    if (IN(1) && !(skip_pre && 1 < JOIN_PH)) {
        const float* modp = (const float*)(ws + WS_MODPART); float* modw = (float*)(ws + WS_MOD);
        if (F.bx == 0 && F.wave < 2) pebias_reduce((const float*)(ws + WS_PEPART) + F.wave * 2048, (float*)(ws + WS_SMALL + (F.wave ? SM_BIASV : SM_BIASK)), F.lane);
        for (int idx = F.bx * (NWAVES * 64) + F.tid; idx < NB * 6 * DM; idx += F.G * NWAVES * 64) modw[idx] = mod_reduce1(modp, args.in[3], idx);
        LAS float* lmod = (LAS float*)F.lds;
        const int rpb = ((NTOK + F.G - 1) / F.G + 7) & ~7, r0 = F.bx * rpb, r1 = (r0 + rpb < NTOK) ? r0 + rpb : NTOK;
        int curb = -1;
        f32x4 g1v[8];
#pragma unroll
        for (int j = 0; j < 8; ++j) g1v[j] = *((const GAS f32x4*)args.in[4] + F.lane + 64 * j);
        for (int rb = r0; rb < r1; rb += 8) {
            const int b = rb / SEQ;
            if (b != curb) { __syncthreads(); for (int i = F.tid; i < 2 * DM; i += NWAVES * 64) lmod[i] = mod_reduce1(modp, args.in[3], b * 6 * DM + i); curb = b; __syncthreads(); }
            const int row = rb + F.wave;
            if (row < r1) {
                const GAS f32x4* xr = (const GAS f32x4*)(args.in[0] + (size_t)row * DM) + F.lane;
                f32x4 v[8]; float s = 0.f;
#pragma unroll
                for (int j = 0; j < 8; ++j) { v[j] = xr[64 * j]; s += (v[j].x * v[j].x + v[j].y * v[j].y) + (v[j].z * v[j].z + v[j].w * v[j].w); }
                const float rstd = rsqrtf(wsum(s) * (1.f / DM) + EPS);
                GAS unsigned long long* o8 = (GAS unsigned long long*)((bf16_t*)(ws + WS_H) + (size_t)row * DM) + F.lane;
#pragma unroll
                for (int j = 0; j < 8; ++j) {
                    const f32x4 gg = g1v[j], sh = *((const LAS f32x4*)lmod + F.lane + 64 * j), sc = *((const LAS f32x4*)(lmod + DM) + F.lane + 64 * j);
                    const f32x4 hv = v[j] * rstd * gg * (sc + 1.f) + sh;
                    o8[64 * j] = (unsigned long long)pk2(hv.x, hv.y) | ((unsigned long long)pk2(hv.z, hv.w) << 32);
                }
            }
        }
        __syncthreads();
        if (BOTH(1)) GRID_BAR(1);
    }
    if (IN(2)) SET_ID(2);
    if (IN(2) && !(skip_pre && 2 < JOIN_PH)) {
        ProbZ P; P.ord.init(NTOK, ZW, F.G, F.bx); P.A = (const bf16_t*)(ws + WS_H); P.Bt = (const bf16_t*)(ws + WS_WIN); P.Z = (bf16_t*)(ws + WS_Z);
        g8::gemm_phase<ProbZ>(F.lds, P);
        if (BOTH(2)) GRID_BAR(2);
    }
    if (IN(3)) SET_ID(3);
    if (IN(3) && !(skip_pre && 3 < JOIN_PH)) {
        for (int it = F.bx; it < NB * 32; it += F.G) prep_item(F, args, it);
        for (int it = gw2; it < NB * 4 * 8 * 2; it += NGW) compress_item(F, args, it);
        for (int it = gw; it < NB * 32 * 16; it += NGW) lru_item<false>(F, args, it);
        if (BOTH(3)) GRID_BAR(3);
    }
    if (IN(4)) SET_ID(4);
    if (IN(4)) {
        {
            const bool bal = (F.G == 256); const int nu = bal ? 4 : (NB * 4 * 32 + F.G - 1 - F.bx) / F.G;
#pragma unroll 1
            for (int i = 0; i < nu; ++i) {
                int bg, qb;
                if (bal) { const int s = F.vcu & 7; bg = F.vcu >> 3; qb = (i == 0) ? 31 - s : (i == 1) ? 16 + s : (i == 2) ? 15 - s : s; }
                else { const int u = F.bx + i * F.G; bg = u & 31; qb = 31 - (u >> 5); }
                attn_unit(F, args, bg >> 2, bg & 3, qb);
            }
        }
        for (int it = gw; it < NB * 32 * 16; it += NGW) lru_item<true>(F, args, it);
        if (BOTH(4)) GRID_BAR(4);
    }
    if (IN(5) && conv5) { p0_experts(F, args, cv, 8 * NCX, CONV_NIT1, CONV_NIT); if (BOTH(5)) GRID_BAR(5); }
    if (IN(5) && !conv5) {
        if (w2_late) { F.G = GB; F.vcu = vcuB; F.bx = bxB; }
        ProbMix8 P; P.ord.init(NTOK, DM, F.G, F.bx); P.A8 = ws + WS_A2; P.W8 = ws + WS_WOUT; P.x = args.in[0]; P.mod = mod; P.x1b = (bf16_t*)(ws + WS_X1B);
        P.rs = (const LAS float*)(F.lds + RSTAB_OFF);
        p5_build_rstab(F, P.ord, (const float*)(ws + WS_SSN), (const float*)(ws + WS_SSL));
        g8::gemm8_phase<ProbMix8>(F.lds, P);
        if (BOTH(5)) GRID_BAR(5);
    }
    if (IN(6)) SET_ID(6);
    if (IN(6)) { p6_route(F, args, mod); if (BOTH(6)) GRID_BAR(6); }
    if (IN(7)) {
        build_tile_table(F);
        ProbM1F P; P.ord.tab = (const LAS int*)(F.lds + TILETAB_OFF); P.ord.G = F.G; P.ord.c = F.bx; P.ord.NPN = 16;
        P.H8 = ws + WS_H8; P.W1T8 = ws + WS_W1; P.b1 = args.in[26]; P.rowtok = (const int*)(ws + WS_ROUTE + RT_ROWTOK); P.ACT8 = ws + WS_ACT;
        g8::gemm8_phase<ProbM1F>(F.lds, P);
        if (BOTH(7)) GRID_BAR(7);
    }
    if (IN(8)) {
        build_tile_table(F);
        ProbM2F P; P.ord.tab = (const LAS int*)(F.lds + TILETAB_OFF); P.ord.G = F.G; P.ord.c = F.bx; P.ord.NPN = 8;
        P.ACT8 = ws + WS_ACT; P.W2T8 = ws + WS_W2; P.b2 = args.in[28]; P.rowg = (const float*)(ws + WS_ROUTE + RT_ROWG); P.Y8 = ws + WS_Y;
        g8::gemm8_phase<ProbM2F>(F.lds, P);
        if (BOTH(8)) GRID_BAR(8);
    }
    if (IN(9)) { build_tile_table(F); p9_combine(F, args, mod); }
#undef IN
#undef BOTH
#undef GRID_BAR
#undef SET_ID
}

extern "C" void kernel_launch(void* const* d_in, const int* in_sizes, int n_in, void* d_out, int out_size, void* d_ws, size_t ws_size, hipStream_t stream) {
    float* out = (float*)d_out;
    static int grid = 0;
    if (grid == 0) {
        int dev = 0, cus = 0;
        (void)hipGetDevice(&dev); (void)hipDeviceGetAttribute(&cus, hipDeviceAttributeMultiprocessorCount, dev);
        (void)hipFuncSetAttribute((const void*)mega, hipFuncAttributeMaxDynamicSharedMemorySize, LDS_BYTES);
        int per_cu = 0;
        (void)hipOccupancyMaxActiveBlocksPerMultiprocessor(&per_cu, (const void*)mega, NWAVES * 64, LDS_BYTES);
        (void)hipGetLastError();
        grid = (cus > 0 ? cus : 256) * (per_cu >= 1 ? 1 : 1);
    }
    char* ws = (char*)d_ws;
    (void)ws_size; (void)in_sizes; (void)n_in; (void)out_size;

    (void)hipMemsetAsync(ws + WS_CTL, 0, CTL_ZERO_BYTES, stream);
    Args a{};
    for (int i = 0; i < 29; ++i) a.in[i] = (const float*)d_in[i];
    a.out = out; a.ws = (unsigned char*)d_ws; a.ph_lo = 0; a.ph_hi = 10; a.li = 0; a.pad = 0;
    hipLaunchKernelGGL(mega, dim3(grid), dim3(NWAVES * 64), LDS_BYTES, stream, a);
}
```

```cpp
#include <hip/hip_runtime.h>
#include <stdint.h>
#include <math.h>

constexpr int DM = 2048, NB = 8, SEQ = 2048, NTOK = NB * SEQ;
constexpr int INW = 4656;
constexpr int NE = 32, TOPK = 4, NSLOT = NTOK * TOPK;
constexpr float EPS = 1e-6f;
#define LAS __attribute__((address_space(3)))
#define GAS __attribute__((address_space(1)))
typedef unsigned short bf16_t;
typedef short bf16x8 __attribute__((ext_vector_type(8)));
typedef short s16x4 __attribute__((ext_vector_type(4)));
typedef float f32x4 __attribute__((ext_vector_type(4)));
typedef float f32x16 __attribute__((ext_vector_type(16)));
typedef float f32x2 __attribute__((ext_vector_type(2)));
typedef unsigned u32x4 __attribute__((ext_vector_type(4)));
typedef unsigned u32x2 __attribute__((ext_vector_type(2)));
typedef GAS unsigned gu32;

constexpr int ZW = 4864;
constexpr int ZC_Q = 0, ZC_KC = 1024, ZC_VC = 1280, ZC_KS = 1536, ZC_VS = 1792, ZC_KW = 2048, ZC_VW = 2304, ZC_XR = 2560, ZC_XG = 3584, ZC_GL = 4608;
constexpr int PMAXT = 288, PMAXROWS = PMAXT * 256;

constexpr size_t MiB = 1u << 20;
constexpr size_t WS_CTL = 0, CTL_ZERO_BYTES = 1 * MiB;
constexpr int CW_TMO = 0, CW_CNT = 1024, CW_BAR = 4096;
constexpr size_t CTL_MOD_B = 256 * 1024;
constexpr size_t CTL_ROWSS_B = 640 * 1024;
constexpr size_t WS_WIN = 2 * MiB, WS_WOUT = 22 * MiB, WS_SMALL = 30 * MiB, WS_W1 = 32 * MiB, WS_W2 = 544 * MiB;
constexpr size_t SM_WR = 0, SM_WCK = 128 * 1024, SM_WCV = 384 * 1024, SM_WRG = 640 * 1024, SM_WIG = 768 * 1024, SM_BIASK = 896 * 1024, SM_BIASV = 897 * 1024;
constexpr float A2_SCALE = 16.f;
constexpr size_t WS_X1B = 864 * MiB;
constexpr size_t WS_MODPART = 1700 * MiB, WS_MOD = 1707 * MiB, WS_SSN = 1708 * MiB, WS_SSL = 1709 * MiB, WS_PEPART = 1710 * MiB;
constexpr size_t WS_H8 = 288 * MiB;
constexpr size_t WS_H = 800 * MiB, WS_Z = 864 * MiB, WS_KIMG = 1016 * MiB, WS_LRUS = 1050 * MiB, WS_A2 = 1052 * MiB, WS_ROUTE = 1116 * MiB, WS_ACT = 1122 * MiB, WS_Y = 1410 * MiB, WS_FAST_END = 1710 * MiB;
constexpr size_t KI_KS = 0, KI_KW = 8 * MiB, KI_VS = 16 * MiB, KI_VW = 24 * MiB, KI_KC = 32 * MiB, KI_VC = 32 * MiB + 512 * 1024;
constexpr size_t RT_ROWTOK = 0, RT_ROWG = 2 * MiB, RT_TOKSLOT = 4 * MiB;

constexpr int RING_BYTES = 131072, LDSCTL_OFF = RING_BYTES, MISC_OFF = LDSCTL_OFF + 320, TILETAB_OFF = LDSCTL_OFF + 1024, LDS_BYTES = 163840;
constexpr int NWAVES = 8;

#define RLX_AGENT __ATOMIC_RELAXED, __HIP_MEMORY_SCOPE_AGENT
#define LDS_WAIT() asm volatile("s_waitcnt lgkmcnt(0)" ::: "memory")
#define VM_WAIT() asm volatile("s_waitcnt vmcnt(0)" ::: "memory")
__device__ __forceinline__ unsigned f2bf(float f) { unsigned u = __builtin_bit_cast(unsigned, f); return (u + 0x7fffu + ((u >> 16) & 1u)) >> 16; }
__device__ __forceinline__ unsigned pk2(float lo, float hi) { return f2bf(lo) | (f2bf(hi) << 16); }
__device__ __forceinline__ float bf2f(unsigned short b) { return __builtin_bit_cast(float, (unsigned)b << 16); }
__device__ __forceinline__ float bflo(unsigned w) { return __builtin_bit_cast(float, w << 16); }
__device__ __forceinline__ float bfhi(unsigned w) { return __builtin_bit_cast(float, w & 0xffff0000u); }
__device__ __forceinline__ unsigned cvt_pk_bf16(float lo, float hi) { unsigned r; asm volatile("v_cvt_pk_bf16_f32 %0, %1, %2" : "=v"(r) : "v"(lo), "v"(hi)); return r; }

__device__ __forceinline__ float clamp448(float v) { return fminf(fmaxf(v, -448.f), 448.f); }
__device__ __forceinline__ unsigned pk4_fp8(float a, float b, float c, float d);
__device__ __forceinline__ unsigned pk4_fp8c(float a, float b, float c, float d) { return pk4_fp8(clamp448(a), clamp448(b), clamp448(c), clamp448(d)); }
__device__ __forceinline__ unsigned pk4_fp8(float a, float b, float c, float d) {
    unsigned w = 0u; w = __builtin_amdgcn_cvt_pk_fp8_f32(a, b, w, false); w = __builtin_amdgcn_cvt_pk_fp8_f32(c, d, w, true); return w; }

#define XB_TMO      128
#define XB_XCNT(j)  (256  + 64 * (j))
#define XB_XSUB(j)  (1280 + 64 * (j))
#define XB_XGEN(j)  (2304 + 64 * (j))
#define XB_TOP      3328
#define XB_TOPGEN   3392
#define XCD_BAR_WORDS 3456
#define XB_SPIN_CAP (1u << 18)
__device__ __forceinline__ unsigned xb_ld(unsigned* p)              { return __hip_atomic_load(p, __ATOMIC_RELAXED, __HIP_MEMORY_SCOPE_AGENT); }
__device__ __forceinline__ unsigned xb_add(unsigned* p, unsigned v) { return __hip_atomic_fetch_add(p, v, __ATOMIC_RELAXED, __HIP_MEMORY_SCOPE_AGENT); }
__device__ __forceinline__ unsigned xb_xcc_id() { return (unsigned)__builtin_amdgcn_s_getreg((3 << 11) | 20) & 0xFu; }
#define XB_SPIN(cond, bar) do { unsigned _sp = 0; while (cond) { __builtin_amdgcn_s_sleep(1); \
    if ((++_sp & 255u) == 0u) { if (xb_ld(&(bar)[XB_TMO])) break; if (_sp > XB_SPIN_CAP) { atomicAdd(&(bar)[XB_TMO], 1u); break; } } } } while (0)
struct XcdBarrier { unsigned* bar; unsigned x; volatile LAS unsigned* st; unsigned total; };
__device__ __forceinline__ XcdBarrier xcd_barrier_post(unsigned* bar, volatile LAS unsigned* st, unsigned total, bool member) {
    XcdBarrier b; b.bar = bar; b.x = xb_xcc_id(); b.st = st; b.total = total;
    if (member && threadIdx.x == 0) (void)xb_add(&bar[XB_XCNT(b.x)], 1u);
    return b;
}
__device__ __forceinline__ void xcd_barrier_complete(unsigned* bar, unsigned x, unsigned G, unsigned& nloc, unsigned& nx) {
    unsigned sum, cnt, mine, sp = 0u;
    for (;;) {
        sum = 0u; cnt = 0u; mine = 0u;
#pragma unroll
        for (unsigned j = 0; j < 16; ++j) { const unsigned c = xb_ld(&bar[XB_XCNT(j)]); sum += c; cnt += (c > 0u) ? 1u : 0u; mine = (j == x) ? c : mine; }
        if (sum == G) break;
        __builtin_amdgcn_s_sleep(1);
        if ((++sp & 255u) == 0u) { if (xb_ld(&bar[XB_TMO])) break; if (sp > XB_SPIN_CAP) { atomicAdd(&bar[XB_TMO], 1u); break; } }
    }
    nloc = mine > 0u ? mine : 1u; nx = cnt > 0u ? cnt : 1u;
}
__device__ __forceinline__ void xcd_barrier(const XcdBarrier& b) {
    asm volatile("s_waitcnt vmcnt(0)" ::: "memory");
    __syncthreads();
    if (threadIdx.x == 0) {
        unsigned* bar = b.bar;
        __builtin_amdgcn_s_waitcnt(0);
        unsigned nloc = b.st[0], nx = b.st[1];
        if (nloc == 0u) { xcd_barrier_complete(bar, b.x, b.total, nloc, nx); b.st[0] = nloc; b.st[1] = nx; }
        const unsigned old = xb_add(&bar[XB_XSUB(b.x)], 1u);
        const unsigned gen = old / nloc;
        if (old + 1u == (gen + 1u) * nloc) {
            __builtin_amdgcn_fence(__ATOMIC_RELEASE, "agent");
            asm volatile("s_waitcnt vmcnt(0)" ::: "memory");
            const unsigned og = xb_add(&bar[XB_TOP], 1u);
            const unsigned tg = og / nx;
            if (og + 1u == (tg + 1u) * nx) xb_add(&bar[XB_TOPGEN], 1u);
            else XB_SPIN(xb_ld(&bar[XB_TOPGEN]) == tg, bar);
            __builtin_amdgcn_fence(__ATOMIC_ACQUIRE, "agent");
            xb_add(&bar[XB_XGEN(b.x)], 1u);
            asm volatile("s_waitcnt vmcnt(0)" ::: "memory");
        } else {
            XB_SPIN(xb_ld(&bar[XB_XGEN(b.x)]) == gen, bar);
            __builtin_amdgcn_fence(__ATOMIC_ACQUIRE, "agent");
            asm volatile("s_waitcnt vmcnt(0)" ::: "memory");
        }
    }
    __syncthreads();
}

namespace g8 {
constexpr int BM = 256, BK = 64, HALF = 128, HTB = HALF * BK * 2, STAGE_BYTES = 8 * HTB;
__host__ __device__ __forceinline__ int lds_byte(int r, int c) { const int st = (r >> 4) * 2 + (c >> 5), rr = r & 15, cc = c & 31, ob = rr * 64 + cc * 2; return st * 1024 + (ob ^ (((ob >> 9) & 1) << 5)); }
__host__ __device__ __forceinline__ void stage_rc(int b, int& R, int& C) { const int st = b / 1024, sb = b % 1024, swz = sb ^ (((sb >> 9) & 1) << 5); R = (st >> 1) * 16 + swz / 64; C = (st & 1) * 32 + (swz % 64) / 2; }
__host__ __device__ __forceinline__ int perm32(int rho) { const int n = rho >> 4, i = rho & 15; return 8 * (i >> 2) + 4 * n + (i & 3); }
struct Unit { int pm, pn, e, row0, p0; };
typedef f32x4 Acc[2][2][4][2];

template <class P>
__device__ __forceinline__ void gemm_phase(LAS unsigned char* lds, const P& S) {
    const int tid = threadIdx.x, wid = __builtin_amdgcn_readfirstlane(tid >> 6), lane = tid & 63, wr = wid >> 2, wc = wid & 3, fr = lane & 15, fq = lane >> 4;
    constexpr int K = P::K, nt = K / BK;
    int R0, C0, R1, C1; stage_rc(tid * 16, R0, C0); stage_rc(tid * 16 + 8192, R1, C1);
    const int Rb0 = P::PERM ? ((R0 & ~31) + perm32(R0 & 31)) : R0, Rb1 = P::PERM ? ((R1 & ~31) + perm32(R1 & 31)) : R1;
    const unsigned voffB0 = (unsigned)(Rb0 * K + C0) * 2u, voffB1 = (unsigned)(Rb1 * K + C1) * 2u;
    constexpr size_t kstep = (size_t)(BK * 2);
    constexpr unsigned hstep = (unsigned)HALF * K * 2u;
    const unsigned ldsw = (unsigned)wid * 1024u;
    const int aoff = lds_byte(wr * 64 + fr, fq * 8), boff = lds_byte(wc * 32 + fr, fq * 8);
#define G8_SA(b, h) (((b) * 2 + (h)) * HTB)
#define G8_SB(b, h) ((4 + (b) * 2 + (h)) * HTB)
#define G8_STAGE(bufoff, gbase, o0, o1) do { \
        __builtin_amdgcn_global_load_lds((const unsigned*)((const char*)(gbase) + (o0)), (LAS unsigned*)(lds + (bufoff) + ldsw), 16, 0, 0); \
        __builtin_amdgcn_global_load_lds((const unsigned*)((const char*)(gbase) + (o1)), (LAS unsigned*)(lds + (bufoff) + ldsw + 8192), 16, 0, 0); } while (0)
#define G8_STAGEB(bufoff, gbase, h) G8_STAGE(bufoff, gbase, voffB0 + (h) * hstep, voffB1 + (h) * hstep)
#define G8_LDA(dst, b, h) do { _Pragma("unroll") for (int m = 0; m < 4; ++m) _Pragma("unroll") for (int k = 0; k < 2; ++k) dst[m][k] = *(const LAS bf16x8*)(lds + G8_SA(b, h) + aoff + m * 2048 + k * 1024); } while (0)
#define G8_LDB(dst, b, h) do { _Pragma("unroll") for (int n = 0; n < 2; ++n) _Pragma("unroll") for (int k = 0; k < 2; ++k) dst[n][k] = *(const LAS bf16x8*)(lds + G8_SB(b, h) + boff + n * 2048 + k * 1024); } while (0)
#define G8_MMA(ai, bj, At, Bt) do { __builtin_amdgcn_s_setprio(1); _Pragma("unroll") for (int m = 0; m < 4; ++m) _Pragma("unroll") for (int n = 0; n < 2; ++n) _Pragma("unroll") for (int k = 0; k < 2; ++k) \
        acc[ai][bj][m][n] = __builtin_amdgcn_mfma_f32_16x16x32_bf16(Bt[n][k], At[m][k], acc[ai][bj][m][n], 0, 0, 0); __builtin_amdgcn_s_setprio(0); } while (0)
#define G8_WAIT_V(n) asm volatile("s_waitcnt vmcnt(" #n ")" ::: "memory")
#define G8_WAIT_L(n) asm volatile("s_waitcnt lgkmcnt(" #n ")" ::: "memory")
#define G8_BAR __builtin_amdgcn_s_barrier()
#define G8_SCHED __builtin_amdgcn_sched_barrier(0)
    Unit cur, nxt; int ui = 0;
    if (!S.next(0, cur)) return;
    Acc acc;
#pragma unroll
    for (int a = 0; a < 2; ++a)
#pragma unroll
        for (int b = 0; b < 2; ++b)
#pragma unroll
            for (int m = 0; m < 4; ++m)
#pragma unroll
                for (int n = 0; n < 2; ++n) acc[a][b][m][n] = (f32x4){0.f, 0.f, 0.f, 0.f};
    bf16x8 At[4][2], B0[2][2], B1[2][2];
    unsigned c00, c01, c10, c11, n00, n01, n10, n11;
    S.a_voff(cur, R0, C0, R1, C1, c00, c01, c10, c11);
    n00 = c00; n01 = c01; n10 = c10; n11 = c11;
    const char* cA = S.a_base(cur); const char* cB = S.b_base(cur);
    G8_STAGEB(G8_SB(0, 0), cB, 0); G8_STAGEB(G8_SB(0, 1), cB, 1); G8_STAGE(G8_SA(0, 0), cA, c00, c01); G8_STAGE(G8_SA(0, 1), cA, c10, c11);
    if (wr == 1) G8_BAR;
    G8_WAIT_V(2); G8_BAR;
    G8_STAGEB(G8_SB(1, 0), cB + kstep, 0); G8_STAGE(G8_SA(1, 0), cA + kstep, c00, c01); G8_STAGEB(G8_SB(1, 1), cB + kstep, 1);
    G8_WAIT_V(6); G8_BAR;
    for (;;) {
        const bool has_next = S.next(ui + 1, nxt);
        const char* nA = has_next ? S.a_base(nxt) : cA; const char* nB = has_next ? S.b_base(nxt) : cB;
        if (P::GATHER) { if (has_next) S.a_voff(nxt, R0, C0, R1, C1, n00, n01, n10, n11); else { n00 = c00; n01 = c01; n10 = c10; n11 = c11; } }
        for (int t = 0; t < nt; t += 2) {
            const bool last = (t == nt - 2);
            if (P::MIDK) { if (t == nt / 2) S.midk(acc, cur, wr, fr); }
            const char* a1 = cA + (size_t)(t + 1) * kstep;
            const char* a2 = last ? nA : cA + (size_t)(t + 2) * kstep; const char* b2 = last ? nB : cB + (size_t)(t + 2) * kstep;
            const char* a3 = a2 + kstep; const char* b3 = b2 + kstep;
            const unsigned x00 = (P::GATHER && last) ? n00 : c00, x01 = (P::GATHER && last) ? n01 : c01, x10 = (P::GATHER && last) ? n10 : c10, x11 = (P::GATHER && last) ? n11 : c11;
            G8_LDB(B0, 0, 0); G8_LDB(B1, 0, 1); G8_SCHED; G8_LDA(At, 0, 0); G8_STAGE(G8_SA(1, 1), a1, c10, c11);
            G8_WAIT_V(8); G8_WAIT_L(0); G8_BAR; G8_MMA(0, 0, At, B0); G8_MMA(0, 1, At, B1); G8_BAR; G8_SCHED;
            G8_LDA(At, 0, 1); G8_STAGEB(G8_SB(0, 0), b2, 0); G8_STAGEB(G8_SB(0, 1), b2, 1); G8_STAGE(G8_SA(0, 0), a2, x00, x01);
            G8_WAIT_V(8); G8_WAIT_L(0); G8_BAR; G8_MMA(1, 0, At, B0); G8_MMA(1, 1, At, B1); G8_BAR; G8_SCHED;
            G8_LDB(B0, 1, 0); G8_LDB(B1, 1, 1); G8_SCHED; G8_LDA(At, 1, 0); G8_STAGE(G8_SA(0, 1), a2, x10, x11);
            G8_WAIT_V(8); G8_WAIT_L(0); G8_BAR; G8_MMA(0, 0, At, B0); G8_MMA(0, 1, At, B1); G8_BAR; G8_SCHED;
            G8_LDA(At, 1, 1); G8_STAGEB(G8_SB(1, 0), b3, 0); G8_STAGEB(G8_SB(1, 1), b3, 1); G8_STAGE(G8_SA(1, 0), a3, x00, x01);
            G8_WAIT_V(8); G8_WAIT_L(0); G8_BAR; G8_MMA(1, 0, At, B0); G8_MMA(1, 1, At, B1); G8_BAR; G8_SCHED;
        }
        if (wr == 0) G8_BAR;
        S.epi(acc, cur, wr, wc, fr, fq);
        if (!has_next) break;
#pragma unroll
        for (int a = 0; a < 2; ++a)
#pragma unroll
            for (int b = 0; b < 2; ++b)
#pragma unroll
                for (int m = 0; m < 4; ++m)
#pragma unroll
                    for (int n = 0; n < 2; ++n) acc[a][b][m][n] = (f32x4){0.f, 0.f, 0.f, 0.f};
        cur = nxt; cA = nA; cB = nB; ++ui;
        if (P::GATHER) { c00 = n00; c01 = n01; c10 = n10; c11 = n11; }
        if (wr == 1) G8_BAR;
    }
    G8_WAIT_V(0);
    G8_BAR;
#undef G8_SA
#undef G8_SB
#undef G8_STAGE
#undef G8_STAGEB
#undef G8_LDA
#undef G8_LDB
#undef G8_MMA
#undef G8_WAIT_V
#undef G8_WAIT_L
#undef G8_BAR
#undef G8_SCHED
}

struct DenseOrder {
    int nM, nN, nwg, G, c;
    __device__ __forceinline__ void init(int M, int N, int G_, int c_) { nM = M / BM; nN = N / BM; nwg = nM * nN; G = G_; c = c_; }
    __device__ __forceinline__ bool next(int i, Unit& u) const {
        const long L = (long)i * G + c; if (L >= nwg) return false;
        int wgid = (int)L; { const int q = nwg / 8, r = nwg % 8, xcd = wgid % 8, off = wgid / 8; wgid = (xcd < r ? xcd * (q + 1) : r * (q + 1) + (xcd - r) * q) + off; }
        const int nig = 8 * nN, gid = wgid / nig, fm = gid * 8, gsz = (nM - fm) < 8 ? (nM - fm) : 8;
        u.pm = fm + ((wgid % nig) % gsz); u.pn = (wgid % nig) / gsz; u.e = 0; u.row0 = u.pm * BM; u.p0 = 0; return true;
    }
};
}

struct Args { const float* in[29]; float* out; unsigned char* ws; int ph_lo, ph_hi, li, pad; };
struct Frame {
    LAS unsigned char* lds;
    gu32* ctl;
    int tid, lane, wave, vcu, G, bx;
    unsigned char* ws;
};
__device__ __forceinline__ float wsum(float v) {
#pragma unroll
    for (int o = 1; o < 64; o <<= 1) v += __shfl_xor(v, o);
    return v;
}

__device__ __forceinline__ void conv_item(const float* W, int ldw, int n_src0, int nvalid, int k0, bf16_t* WT, int dst_row0, int Kd, LAS float* scr, int lane) {
    const int ln = lane & 31;
#pragma unroll
    for (int i = 0; i < 32; ++i) { const int kk = 2 * i + (lane >> 5); scr[kk * 33 + ln] = (ln < nvalid) ? W[(size_t)(k0 + kk) * ldw + n_src0 + ln] : 0.f; }
    LDS_WAIT(); asm volatile("" ::: "memory");
    const int c = lane & 7;
#pragma unroll
    for (int j = 0; j < 4; ++j) { const int n = (lane >> 3) + 8 * j; const LAS float* s = scr + (8 * c) * 33 + n;
        u32x4 o; o.x = pk2(s[0 * 33], s[1 * 33]); o.y = pk2(s[2 * 33], s[3 * 33]); o.z = pk2(s[4 * 33], s[5 * 33]); o.w = pk2(s[6 * 33], s[7 * 33]);
        *(GAS u32x4*)(WT + (size_t)(dst_row0 + n) * Kd + k0 + 8 * c) = o; }
    LDS_WAIT(); asm volatile("" ::: "memory");
}
__device__ __forceinline__ void mod_item(const float* c, const float* w, float* modp, int item, int lane, LAS float* scr) {
    const int cb = item % 48, ks = item / 48, j0 = cb * 256 + lane * 4, k0 = ks * 128;
#pragma unroll
    for (int i = 0; i < 16; ++i) { const int idx = i * 64 + lane, kk = idx >> 3, b = idx & 7; const float cv = c[b * DM + k0 + kk]; scr[idx] = cv / (1.f + __expf(-cv)); }
    LDS_WAIT(); asm volatile("" ::: "memory");
    f32x4 acc[NB];
#pragma unroll
    for (int b = 0; b < NB; ++b) acc[b] = (f32x4){0.f, 0.f, 0.f, 0.f};
#pragma unroll 1
    for (int kb = 0; kb < 128; kb += 8) {
        f32x4 wv[8];
#pragma unroll
        for (int k = 0; k < 8; ++k) wv[k] = *(const GAS f32x4*)(w + (size_t)(k0 + kb + k) * (6 * DM) + j0);
        asm volatile("" : "+v"(wv[0]), "+v"(wv[1]), "+v"(wv[2]), "+v"(wv[3]), "+v"(wv[4]), "+v"(wv[5]), "+v"(wv[6]), "+v"(wv[7]) :: "memory");
#pragma unroll
        for (int k = 0; k < 8; ++k) {
            const f32x4 s0 = *(const LAS f32x4*)(scr + (kb + k) * 8), s1 = *(const LAS f32x4*)(scr + (kb + k) * 8 + 4);
            acc[0] += wv[k] * s0.x; acc[1] += wv[k] * s0.y; acc[2] += wv[k] * s0.z; acc[3] += wv[k] * s0.w; acc[4] += wv[k] * s1.x; acc[5] += wv[k] * s1.y; acc[6] += wv[k] * s1.z; acc[7] += wv[k] * s1.w;
        }
    }
#pragma unroll
    for (int b = 0; b < NB; ++b) *(GAS f32x4*)(modp + ((size_t)ks * NB + b) * 6 * DM + j0) = acc[b];
    LDS_WAIT(); asm volatile("" ::: "memory");
}
__device__ __forceinline__ float mod_reduce1(const float* modp, const float* bias, int idx) {
    const int b = idx / (6 * DM), j = idx % (6 * DM);
    float s = bias[j];
#pragma unroll
    for (int ks = 0; ks < 16; ++ks) s += modp[((size_t)ks * NB + b) * 6 * DM + j];
    return s;
}
__device__ __forceinline__ void pebias_part(const float* pe, const float* w, float* part, int kc, int lane) {
    const float* wp = w + (size_t)(kc * 64) * 64 + lane; const float* pp = pe + kc * 64;
    float a0 = 0.f, a1 = 0.f, a2 = 0.f, a3 = 0.f;
#pragma unroll
    for (int b = 0; b < 4; ++b) {
        float v[16];
#pragma unroll
        for (int j = 0; j < 16; ++j) v[j] = wp[(size_t)(b * 16 + j) * 64];
        asm volatile("" : "+v"(v[0]), "+v"(v[1]), "+v"(v[2]), "+v"(v[3]), "+v"(v[4]), "+v"(v[5]), "+v"(v[6]), "+v"(v[7]),
                          "+v"(v[8]), "+v"(v[9]), "+v"(v[10]), "+v"(v[11]), "+v"(v[12]), "+v"(v[13]), "+v"(v[14]), "+v"(v[15]));
#pragma unroll
        for (int j = 0; j < 16; j += 4) { a0 += pp[b * 16 + j] * v[j]; a1 += pp[b * 16 + j + 1] * v[j + 1]; a2 += pp[b * 16 + j + 2] * v[j + 2]; a3 += pp[b * 16 + j + 3] * v[j + 3]; }
    }
    part[kc * 64 + lane] = (a0 + a1) + (a2 + a3);
}
__device__ __forceinline__ void pebias_reduce(const float* part, float* outb, int lane) {
    float v[32];
#pragma unroll
    for (int j = 0; j < 32; ++j) v[j] = part[j * 64 + lane];
    float a = 0.f;
#pragma unroll
    for (int j = 0; j < 32; ++j) a += v[j];
    outb[lane] = a;
}

__device__ __forceinline__ void p0_prologue(Frame& F, const Args& A) {
    LAS float* scr = (LAS float*)(F.lds + F.wave * 16384);
    const int gw = F.wave * F.G + F.vcu, NGW = F.G * NWAVES;
    unsigned char* ws = F.ws;
    float* modp = (float*)(ws + WS_MODPART);
    constexpr int I_MOD = 768;
    constexpr int I_WIN = 32 * (ZW / 32);
    constexpr int I_WOUT = 0;
    constexpr int I_WR = 32, I_WCK = 64, I_WCV = 64, I_WRG = 32, I_WIG = 32, I_PE = 64;
    constexpr int NITEMS = I_MOD + I_WIN + I_WOUT + I_WR + I_WCK + I_WCV + I_WRG + I_WIG + I_PE;
    for (int it = gw; it < NITEMS; it += NGW) {
        int ln = F.lane; asm volatile("" : "+v"(ln));
        int r = it;
        if (r < I_MOD) { mod_item(A.in[1], A.in[2], modp, r, F.lane, scr); continue; } r -= I_MOD;
        if (r < I_WIN) {
            const int nb = r % (ZW / 32), kb = r / (ZW / 32), zc = nb * 32;
            int src, nv = 32;
            if (zc < 2560) src = zc; else if (zc < 4608) src = zc + 48; else { src = zc - 2048; nv = 4656 - zc; if (nv > 32) nv = 32; if (nv < 0) nv = 0; }
            if (nv == 0) src = 0;
            conv_item(A.in[5], INW, src, nv, kb * 64, (bf16_t*)(ws + WS_WIN), zc, DM, scr, ln); continue; } r -= I_WIN;
        if (r < I_WOUT) { const int nb = r % 64, kb = r / 64; conv_item(A.in[21], DM, nb * 32, 32, kb * 64, (bf16_t*)(ws + WS_WOUT), nb * 32, DM, scr, ln); continue; } r -= I_WOUT;
        if (r < I_WR) { conv_item(A.in[23], 32, 0, 32, r * 64, (bf16_t*)(ws + WS_SMALL + SM_WR), 0, DM, scr, ln); continue; } r -= I_WR;
        if (r < I_WCK) { const int nb = r % 2, kb = r / 2; conv_item(A.in[8], 64, nb * 32, 32, kb * 64, (bf16_t*)(ws + WS_SMALL + SM_WCK), nb * 32, DM, scr, ln); continue; } r -= I_WCK;
        if (r < I_WCV) { const int nb = r % 2, kb = r / 2; conv_item(A.in[9], 64, nb * 32, 32, kb * 64, (bf16_t*)(ws + WS_SMALL + SM_WCV), nb * 32, DM, scr, ln); continue; } r -= I_WCV;
        if (r < I_WRG) { const int nb = r % 2, blk = r / 2; conv_item(A.in[14] + (size_t)blk * 4096, 64, nb * 32, 32, 0, (bf16_t*)(ws + WS_SMALL + SM_WRG) + (size_t)blk * 4096, nb * 32, 64, scr, ln); continue; } r -= I_WRG;
        if (r < I_WIG) { const int nb = r % 2, blk = r / 2; conv_item(A.in[16] + (size_t)blk * 4096, 64, nb * 32, 32, 0, (bf16_t*)(ws + WS_SMALL + SM_WIG) + (size_t)blk * 4096, nb * 32, 64, scr, ln); continue; } r -= I_WIG;
        if (r < I_PE) { const int which = r >> 5; pebias_part(A.in[6 + which], A.in[8 + which], (float*)(ws + WS_PEPART) + which * 2048, r & 31, ln); continue; }
        (void)r;
    }
}

struct ProbZ {
    static constexpr int K = DM; static constexpr bool GATHER = false, PERM = true, MIDK = false;
    g8::DenseOrder ord; const bf16_t* A; const bf16_t* Bt; bf16_t* Z;
    __device__ __forceinline__ bool next(int i, g8::Unit& u) const { return ord.next(i, u); }
    __device__ __forceinline__ const char* a_base(const g8::Unit& u) const { return (const char*)A + (size_t)u.pm * 256 * K * 2; }
    __device__ __forceinline__ const char* b_base(const g8::Unit& u) const { return (const char*)Bt + (size_t)u.pn * 256 * K * 2; }
    __device__ __forceinline__ void a_voff(const g8::Unit&, int R0, int C0, int R1, int C1, unsigned& v00, unsigned& v01, unsigned& v10, unsigned& v11) const {
        v00 = (unsigned)(R0 * K + C0) * 2u; v01 = (unsigned)(R1 * K + C1) * 2u; v10 = v00 + 128u * K * 2u; v11 = v01 + 128u * K * 2u; }
    __device__ __forceinline__ void midk(g8::Acc&, const g8::Unit&, int, int) const {}
    __device__ __forceinline__ void epi(const g8::Acc& acc, const g8::Unit& u, int wr, int wc, int fr, int fq) const {
        const int row0 = u.row0 + wr * 64 + fr, col0 = u.pn * 256 + wc * 32 + 8 * fq;
#pragma unroll
        for (int ai = 0; ai < 2; ++ai)
#pragma unroll
            for (int m = 0; m < 4; ++m) { bf16_t* rowp = Z + (size_t)(row0 + ai * 128 + m * 16) * ZW + col0;
#pragma unroll
                for (int bj = 0; bj < 2; ++bj) { const f32x4 v0 = acc[ai][bj][m][0], v1 = acc[ai][bj][m][1];
                    u32x4 w; w.x = cvt_pk_bf16(v0[0], v0[1]); w.y = cvt_pk_bf16(v0[2], v0[3]); w.z = cvt_pk_bf16(v1[0], v1[1]); w.w = cvt_pk_bf16(v1[2], v1[3]);
                    *(u32x4*)(rowp + bj * 128) = w; } }
    }
};
__device__ __forceinline__ void build_tile_table(Frame& F) {
    LAS int* tab = (LAS int*)(F.lds + TILETAB_OFF);
    if (F.wave == 0) {
        const int lane = F.lane;
        const int* cnt = (const int*)(F.ctl + CW_CNT);
        const int c = (lane < NE) ? cnt[lane] : 0;
        const int t = (c + 255) >> 8;
        int ps = t;
#pragma unroll
        for (int o = 1; o < 32; o <<= 1) { const int v = __shfl_up(ps, o); if (lane >= o) ps += v; }
        const int t0 = ps - t;
        if (lane < NE) { tab[8 + lane] = c; tab[40 + lane] = t0 * 256;
            for (int j = 0; j < t; ++j) { tab[128 + t0 + j] = lane; tab[416 + t0 + j] = j * 256; } }
        if (lane == NE - 1) tab[0] = ps;
    }
    __syncthreads();
}
struct MoeOrder {
    const LAS int* tab; int G, c, NPN;
    __device__ __forceinline__ bool next(int i, g8::Unit& u) const {
        const int nt = tab[0], nunits = nt * NPN; const long L = (long)i * G + c; if (L >= nunits) return false;
        int w = (int)L; { const int q = nunits / 8, r = nunits % 8, xcd = w % 8, off = w / 8; w = (xcd < r ? xcd * (q + 1) : r * (q + 1) + (xcd - r) * q) + off; }
        const int gs = 4 * NPN, grp = w / gs, fm = grp * 4, gsz = (nt - fm) < 4 ? (nt - fm) : 4, rem = w % gs;
        u.pm = fm + rem % gsz; u.pn = rem / gsz; u.e = tab[128 + u.pm]; u.p0 = tab[416 + u.pm]; u.row0 = tab[40 + u.e] + u.p0; return true;
    }
};
__device__ __forceinline__ float fast_sigmoid(float x) { return __builtin_amdgcn_rcpf(1.f + __builtin_amdgcn_exp2f(-1.4426950408889634f * x)); }


__device__ __forceinline__ void p6_row(const u32x2 (&vb)[8], const f32x4 (&Ag)[8], const f32x4 (&Sh)[8], bf16_t* orow, unsigned char* orow8, int lane) {
    f32x4 v[8];
#pragma unroll
    for (int j = 0; j < 8; ++j) v[j] = (f32x4){bflo(vb[j].x), bfhi(vb[j].x), bflo(vb[j].y), bfhi(vb[j].y)};
    float s = 0.f;
#pragma unroll
    for (int j = 0; j < 8; ++j) s += (v[j].x * v[j].x + v[j].y * v[j].y) + (v[j].z * v[j].z + v[j].w * v[j].w);
    const float rstd = rsqrtf(wsum(s) * (1.f / DM) + EPS);
    GAS unsigned long long* o8 = (GAS unsigned long long*)orow + lane; GAS unsigned* o4 = (GAS unsigned*)orow8 + lane;
#pragma unroll
    for (int j = 0; j < 8; ++j) { const f32x4 hv = v[j] * rstd * Ag[j] + Sh[j];
        o8[64 * j] = (unsigned long long)pk2(hv.x, hv.y) | ((unsigned long long)pk2(hv.z, hv.w) << 32);
        o4[64 * j] = pk4_fp8(hv.x, hv.y, hv.z, hv.w); }
}
__device__ __forceinline__ void p6_route(Frame& F, const Args& A, const float* mod) {
    unsigned char* ws = F.ws;
    bf16_t* H2 = (bf16_t*)(ws + WS_H); const bf16_t* WrT = (const bf16_t*)(ws + WS_SMALL + SM_WR);
    int* cnt = (int*)(F.ctl + CW_CNT); int* rowtok = (int*)(ws + WS_ROUTE + RT_ROWTOK); float* rowg = (float*)(ws + WS_ROUTE + RT_ROWG); int* tokslot = (int*)(ws + WS_ROUTE + RT_TOKSLOT);
    const float* br = A.in[24];
    const int lane = F.lane, ar = lane & 15, kq = lane >> 4, tid = F.tid;
    LAS unsigned char* wl = F.lds;
    LAS int* ch_e = (LAS int*)(F.lds + TILETAB_OFF);
    LAS float* ch_g = (LAS float*)(ch_e + 256);
    LAS int* wcnt = (LAS int*)(ch_g + 256);
    LAS int* wbase = wcnt + 128;
    {
#pragma unroll
        for (int i = 0; i < 16; ++i) { const int q = F.wave * 16 + i, n = q >> 2, p = (q & 3) * 64 + lane;
            __builtin_amdgcn_global_load_lds((const unsigned*)((const char*)WrT + (size_t)n * 4096 + ((p ^ (n & 15)) << 4)), (LAS unsigned*)(wl + q * 1024), 16, 0, 0); }
    }
    for (int chunk = F.bx; chunk < NTOK / 64; chunk += F.G) {
        const int row0 = chunk * 64 + F.wave * 8, b = row0 / SEQ; const float* mb = mod + (size_t)b * 6 * DM;
        f32x4 Ag[8], Sh[8];
#pragma unroll
        for (int j = 0; j < 8; ++j) { const f32x4 gg = *((const GAS f32x4*)A.in[22] + lane + 64 * j), sc = *((const GAS f32x4*)(mb + 4 * DM) + lane + 64 * j);
            Ag[j] = gg * (sc + 1.f); Sh[j] = *((const GAS f32x4*)(mb + 3 * DM) + lane + 64 * j); }
        u32x2 xa[8], xb[8];
        const bf16_t* X1B = (const bf16_t*)(ws + WS_X1B);
#pragma unroll
        for (int j = 0; j < 8; ++j) xa[j] = *((const GAS u32x2*)(X1B + (size_t)row0 * DM) + lane + 64 * j);
#pragma unroll 1
        for (int r = 0; r < 8; r += 2) {
#pragma unroll
            for (int j = 0; j < 8; ++j) xb[j] = *((const GAS u32x2*)(X1B + (size_t)(row0 + r + 1) * DM) + lane + 64 * j);
            p6_row(xa, Ag, Sh, H2 + (size_t)(row0 + r) * DM, ws + WS_H8 + (size_t)(row0 + r) * DM, lane);
            if (r + 2 < 8) {
#pragma unroll
                for (int j = 0; j < 8; ++j) xa[j] = *((const GAS u32x2*)(X1B + (size_t)(row0 + r + 2) * DM) + lane + 64 * j); }
            p6_row(xb, Ag, Sh, H2 + (size_t)(row0 + r + 1) * DM, ws + WS_H8 + (size_t)(row0 + r + 1) * DM, lane);
        }
        VM_WAIT();
        __syncthreads();
        f32x4 acc0 = (f32x4){0.f, 0.f, 0.f, 0.f}, acc1 = acc0;
        const bf16_t* ap = H2 + (size_t)(row0 + (ar & 7)) * DM + kq * 8;
        const LAS unsigned char* w0 = wl + ar * 4096, *w1 = wl + (16 + ar) * 4096;
#pragma unroll 16
        for (int s = 0; s < 64; ++s) {
            const bf16x8 a = *(const GAS bf16x8*)(ap + 32 * s);
            const bf16x8 b0 = *(const LAS bf16x8*)(w0 + (((4 * s + kq) ^ ar) << 4)), b1 = *(const LAS bf16x8*)(w1 + (((4 * s + kq) ^ ar) << 4));
            acc0 = __builtin_amdgcn_mfma_f32_16x16x32_bf16(b0, a, acc0, 0, 0, 0);
            acc1 = __builtin_amdgcn_mfma_f32_16x16x32_bf16(b1, a, acc1, 0, 0, 0);
        }
        {
            const f32x4 bb0 = *(const GAS f32x4*)(br + 4 * kq), bb1 = *(const GAS f32x4*)(br + 16 + 4 * kq);
            float v[8] = {acc0[0] + bb0.x, acc0[1] + bb0.y, acc0[2] + bb0.z, acc0[3] + bb0.w, acc1[0] + bb1.x, acc1[1] + bb1.y, acc1[2] + bb1.z, acc1[3] + bb1.w};
            float tv[4]; int te[4];
#pragma unroll
            for (int k = 0; k < 4; ++k) {
                float bv = v[0]; int bi = 4 * kq;
#pragma unroll
                for (int q = 1; q < 8; ++q) { const int eq = (q < 4) ? 4 * kq + q : 16 + 4 * kq + (q - 4); if (v[q] > bv) { bv = v[q]; bi = eq; } }
#pragma unroll
                for (int o = 16; o < 64; o <<= 1) { const float ov = __shfl_xor(bv, o); const int oi = __shfl_xor(bi, o); if (ov > bv || (ov == bv && oi < bi)) { bv = ov; bi = oi; } }
                tv[k] = bv; te[k] = bi;
#pragma unroll
                for (int q = 0; q < 8; ++q) { const int eq = (q < 4) ? 4 * kq + q : 16 + 4 * kq + (q - 4); if (eq == bi) v[q] = -INFINITY; }
            }
            const float e1 = __expf(tv[1] - tv[0]), e2 = __expf(tv[2] - tv[0]), e3 = __expf(tv[3] - tv[0]); const float inv = 1.f / (1.f + e1 + e2 + e3);
            if (kq == 0 && ar < 8) { const int li = (F.wave * 8 + ar) * 4;
                ch_e[li] = te[0]; ch_e[li + 1] = te[1]; ch_e[li + 2] = te[2]; ch_e[li + 3] = te[3];
                ch_g[li] = inv; ch_g[li + 1] = e1 * inv; ch_g[li + 2] = e2 * inv; ch_g[li + 3] = e3 * inv; }
        }
        __syncthreads();
        int my_e = 0, my_rank = 0;
        if (F.wave < 4) { my_e = ch_e[tid];
#pragma unroll 4
            for (int e = 0; e < NE; ++e) { const unsigned long long mk = __ballot(my_e == e);
                if (my_e == e) my_rank = __popcll(mk & ((1ull << lane) - 1ull));
                if (lane == 0) wcnt[F.wave * 32 + e] = __popcll(mk); } }
        __syncthreads();
        if (tid < 32) { const int c0 = wcnt[tid], c1 = wcnt[32 + tid], c2 = wcnt[64 + tid], c3 = wcnt[96 + tid], tot = c0 + c1 + c2 + c3;
            const int base = tot ? atomicAdd(&cnt[tid], tot) : 0;
            wbase[tid] = base; wbase[32 + tid] = base + c0; wbase[64 + tid] = base + c0 + c1; wbase[96 + tid] = base + c0 + c1 + c2; }
        __syncthreads();
        if (F.wave < 4) { const int pos = wbase[F.wave * 32 + my_e] + my_rank, row = chunk * 64 + (tid >> 2);
            rowtok[(size_t)my_e * NTOK + pos] = row; rowg[(size_t)my_e * NTOK + pos] = ch_g[tid]; tokslot[row * 4 + (tid & 3)] = my_e * NTOK + pos; }
        __syncthreads();
    }
    VM_WAIT();
    __syncthreads();
}
__device__ __forceinline__ void p9_combine(Frame& F, const Args& A, const float* mod) {
    unsigned char* ws = F.ws; const LAS int* tab = (const LAS int*)(F.lds + TILETAB_OFF);
    const unsigned char* Y8 = ws + WS_Y; const int* tokslot = (const int*)(ws + WS_ROUTE + RT_TOKSLOT);
    const int lane = F.lane; const int gw = F.vcu * NWAVES + F.wave, NGW = F.G * NWAVES;
    for (int tok = gw; tok < NTOK; tok += NGW) {
        const int b = tok / SEQ; const float* g2 = mod + (size_t)b * 6 * DM + 5 * DM;
        const int4 sl = *(const int4*)(tokslot + tok * 4);
        const int s4[4] = {sl.x, sl.y, sl.z, sl.w};
        const unsigned char* yr[4];
#pragma unroll
        for (int k = 0; k < 4; ++k) { const int e = s4[k] / NTOK, p = s4[k] % NTOK; yr[k] = Y8 + (size_t)(tab[40 + e] + p) * DM + lane * 16; }
        float* orow = A.out + (size_t)tok * DM + lane * 16;
        const bf16_t* xrow = (const bf16_t*)(ws + WS_X1B) + (size_t)tok * DM + lane * 16;
#pragma unroll
        for (int j = 0; j < 2; ++j) {
            float s[16];
#pragma unroll
            for (int q = 0; q < 16; ++q) s[q] = 0.f;
#pragma unroll
            for (int k = 0; k < 4; ++k) { const u32x4 v = *(const GAS u32x4*)(yr[k] + 1024 * j);
                const unsigned w[4] = {v.x, v.y, v.z, v.w};
#pragma unroll
                for (int q = 0; q < 4; ++q) { const f32x2 lo = __builtin_amdgcn_cvt_pk_f32_fp8(w[q], false), hi2 = __builtin_amdgcn_cvt_pk_f32_fp8(w[q], true);
                    s[4 * q] += lo.x; s[4 * q + 1] += lo.y; s[4 * q + 2] += hi2.x; s[4 * q + 3] += hi2.y; } }
            const u32x4 xw0 = *(const GAS u32x4*)(xrow + 1024 * j), xw1 = *(const GAS u32x4*)(xrow + 1024 * j + 8);
            const unsigned xw[8] = {xw0.x, xw0.y, xw0.z, xw0.w, xw1.x, xw1.y, xw1.z, xw1.w};
#pragma unroll
            for (int q = 0; q < 4; ++q) { const f32x4 x0 = (f32x4){bflo(xw[2 * q]), bfhi(xw[2 * q]), bflo(xw[2 * q + 1]), bfhi(xw[2 * q + 1])}; const f32x4 ga = *(const GAS f32x4*)(g2 + lane * 16 + 1024 * j + 4 * q);
                *(GAS f32x4*)(orow + 1024 * j + 4 * q) = x0 + ga * ((f32x4){s[4 * q], s[4 * q + 1], s[4 * q + 2], s[4 * q + 3]} * 0.125f); }
        }
    }
}
constexpr int RSTAB_OFF = TILETAB_OFF + 4096;
struct ProbMix {
    static constexpr int K = DM; static constexpr bool GATHER = false, PERM = false, MIDK = true;
    g8::DenseOrder ord; const bf16_t* A; const bf16_t* Bt; const float* x; const float* mod; bf16_t* x1b; const LAS float* rs;
    __device__ __forceinline__ bool next(int i, g8::Unit& u) const { const bool ok = ord.next(i, u); u.p0 = i; return ok; }
    __device__ __forceinline__ const char* a_base(const g8::Unit& u) const { return (const char*)A + (size_t)u.pm * 256 * K * 2; }
    __device__ __forceinline__ const char* b_base(const g8::Unit& u) const { return (const char*)Bt + (size_t)u.pn * 256 * K * 2; }
    __device__ __forceinline__ void a_voff(const g8::Unit&, int R0, int C0, int R1, int C1, unsigned& v00, unsigned& v01, unsigned& v10, unsigned& v11) const {
        v00 = (unsigned)(R0 * K + C0) * 2u; v01 = (unsigned)(R1 * K + C1) * 2u; v10 = v00 + 128u * K * 2u; v11 = v01 + 128u * K * 2u; }
    __device__ __forceinline__ void midk(g8::Acc& acc, const g8::Unit& u, int wr, int fr) const {
        const LAS float* t = rs + (size_t)u.p0 * 512;
#pragma unroll
        for (int ai = 0; ai < 2; ++ai)
#pragma unroll
            for (int m = 0; m < 4; ++m) { const float r = t[(ai * 128 + wr * 64 + m * 16 + fr) * 2];
#pragma unroll
                for (int bj = 0; bj < 2; ++bj)
#pragma unroll
                    for (int n = 0; n < 2; ++n) acc[ai][bj][m][n] *= r; }
    }
    __device__ __forceinline__ void epi(const g8::Acc& acc, const g8::Unit& u, int wr, int wc, int fr, int fq) const {
        const LAS float* t = rs + (size_t)u.p0 * 512;
        const int lr0 = wr * 64 + fr, col0 = u.pn * 256 + wc * 32 + 4 * fq; const int b = u.row0 / SEQ;
        const float* g1 = mod + (size_t)b * 6 * DM + 2 * DM + col0;
        f32x4 gv[2][2];
#pragma unroll
        for (int bj = 0; bj < 2; ++bj)
#pragma unroll
            for (int n = 0; n < 2; ++n) gv[bj][n] = *(const f32x4*)(g1 + bj * 128 + n * 16);
#pragma unroll
        for (int ai = 0; ai < 2; ++ai) {
            f32x4 xv[4][2][2];
#pragma unroll
            for (int m = 0; m < 4; ++m) { const size_t off = (size_t)(u.row0 + lr0 + ai * 128 + m * 16) * DM + col0;
#pragma unroll
                for (int bj = 0; bj < 2; ++bj)
#pragma unroll
                    for (int n = 0; n < 2; ++n) xv[m][bj][n] = *(const f32x4*)(x + off + bj * 128 + n * 16); }
#pragma unroll
            for (int m = 0; m < 4; ++m) { const int lr = lr0 + ai * 128 + m * 16; const float rl = t[lr * 2 + 1]; const size_t off = (size_t)(u.row0 + lr) * DM + col0;
#pragma unroll
                for (int bj = 0; bj < 2; ++bj)
#pragma unroll
                    for (int n = 0; n < 2; ++n) { const f32x4 r = xv[m][bj][n] + gv[bj][n] * (acc[ai][bj][m][n] * rl);
                        *(u32x2*)(x1b + off + bj * 128 + n * 16) = (u32x2){pk2(r.x, r.y), pk2(r.z, r.w)}; } }
            asm volatile("" ::: "memory");
        }
    }
};
__device__ __forceinline__ void p5_build_rstab(Frame& F, const g8::DenseOrder& ord, const float* ssn, const float* ssl) {
    LAS float* rs = (LAS float*)(F.lds + RSTAB_OFF);
    g8::Unit u;
    for (int i = 0; i < 4 && ord.next(i, u); ++i) {
        for (int r = F.tid; r < 256; r += NWAVES * 64) { const int row = u.row0 + r;
            const f32x4 a = *(const GAS f32x4*)(ssn + (size_t)row * 4); float sn = (a.x + a.y) + (a.z + a.w);
            float sl = 0.f;
#pragma unroll
            for (int q = 0; q < 4; ++q) { const f32x4 c = *(const GAS f32x4*)(ssl + (size_t)row * 16 + 4 * q); sl += (c.x + c.y) + (c.z + c.w); }
            const float rn = rsqrtf(sn * (1.f / 1024.f) + EPS), rl = rsqrtf(sl * (1.f / 1024.f) + EPS);
            rs[(i * 256 + r) * 2] = rn / rl; rs[(i * 256 + r) * 2 + 1] = rl; }
    }
    __syncthreads();
}
constexpr int TOKBUF_OFF = TILETAB_OFF + 3072;
namespace g8 {
typedef int v8i __attribute__((ext_vector_type(8)));
typedef int v4i __attribute__((ext_vector_type(4)));
__host__ __device__ __forceinline__ int sw8(int row) { const int P = (row >> 1) & 7; return P ^ ((((P >> 2) ^ (P >> 1)) & 1) << 1); }
__device__ __forceinline__ void mfma16_fp8(f32x4& acc, const v8i& a, const v8i& b, int scl) {
    asm volatile("v_mfma_scale_f32_16x16x128_f8f6f4 %0, %1, %2, %0, %3, %3 op_sel_hi:[0,0,0]" : "+v"(acc) : "v"(a), "v"(b), "v"(scl)); }

template <class P>
__device__ __forceinline__ void gemm8_phase(LAS unsigned char* lds, const P& S) {
    const int tid = threadIdx.x, wid = __builtin_amdgcn_readfirstlane(tid >> 6), lane = tid & 63, wr = wid >> 2, wc = wid & 3, fr = lane & 15, fq = lane >> 4;
    constexpr int KB = P::KB, nt = KB / 128;
    const int R0 = wid * 8 + (lane >> 3), R1 = R0 + 64;
    const unsigned cs = (unsigned)(((lane & 7) ^ sw8(R0)) * 16);
    const int Rb0 = (R0 & ~31) + perm32(R0 & 31), Rb1 = (R1 & ~31) + perm32(R1 & 31);
    const unsigned voffB0 = (unsigned)Rb0 * KB + cs, voffB1 = (unsigned)Rb1 * KB + cs;
    constexpr size_t kstep = 128;
    constexpr unsigned hstep = 128u * KB;
    const unsigned ldsw = (unsigned)wid * 1024u;
    const int xr = sw8(fr);
    int aoff[2], boff[2];
#pragma unroll
    for (int c = 0; c < 2; ++c) { const int sl = ((2 * fq + c) ^ xr) << 4; aoff[c] = (64 * wr + fr) * 128 + sl; boff[c] = (32 * wc + fr) * 128 + sl; }
    int scl = 0x7f7f7f7f;
    asm volatile("" : "+v"(scl));
#define G8_SA(b, h) (((b) * 2 + (h)) * HTB)
#define G8_SB(b, h) ((4 + (b) * 2 + (h)) * HTB)
#define G8_STAGE(bufoff, gbase, o0, o1) do { \
        __builtin_amdgcn_global_load_lds((const unsigned*)((const char*)(gbase) + (o0)), (LAS unsigned*)(lds + (bufoff) + ldsw), 16, 0, 0); \
        __builtin_amdgcn_global_load_lds((const unsigned*)((const char*)(gbase) + (o1)), (LAS unsigned*)(lds + (bufoff) + ldsw + 8192), 16, 0, 0); } while (0)
#define G8_STAGEB(bufoff, gbase, h) G8_STAGE(bufoff, gbase, voffB0 + (h) * hstep, voffB1 + (h) * hstep)
#define G8_LDA(dst, b, h) do { _Pragma("unroll") for (int m = 0; m < 4; ++m) { \
        const v4i _lo = *(const LAS v4i*)(lds + G8_SA(b, h) + aoff[0] + m * 2048), _hi = *(const LAS v4i*)(lds + G8_SA(b, h) + aoff[1] + m * 2048); \
        dst[m] = __builtin_shufflevector(_lo, _hi, 0, 1, 2, 3, 4, 5, 6, 7); } } while (0)
#define G8_LDB(dst, b, h) do { _Pragma("unroll") for (int n = 0; n < 2; ++n) { \
        const v4i _lo = *(const LAS v4i*)(lds + G8_SB(b, h) + boff[0] + n * 2048), _hi = *(const LAS v4i*)(lds + G8_SB(b, h) + boff[1] + n * 2048); \
        dst[n] = __builtin_shufflevector(_lo, _hi, 0, 1, 2, 3, 4, 5, 6, 7); } } while (0)
#define G8_MMA(ai, bj, At, Bt) do { __builtin_amdgcn_s_setprio(1); _Pragma("unroll") for (int m = 0; m < 4; ++m) _Pragma("unroll") for (int n = 0; n < 2; ++n) \
        mfma16_fp8(acc[ai][bj][m][n], Bt[n], At[m], scl); __builtin_amdgcn_s_setprio(0); } while (0)
#define G8_WAIT_V(n) asm volatile("s_waitcnt vmcnt(" #n ")" ::: "memory")
#define G8_WAIT_L(n) asm volatile("s_waitcnt lgkmcnt(" #n ")" ::: "memory")
#define G8_BAR __builtin_amdgcn_s_barrier()
#define G8_SCHED __builtin_amdgcn_sched_barrier(0)
    Unit cur, nxt; int ui = 0;
    if (!S.next(0, cur)) return;
    Acc acc;
#pragma unroll
    for (int a = 0; a < 2; ++a)
#pragma unroll
        for (int b = 0; b < 2; ++b)
#pragma unroll
            for (int m = 0; m < 4; ++m)
#pragma unroll
                for (int n = 0; n < 2; ++n) acc[a][b][m][n] = (f32x4){0.f, 0.f, 0.f, 0.f};
    v8i At[4], B0[2], B1[2];
    unsigned c00, c01, c10, c11, n00, n01, n10, n11;
    S.a_voff(cur, R0, R1, cs, c00, c01, c10, c11);
    n00 = c00; n01 = c01; n10 = c10; n11 = c11;
    const char* cA = S.a_base(cur); const char* cB = S.b_base(cur);
    if (P::ROWPF) S.tok_prefetch(lds, cur, 0, wid, lane);
    G8_STAGEB(G8_SB(0, 0), cB, 0); G8_STAGEB(G8_SB(0, 1), cB, 1); G8_STAGE(G8_SA(0, 0), cA, c00, c01); G8_STAGE(G8_SA(0, 1), cA, c10, c11);
    if (wr == 1) G8_BAR;
    G8_WAIT_V(2); G8_BAR;
    G8_STAGEB(G8_SB(1, 0), cB + kstep, 0); G8_STAGE(G8_SA(1, 0), cA + kstep, c00, c01); G8_STAGEB(G8_SB(1, 1), cB + kstep, 1);
    G8_WAIT_V(6); G8_BAR;
    for (;;) {
        const bool has_next = S.next(ui + 1, nxt);
        const char* nA = has_next ? S.a_base(nxt) : cA; const char* nB = has_next ? S.b_base(nxt) : cB;
        if (P::GATHER || P::ROWPF) { if (has_next) S.tok_prefetch(lds, nxt, ui + 1, wid, lane); }
        if (P::GATHER) { n00 = c00; n01 = c01; n10 = c10; n11 = c11; }
        for (int t = 0; t < nt; t += 2) {
            const bool last = (t == nt - 2);
            if (P::MIDK) { if (t == nt / 2) S.midk(acc, cur, wr, fr); }
            if (P::GATHER) { if (last && has_next) S.a_voff_lds(lds, nxt, ui + 1, R0, R1, cs, n00, n01, n10, n11); }
            const char* a1 = cA + (size_t)(t + 1) * kstep;
            const char* a2 = last ? nA : cA + (size_t)(t + 2) * kstep; const char* b2 = last ? nB : cB + (size_t)(t + 2) * kstep;
            const char* a3 = a2 + kstep; const char* b3 = b2 + kstep;
            const unsigned x00 = (P::GATHER && last) ? n00 : c00, x01 = (P::GATHER && last) ? n01 : c01, x10 = (P::GATHER && last) ? n10 : c10, x11 = (P::GATHER && last) ? n11 : c11;
            G8_LDB(B0, 0, 0); G8_LDB(B1, 0, 1); G8_SCHED; G8_LDA(At, 0, 0); G8_STAGE(G8_SA(1, 1), a1, c10, c11);
            G8_WAIT_V(8); G8_WAIT_L(0); G8_BAR; G8_WAIT_L(0); G8_SCHED; G8_MMA(0, 0, At, B0); G8_MMA(0, 1, At, B1); G8_BAR; G8_SCHED;
            G8_LDA(At, 0, 1); G8_STAGEB(G8_SB(0, 0), b2, 0); G8_STAGEB(G8_SB(0, 1), b2, 1); G8_STAGE(G8_SA(0, 0), a2, x00, x01);
            G8_WAIT_V(8); G8_WAIT_L(0); G8_BAR; G8_WAIT_L(0); G8_SCHED; G8_MMA(1, 0, At, B0); G8_MMA(1, 1, At, B1); G8_BAR; G8_SCHED;
            G8_LDB(B0, 1, 0); G8_LDB(B1, 1, 1); G8_SCHED; G8_LDA(At, 1, 0); G8_STAGE(G8_SA(0, 1), a2, x10, x11);
            G8_WAIT_V(8); G8_WAIT_L(0); G8_BAR; G8_WAIT_L(0); G8_SCHED; G8_MMA(0, 0, At, B0); G8_MMA(0, 1, At, B1); G8_BAR; G8_SCHED;
            G8_LDA(At, 1, 1); G8_STAGEB(G8_SB(1, 0), b3, 0); G8_STAGEB(G8_SB(1, 1), b3, 1); G8_STAGE(G8_SA(1, 0), a3, x00, x01);
            G8_WAIT_V(8); G8_WAIT_L(0); G8_BAR; G8_WAIT_L(0); G8_SCHED; G8_MMA(1, 0, At, B0); G8_MMA(1, 1, At, B1); G8_BAR; G8_SCHED;
        }
        asm volatile("s_nop 15\n\ts_nop 15" ::: "memory");
        if (wr == 0) G8_BAR;
        { int tz = threadIdx.x; asm volatile("" : "+v"(tz));
          const int lz = tz & 63; S.epi(acc, cur, wr, wc, lz & 15, lz >> 4, lds, ui); }
        if (!has_next) break;
#pragma unroll
        for (int a = 0; a < 2; ++a)
#pragma unroll
            for (int b = 0; b < 2; ++b)
#pragma unroll
                for (int m = 0; m < 4; ++m)
#pragma unroll
                    for (int n = 0; n < 2; ++n) acc[a][b][m][n] = (f32x4){0.f, 0.f, 0.f, 0.f};
        cur = nxt; cA = nA; cB = nB; ++ui;
        if (P::GATHER) { c00 = n00; c01 = n01; c10 = n10; c11 = n11; }
        if (wr == 1) G8_BAR;
    }
    G8_WAIT_V(0);
    G8_BAR;
#undef G8_SA
#undef G8_SB
#undef G8_STAGE
#undef G8_STAGEB
#undef G8_LDA
#undef G8_LDB
#undef G8_MMA
#undef G8_WAIT_V
#undef G8_WAIT_L
#undef G8_BAR
#undef G8_SCHED
}
}


struct Conv8Src { const float* W; int ldw, n_src0, k0; unsigned char* WT8; int dst_row0; };
__device__ __forceinline__ void conv8_load(const Conv8Src& s, f32x4 (&v)[8], int tid) {
    const int c4 = tid & 15, kr = tid >> 4;
#pragma unroll
    for (int i = 0; i < 8; ++i) v[i] = *(const GAS f32x4*)(s.W + (size_t)(s.k0 + i * 32 + kr) * s.ldw + s.n_src0 + 4 * c4);
}
__device__ __forceinline__ void conv8_to_lds(const f32x4 (&v)[8], LAS float* scr, int tid) {
    const int c4 = tid & 15, kr = tid >> 4;
#pragma unroll
    for (int i = 0; i < 8; ++i) { const int k = i * 32 + kr; const int g = 4 * ((k >> 4) & 7) + 2 * (k >> 7);
        *(LAS f32x2*)(scr + k * 64 + ((4 * c4) ^ g)) = (f32x2){v[i].x, v[i].y}; *(LAS f32x2*)(scr + k * 64 + ((4 * c4 + 2) ^ g)) = (f32x2){v[i].z, v[i].w}; }
}
__device__ __forceinline__ void conv8_store(const Conv8Src& sd, const LAS float* scr, int tid) {
    const int kc = tid & 15, ns = tid >> 4; const int g = 4 * (kc & 7) + 2 * (kc >> 3);
#pragma unroll
    for (int p = 0; p < 2; ++p) { const int n = ns + 32 * p; const LAS float* s = scr + (16 * kc) * 64 + (n ^ g);
        u32x4 o;
        o.x = pk4_fp8(s[0 * 64] * 32.f, s[1 * 64] * 32.f, s[2 * 64] * 32.f, s[3 * 64] * 32.f);     o.y = pk4_fp8(s[4 * 64] * 32.f, s[5 * 64] * 32.f, s[6 * 64] * 32.f, s[7 * 64] * 32.f);
        o.z = pk4_fp8(s[8 * 64] * 32.f, s[9 * 64] * 32.f, s[10 * 64] * 32.f, s[11 * 64] * 32.f);   o.w = pk4_fp8(s[12 * 64] * 32.f, s[13 * 64] * 32.f, s[14 * 64] * 32.f, s[15 * 64] * 32.f);
        *(GAS u32x4*)(sd.WT8 + (size_t)(sd.dst_row0 + n) * DM + sd.k0 + 16 * kc) = o; }
}

struct ProbM1F {
    static constexpr int KB = DM; static constexpr bool GATHER = true, ROWPF = false, MIDK = false;
    MoeOrder ord; const unsigned char* H8; const unsigned char* W1T8; const float* b1; const int* rowtok; unsigned char* ACT8;
    __device__ __forceinline__ bool next(int i, g8::Unit& u) const { return ord.next(i, u); }
    __device__ __forceinline__ const char* a_base(const g8::Unit&) const { return (const char*)H8; }
    __device__ __forceinline__ const char* b_base(const g8::Unit& u) const { return (const char*)W1T8 + ((size_t)u.e * 4096 + (size_t)u.pn * 256) * KB; }
    __device__ __forceinline__ void a_voff(const g8::Unit& u, int R0, int R1, unsigned cs, unsigned& v00, unsigned& v01, unsigned& v10, unsigned& v11) const {
        const int cntE = ord.tab[8 + u.e]; const int* rt = rowtok + (size_t)u.e * NTOK + u.p0; const int lim = cntE - u.p0;
        const int t00 = (R0 < lim) ? rt[R0] : 0, t01 = (R1 < lim) ? rt[R1] : 0, t10 = (128 + R0 < lim) ? rt[128 + R0] : 0, t11 = (128 + R1 < lim) ? rt[128 + R1] : 0;
        v00 = (unsigned)t00 * KB + cs; v01 = (unsigned)t01 * KB + cs; v10 = (unsigned)t10 * KB + cs; v11 = (unsigned)t11 * KB + cs; }
    __device__ __forceinline__ void tok_prefetch(LAS unsigned char* lds, const g8::Unit& u, int ui, int wid, int lane) const {
        if (wid == 0) __builtin_amdgcn_global_load_lds((const unsigned*)(rowtok + (size_t)u.e * NTOK + u.p0 + lane * 4), (LAS unsigned*)(lds + TOKBUF_OFF + (ui & 1) * 1024), 16, 0, 0); }
    __device__ __forceinline__ void a_voff_lds(const LAS unsigned char* lds, const g8::Unit& u, int ui, int R0, int R1, unsigned cs, unsigned& v00, unsigned& v01, unsigned& v10, unsigned& v11) const {
        const LAS int* rt = (const LAS int*)(lds + TOKBUF_OFF + (ui & 1) * 1024); const int lim = ord.tab[8 + u.e] - u.p0;
        const int t00 = (R0 < lim) ? rt[R0] : 0, t01 = (R1 < lim) ? rt[R1] : 0, t10 = (128 + R0 < lim) ? rt[128 + R0] : 0, t11 = (128 + R1 < lim) ? rt[128 + R1] : 0;
        v00 = (unsigned)t00 * KB + cs; v01 = (unsigned)t01 * KB + cs; v10 = (unsigned)t10 * KB + cs; v11 = (unsigned)t11 * KB + cs; }
    __device__ __forceinline__ void midk(g8::Acc&, const g8::Unit&, int, int) const {}
    __device__ __forceinline__ void epi(const g8::Acc& acc, const g8::Unit& u, int wr, int wc, int fr, int fq, const LAS unsigned char* lds, int ui) const {
        const int cc = u.pn * 128 + wc * 32 + 8 * fq;
        const float* bg = b1 + (size_t)u.e * 4096 + cc; const float* bl = bg + 2048;
        f32x4 bgv[2], blv[2];
#pragma unroll
        for (int n = 0; n < 2; ++n) { bgv[n] = *(const f32x4*)(bg + 4 * n); blv[n] = *(const f32x4*)(bl + 4 * n) + 1.f; }
#pragma unroll
        for (int ai = 0; ai < 2; ++ai)
#pragma unroll
            for (int m = 0; m < 4; ++m) {
                unsigned w[2];
#pragma unroll
                for (int n = 0; n < 2; ++n) { f32x2 o2[2];
#pragma unroll
                    for (int h2 = 0; h2 < 2; ++h2) {
                        const f32x2 ag = (f32x2){acc[ai][0][m][n][2 * h2], acc[ai][0][m][n][2 * h2 + 1]}, al = (f32x2){acc[ai][1][m][n][2 * h2], acc[ai][1][m][n][2 * h2 + 1]};
                        const f32x2 bgg = (f32x2){bgv[n][2 * h2], bgv[n][2 * h2 + 1]}, bll = (f32x2){blv[n][2 * h2], blv[n][2 * h2 + 1]};
                        f32x2 ug = ag * 0.03125f + bgg, ul = al * 0.03125f + bll;
                        ug.x = fminf(ug.x, 7.f); ug.y = fminf(ug.y, 7.f); ul.x = fminf(fmaxf(ul.x, -6.f), 8.f); ul.y = fminf(fmaxf(ul.y, -6.f), 8.f);
                        const f32x2 ea = ug * (-1.702f * 1.4426950408889634f);
                        f32x2 den; den.x = __builtin_amdgcn_exp2f(ea.x); den.y = __builtin_amdgcn_exp2f(ea.y); den = den + 1.f;
                        f32x2 sg; sg.x = __builtin_amdgcn_rcpf(den.x); sg.y = __builtin_amdgcn_rcpf(den.y);
                        o2[h2] = (ug * sg) * ul; }
                    w[n] = pk4_fp8(o2[0].x, o2[0].y, o2[1].x, o2[1].y); }
                *(u32x2*)(ACT8 + (size_t)(u.row0 + ai * 128 + wr * 64 + m * 16 + fr) * DM + cc) = (u32x2){w[0], w[1]}; }
    }
};
struct ProbM2F {
    static constexpr int KB = DM; static constexpr bool GATHER = false, ROWPF = true, MIDK = false;
    MoeOrder ord; const unsigned char* ACT8; const unsigned char* W2T8; const float* b2; const float* rowg; unsigned char* Y8;
    __device__ __forceinline__ bool next(int i, g8::Unit& u) const { return ord.next(i, u); }
    __device__ __forceinline__ const char* a_base(const g8::Unit& u) const { return (const char*)ACT8 + (size_t)u.row0 * KB; }
    __device__ __forceinline__ const char* b_base(const g8::Unit& u) const { return (const char*)W2T8 + ((size_t)u.e * DM + (size_t)u.pn * 256) * KB; }
    __device__ __forceinline__ void a_voff(const g8::Unit&, int R0, int R1, unsigned cs, unsigned& v00, unsigned& v01, unsigned& v10, unsigned& v11) const {
        v00 = (unsigned)R0 * KB + cs; v01 = (unsigned)R1 * KB + cs; v10 = v00 + 128u * KB; v11 = v01 + 128u * KB; }
    __device__ __forceinline__ void tok_prefetch(LAS unsigned char* lds, const g8::Unit& u, int ui, int wid, int lane) const {
        if (wid == 0) __builtin_amdgcn_global_load_lds((const unsigned*)(rowg + (size_t)u.e * NTOK + u.p0 + lane * 4), (LAS unsigned*)(lds + RSTAB_OFF + (ui % 3) * 1024), 16, 0, 0); }
    __device__ __forceinline__ void a_voff_lds(const LAS unsigned char*, const g8::Unit&, int, int, int, unsigned, unsigned&, unsigned&, unsigned&, unsigned&) const {}
    __device__ __forceinline__ void midk(g8::Acc&, const g8::Unit&, int, int) const {}
    __device__ __forceinline__ void epi(const g8::Acc& acc, const g8::Unit& u, int wr, int wc, int fr, int fq, const LAS unsigned char* lds, int ui) const {
        const int lr0 = wr * 64 + fr, col0 = u.pn * 256 + wc * 32 + 8 * fq;
        const LAS float* rg = (const LAS float*)(lds + RSTAB_OFF + (ui % 3) * 1024) + lr0;
        f32x4 bv[2][2];
#pragma unroll
        for (int bj = 0; bj < 2; ++bj)
#pragma unroll
            for (int n = 0; n < 2; ++n) bv[bj][n] = *(const f32x4*)(b2 + (size_t)u.e * DM + col0 + bj * 128 + 4 * n);
#pragma unroll
        for (int ai = 0; ai < 2; ++ai)
#pragma unroll
            for (int m = 0; m < 4; ++m) { const float gsc = rg[ai * 128 + m * 16] * 8.f; unsigned char* rowp = Y8 + (size_t)(u.row0 + lr0 + ai * 128 + m * 16) * DM + col0;
#pragma unroll
                for (int bj = 0; bj < 2; ++bj) { const f32x4 v0 = (acc[ai][bj][m][0] * 0.03125f + bv[bj][0]) * gsc, v1 = (acc[ai][bj][m][1] * 0.03125f + bv[bj][1]) * gsc;
                    *(u32x2*)(rowp + bj * 128) = (u32x2){pk4_fp8(v0[0], v0[1], v0[2], v0[3]), pk4_fp8(v1[0], v1[1], v1[2], v1[3])}; } }
    }
};

struct ProbMix8 {
    static constexpr int KB = DM; static constexpr bool GATHER = false, ROWPF = false, MIDK = true;
    g8::DenseOrder ord; const unsigned char* A8; const unsigned char* W8; const float* x; const float* mod; bf16_t* x1b; const LAS float* rs;
    __device__ __forceinline__ bool next(int i, g8::Unit& u) const { const bool ok = ord.next(i, u); u.p0 = i; return ok; }
    __device__ __forceinline__ const char* a_base(const g8::Unit& u) const { return (const char*)A8 + (size_t)u.pm * 256 * KB; }
    __device__ __forceinline__ const char* b_base(const g8::Unit& u) const { return (const char*)W8 + (size_t)u.pn * 256 * KB; }
    __device__ __forceinline__ void a_voff(const g8::Unit&, int R0, int R1, unsigned cs, unsigned& v00, unsigned& v01, unsigned& v10, unsigned& v11) const {
        v00 = (unsigned)R0 * KB + cs; v01 = (unsigned)R1 * KB + cs; v10 = v00 + 128u * KB; v11 = v01 + 128u * KB; }
    __device__ __forceinline__ void tok_prefetch(LAS unsigned char*, const g8::Unit&, int, int, int) const {}
    __device__ __forceinline__ void a_voff_lds(const LAS unsigned char*, const g8::Unit&, int, int, int, unsigned, unsigned&, unsigned&, unsigned&, unsigned&) const {}
    __device__ __forceinline__ void midk(g8::Acc& acc, const g8::Unit& u, int wr, int fr) const {
        const LAS float* t = rs + (size_t)u.p0 * 512;
#pragma unroll
        for (int ai = 0; ai < 2; ++ai)
#pragma unroll
            for (int m = 0; m < 4; ++m) { const float r = t[(ai * 128 + wr * 64 + m * 16 + fr) * 2];
#pragma unroll
                for (int bj = 0; bj < 2; ++bj)
#pragma unroll
                    for (int n = 0; n < 2; ++n) acc[ai][bj][m][n] *= r; }
    }
    __device__ __forceinline__ void epi(const g8::Acc& acc, const g8::Unit& u, int wr, int wc, int fr, int fq, const LAS unsigned char*, int) const {
        const LAS float* t = rs + (size_t)u.p0 * 512;
        const int lr0 = wr * 64 + fr, col0 = u.pn * 256 + wc * 32 + 8 * fq; const int b = u.row0 / SEQ;
        const float* g1 = mod + (size_t)b * 6 * DM + 2 * DM + col0;
        f32x4 gv[2][2];
#pragma unroll
        for (int bj = 0; bj < 2; ++bj)
#pragma unroll
            for (int n = 0; n < 2; ++n) gv[bj][n] = *(const f32x4*)(g1 + bj * 128 + 4 * n) * (1.f / (32.f * A2_SCALE));
#pragma unroll
        for (int ai = 0; ai < 2; ++ai) {
            f32x4 xv[4][2][2];
#pragma unroll
            for (int m = 0; m < 4; ++m) { const size_t off = (size_t)(u.row0 + lr0 + ai * 128 + m * 16) * DM + col0;
#pragma unroll
                for (int bj = 0; bj < 2; ++bj)
#pragma unroll
                    for (int n = 0; n < 2; ++n) xv[m][bj][n] = *(const f32x4*)(x + off + bj * 128 + 4 * n); }
#pragma unroll
            for (int m = 0; m < 4; ++m) { const int lr = lr0 + ai * 128 + m * 16; const float rl = t[lr * 2 + 1]; const size_t off = (size_t)(u.row0 + lr) * DM + col0;
#pragma unroll
                for (int bj = 0; bj < 2; ++bj) { const f32x4 r0 = xv[m][bj][0] + gv[bj][0] * (acc[ai][bj][m][0] * rl), r1 = xv[m][bj][1] + gv[bj][1] * (acc[ai][bj][m][1] * rl);
                    *(u32x4*)(x1b + off + bj * 128) = (u32x4){pk2(r0.x, r0.y), pk2(r0.z, r0.w), pk2(r1.x, r1.y), pk2(r1.z, r1.w)}; } }
            asm volatile("" ::: "memory");
        }
    }
};

constexpr int CONV_NIT1 = NE * 16 * 64, CONV_NIT = CONV_NIT1 + NE * 16 * 32, CONV_NITX = CONV_NIT + 16 * 32;
struct Conv8Item { const float* W; int ldw, n_src0, k0; unsigned char* WT8; int dst_row0; };
__device__ __forceinline__ Conv8Item conv8_item_of(const Args& A, unsigned char* ws, int it) {
    constexpr int I1 = NE * 16 * 64;
    Conv8Item s;
    if (it < I1) { const int nb = it & 63, kb = (it >> 6) & 15, e = it >> 10; const int d0 = nb * 64, pn = d0 >> 8, rr = d0 & 255;
        s.W = A.in[25] + (size_t)e * DM * 4096; s.ldw = 4096; s.n_src0 = (rr < 128) ? (pn * 128 + rr) : (2048 + pn * 128 + rr - 128); s.k0 = kb * 128; s.WT8 = ws + WS_W1 + (size_t)e * 4096 * DM; s.dst_row0 = d0; }
    else if (it < CONV_NIT) { const int r = it - I1; const int nb = r & 31, kb = (r >> 5) & 15, e = r >> 9;
        s.W = A.in[27] + (size_t)e * DM * DM; s.ldw = DM; s.n_src0 = nb * 64; s.k0 = kb * 128; s.WT8 = ws + WS_W2 + (size_t)e * DM * DM; s.dst_row0 = nb * 64; }
    else { const int r = it - CONV_NIT; const int nb = r & 31, kb = r >> 5;
        s.W = A.in[21]; s.ldw = DM; s.n_src0 = nb * 64; s.k0 = kb * 128; s.WT8 = ws + WS_WOUT; s.dst_row0 = nb * 64; }
    return s;
}
__device__ __forceinline__ void conv8_dma(const Conv8Item& s, LAS unsigned char* buf, int wave, int lane) {
#pragma unroll
    for (int i = 0; i < 4; ++i) { const int q = wave * 4 + i, k = 4 * q + (lane >> 4), c = lane & 15;
        const float* src = s.W + (size_t)(s.k0 + k) * s.ldw + s.n_src0 + ((c ^ ((k >> 4) & 7)) << 2);
        __builtin_amdgcn_global_load_lds((const unsigned*)src, (LAS unsigned*)(buf + q * 1024), 16, 0, 2); }
}
__device__ __forceinline__ void conv8_out(const Conv8Item& sd, const LAS float* scr, int tid) {
    const int kc = tid & 7, n = tid >> 3; const LAS float* s = scr + (16 * kc) * 64 + ((((n >> 2) ^ kc)) << 2) + (n & 3);
    u32x4 o;
    o.x = pk4_fp8(s[0 * 64] * 32.f, s[1 * 64] * 32.f, s[2 * 64] * 32.f, s[3 * 64] * 32.f);     o.y = pk4_fp8(s[4 * 64] * 32.f, s[5 * 64] * 32.f, s[6 * 64] * 32.f, s[7 * 64] * 32.f);
    o.z = pk4_fp8(s[8 * 64] * 32.f, s[9 * 64] * 32.f, s[10 * 64] * 32.f, s[11 * 64] * 32.f);   o.w = pk4_fp8(s[12 * 64] * 32.f, s[13 * 64] * 32.f, s[14 * 64] * 32.f, s[15 * 64] * 32.f);
    *(GAS u32x4*)(sd.WT8 + (size_t)(sd.dst_row0 + n) * DM + sd.k0 + 16 * kc) = o;
}
__device__ __forceinline__ void p0_experts(Frame& F, const Args& A, int cv, int cG, int it_lo, int it_hi) {
    unsigned char* ws = F.ws;
    const int npb = (it_hi - it_lo + cG - 1) / cG, first = it_lo + cv * npb, n = (first + npb <= it_hi) ? npb : (it_hi - first);
    if (n <= 0) return;
#define P0_ITEM(j) conv8_item_of(A, ws, first + (((j) < n) ? (j) : n - 1))
    Conv8Item cur = P0_ITEM(0);
    conv8_dma(cur, F.lds, F.wave, F.lane);
#pragma unroll 1
    for (int j = 1; j < 4; ++j) { const Conv8Item t = P0_ITEM(j); conv8_dma(t, F.lds + j * 32768, F.wave, F.lane); }
    int bi = 0, bn = 4;
#pragma unroll 1
    for (int i = 0; i < n; ++i) {
        if (i < 3) asm volatile("s_waitcnt vmcnt(12)" ::: "memory"); else asm volatile("s_waitcnt vmcnt(15)" ::: "memory");
        asm volatile("s_waitcnt lgkmcnt(0)" ::: "memory"); __builtin_amdgcn_s_barrier(); asm volatile("" ::: "memory");
        { const Conv8Item t4 = P0_ITEM(i + 4); conv8_dma(t4, F.lds + bn * 32768, F.wave, F.lane); }
        conv8_out(cur, (const LAS float*)(F.lds + bi * 32768), F.tid);
        cur = P0_ITEM(i + 1);
        bi = (bi == 4) ? 0 : bi + 1; bn = (bn == 4) ? 0 : bn + 1;
    }
#undef P0_ITEM
    asm volatile("s_waitcnt vmcnt(0)" ::: "memory");
    __syncthreads();
    for (int u = F.tid; u < (LDS_BYTES - LDSCTL_OFF) / 4; u += NWAVES * 64) ((LAS unsigned*)(F.lds + LDSCTL_OFF))[u] = 0u;
    __syncthreads();
}
constexpr int LRU_LDS_PER_WAVE = 16384, LRU_XG_OFF = 9728;
__device__ __forceinline__ float gelu_tanh_f(float x) { return x * fast_sigmoid(1.5957691216057308f * (x + 0.044715f * x * x * x)); }
template <bool PASSB>
__device__ __forceinline__ void lru_item(Frame& F, const Args& A, int item) {
    const int n = item & 15, ck = (item >> 4) & 31, b = item >> 9;
    const int lane = F.lane, l15 = lane & 15, q = lane >> 4;
    unsigned char* ws = F.ws;
    const bf16_t* Z = (const bf16_t*)(ws + WS_Z);
    LAS bf16_t* xl = (LAS bf16_t*)(F.lds + F.wave * LRU_LDS_PER_WAVE);
    LAS bf16_t* xgl = (LAS bf16_t*)(F.lds + F.wave * LRU_LDS_PER_WAVE + LRU_XG_OFF);
    const int t0 = ck * 64; const size_t tokbase = (size_t)b * SEQ;
    float* AS = (float*)(ws + WS_LRUS); float* HS = AS + (size_t)NB * 32 * 1024;
#pragma unroll
    for (int j0 = 0; j0 < 72; j0 += 8) { const int j = j0 + (lane >> 3), t = t0 - 3 + j;
        u32x4 v = (u32x4){0u, 0u, 0u, 0u};
        if (j < 67 && t >= 0) v = *(const GAS u32x4*)(Z + (tokbase + t) * ZW + ZC_XR + n * 64 + (lane & 7) * 8);
        if (j < 67) *(LAS u32x4*)(xl + j * 72 + (lane & 7) * 8) = v; }
    u32x4 xg0[4], xg1[4];
    if (PASSB) {
#pragma unroll
        for (int i = 0; i < 4; ++i) { const int r = 8 * i + (lane >> 3);
            xg0[i] = *(const GAS u32x4*)(Z + (tokbase + t0 + r) * ZW + ZC_XG + n * 64 + (lane & 7) * 8);
            xg1[i] = *(const GAS u32x4*)(Z + (tokbase + t0 + 32 + r) * ZW + ZC_XG + n * 64 + (lane & 7) * 8); }
#pragma unroll
        for (int i = 0; i < 4; ++i) *(LAS u32x4*)(xgl + (8 * i + (lane >> 3)) * 72 + (lane & 7) * 8) = xg0[i];
    }
    const bf16_t* wrg = (const bf16_t*)(ws + WS_SMALL + SM_WRG) + (size_t)n * 4096; const bf16_t* wig = (const bf16_t*)(ws + WS_SMALL + SM_WIG) + (size_t)n * 4096;
    bf16x8 fr_[4][2], fi_[4][2]; float brg[4], big[4], c8[4];
#pragma unroll
    for (int nt = 0; nt < 4; ++nt) {
#pragma unroll
        for (int s = 0; s < 2; ++s) { fr_[nt][s] = *(const GAS bf16x8*)(wrg + (16 * nt + l15) * 64 + 32 * s + 8 * q); fi_[nt][s] = *(const GAS bf16x8*)(wig + (16 * nt + l15) * 64 + 32 * s + 8 * q); }
        const int ch = n * 64 + 16 * nt + l15; brg[nt] = A.in[15][ch]; big[nt] = A.in[17][ch];
        const float L = A.in[18][ch]; const float sp = (L < 0.f) ? (-L + log1pf(__expf(L))) : log1pf(__expf(-L)); c8[nt] = -8.f * sp; }
    LDS_WAIT();
    { const int ch = n * 64 + lane; const float w0 = A.in[12][ch], w1 = A.in[12][1024 + ch], w2 = A.in[12][2048 + ch], w3 = A.in[12][3072 + ch], cb = A.in[13][ch];
      float x0 = bf2f(xl[lane]), x1 = bf2f(xl[72 + lane]), x2 = bf2f(xl[144 + lane]);
#pragma unroll 8
      for (int t = 0; t < 64; ++t) { const float x3 = bf2f(xl[(t + 3) * 72 + lane]); const float xc = cb + w0 * x0 + w1 * x1 + w2 * x2 + w3 * x3; xl[t * 72 + lane] = (bf16_t)f2bf(xc); x0 = x1; x1 = x2; x2 = x3; } }
    LDS_WAIT();
    float carry[4], atot[4];
#pragma unroll
    for (int nt = 0; nt < 4; ++nt) { carry[nt] = 0.f; atot[nt] = 1.f; }
    if (PASSB) {
#pragma unroll 1
        for (int j0 = 0; j0 < ck; j0 += 8) {
            float ta[8][4], th[8][4];
#pragma unroll
            for (int jj = 0; jj < 8; ++jj) { const int j = (j0 + jj < ck) ? j0 + jj : ck - 1;
#pragma unroll
                for (int nt = 0; nt < 4; ++nt) { const size_t o = ((size_t)b * 32 + j) * 1024 + n * 64 + 16 * nt + l15; ta[jj][nt] = AS[o]; th[jj][nt] = HS[o]; } }
#pragma unroll
            for (int jj = 0; jj < 8; ++jj) { if (j0 + jj < ck) {
#pragma unroll
                for (int nt = 0; nt < 4; ++nt) carry[nt] = ta[jj][nt] * carry[nt] + th[jj][nt]; } }
        }
    }
    float gout[4];
#pragma unroll
    for (int nt = 0; nt < 4; ++nt) gout[nt] = PASSB ? A.in[20][n * 64 + 16 * nt + l15] : 0.f;
#pragma unroll 1
    for (int mt = 0; mt < 4; ++mt) {
        const bf16x8 a0 = *(const LAS bf16x8*)(xl + (16 * mt + l15) * 72 + 8 * q), a1 = *(const LAS bf16x8*)(xl + (16 * mt + l15) * 72 + 32 + 8 * q);
        float xg[4][4];
        if (PASSB) {
            if (mt == 2) {
                LDS_WAIT();
#pragma unroll
                for (int i = 0; i < 4; ++i) *(LAS u32x4*)(xgl + (8 * i + (lane >> 3)) * 72 + (lane & 7) * 8) = xg1[i];
                LDS_WAIT();
            }
#pragma unroll
            for (int nt = 0; nt < 4; ++nt)
#pragma unroll
                for (int r = 0; r < 4; ++r) xg[nt][r] = bf2f(xgl[(16 * (mt & 1) + 4 * q + r) * 72 + 16 * nt + l15]);
        }
        float ss[4] = {0.f, 0.f, 0.f, 0.f};
#pragma unroll
        for (int nt = 0; nt < 4; ++nt) {
            f32x4 ar = (f32x4){0.f, 0.f, 0.f, 0.f}, ai = ar;
            ar = __builtin_amdgcn_mfma_f32_16x16x32_bf16(a0, fr_[nt][0], ar, 0, 0, 0); ar = __builtin_amdgcn_mfma_f32_16x16x32_bf16(a1, fr_[nt][1], ar, 0, 0, 0);
            ai = __builtin_amdgcn_mfma_f32_16x16x32_bf16(a0, fi_[nt][0], ai, 0, 0, 0); ai = __builtin_amdgcn_mfma_f32_16x16x32_bf16(a1, fi_[nt][1], ai, 0, 0, 0);
            float av[4], uv[4];
#pragma unroll
            for (int r = 0; r < 4; ++r) {
                const float rg = fast_sigmoid(ar[r] + brg[nt]), ig = fast_sigmoid(ai[r] + big[nt]);
                const float la = c8[nt] * rg; av[r] = __expf(la);
                uv[r] = sqrtf(fmaxf(1.f - av[r] * av[r], 0.f)) * ig * bf2f(xl[(16 * mt + 4 * q + r) * 72 + 16 * nt + l15]);
            }
            const float A4 = (av[0] * av[1]) * (av[2] * av[3]);
            const float H4 = ((uv[0] * av[1] + uv[1]) * av[2] + uv[2]) * av[3] + uv[3];
            float hin = carry[nt], hc = carry[nt], ap = 1.f;
#pragma unroll
            for (int qq = 0; qq < 4; ++qq) { const float Aq = __shfl(A4, l15 + 16 * qq), Hq = __shfl(H4, l15 + 16 * qq);
                hc = Aq * hc + Hq; ap *= Aq; if (qq < q) hin = Aq * hin + Hq; }
            carry[nt] = hc; atot[nt] *= ap;
            if (PASSB) {
                float h = hin;
#pragma unroll
                for (int r = 0; r < 4; ++r) { h = av[r] * h + uv[r]; const float o = h * gelu_tanh_f(xg[nt][r]); ss[r] += o * o;
                    (ws + WS_A2)[(tokbase + t0 + 16 * mt + 4 * q + r) * DM + 1024 + n * 64 + 16 * nt + l15] = (unsigned char)(pk4_fp8c(o * gout[nt] * A2_SCALE, 0.f, 0.f, 0.f) & 0xffu); }
            }
        }
        if (PASSB) {
#pragma unroll
            for (int r = 0; r < 4; ++r) { float v = ss[r]; v += __shfl_xor(v, 1); v += __shfl_xor(v, 2); v += __shfl_xor(v, 4); v += __shfl_xor(v, 8);
                if (l15 == 0) ((float*)(ws + WS_SSL))[(tokbase + t0 + 16 * mt + 4 * q + r) * 16 + n] = v; }
        }
    }
    if (!PASSB) { if (q == 0) {
#pragma unroll
        for (int nt = 0; nt < 4; ++nt) { const size_t o = ((size_t)b * 32 + ck) * 1024 + n * 64 + 16 * nt + l15; AS[o] = atot[nt]; HS[o] = carry[nt]; } } }
    LDS_WAIT();
}
constexpr float C2 = 0.125f * 1.4426950408889634f;
__device__ __forceinline__ int crow(int r, int hi) { return (r & 3) + 8 * (r >> 2) + 4 * hi; }

__device__ __forceinline__ void prep_item(Frame& F, const Args& A, int item) {
    const int b = item >> 5, tl = item & 31; const size_t tok0 = (size_t)b * SEQ + tl * 64;
    unsigned char* ws = F.ws; bf16_t* Z = (bf16_t*)(ws + WS_Z);
    const int tid = F.tid;
    u32x4 qv[16];
    const f32x4 qga = *(const GAS f32x4*)(A.in[10] + (tid & 7) * 8), qgb = *(const GAS f32x4*)(A.in[10] + (tid & 7) * 8 + 4);
#pragma unroll
    for (int it = 0; it < 16; ++it) { const int u = it * 512 + tid, c = u & 7, h = (u >> 3) & 15, r = u >> 7; qv[it] = *(const GAS u32x4*)(Z + (tok0 + r) * ZW + h * 64 + c * 8); }
#pragma unroll
    for (int it = 0; it < 16; ++it) {
        const int u = it * 512 + tid, c = u & 7, h = (u >> 3) & 15, r = u >> 7;
        bf16_t* p = Z + (tok0 + r) * ZW + h * 64 + c * 8;
        const u32x4 v = qv[it];
        float f[8] = {bflo(v.x), bfhi(v.x), bflo(v.y), bfhi(v.y), bflo(v.z), bfhi(v.z), bflo(v.w), bfhi(v.w)};
        float ss = 0.f;
#pragma unroll
        for (int j = 0; j < 8; ++j) ss += f[j] * f[j];
        ss += __shfl_xor(ss, 1); ss += __shfl_xor(ss, 2); ss += __shfl_xor(ss, 4);
        const float rs = rsqrtf(ss * (1.f / 64.f) + EPS) * C2;
        const f32x4 ga = qga, gb = qgb;
        u32x4 o; o.x = pk2(f[0] * rs * ga.x, f[1] * rs * ga.y); o.y = pk2(f[2] * rs * ga.z, f[3] * rs * ga.w); o.z = pk2(f[4] * rs * gb.x, f[5] * rs * gb.y); o.w = pk2(f[6] * rs * gb.z, f[7] * rs * gb.w);
        *(GAS u32x4*)p = o;
    }
    { const int c = tid & 7, r = tid >> 3;
      u32x4 kv[2][4]; f32x4 kga[2], kgb[2];
#pragma unroll
      for (int br = 0; br < 2; ++br) { const float* kg = A.in[11] + (1 + br) * 64 + c * 8; kga[br] = *(const GAS f32x4*)kg; kgb[br] = *(const GAS f32x4*)(kg + 4); }
#pragma unroll
      for (int br = 0; br < 2; ++br)
#pragma unroll
        for (int g = 0; g < 4; ++g) kv[br][g] = *(const GAS u32x4*)(Z + (tok0 + r) * ZW + (br ? ZC_KW : ZC_KS) + g * 64 + c * 8);
#pragma unroll
      for (int br = 0; br < 2; ++br)
#pragma unroll
        for (int g = 0; g < 4; ++g) {
            const u32x4 v = kv[br][g];
            float f[8] = {bflo(v.x), bfhi(v.x), bflo(v.y), bfhi(v.y), bflo(v.z), bfhi(v.z), bflo(v.w), bfhi(v.w)};
            float ss = 0.f;
#pragma unroll
            for (int j = 0; j < 8; ++j) ss += f[j] * f[j];
            ss += __shfl_xor(ss, 1); ss += __shfl_xor(ss, 2); ss += __shfl_xor(ss, 4);
            const float rs = rsqrtf(ss * (1.f / 64.f) + EPS);
            const f32x4 ga = kga[br], gb = kgb[br];
            u32x4 o; o.x = pk2(f[0] * rs * ga.x, f[1] * rs * ga.y); o.y = pk2(f[2] * rs * ga.z, f[3] * rs * ga.w); o.z = pk2(f[4] * rs * gb.x, f[5] * rs * gb.y); o.w = pk2(f[6] * rs * gb.z, f[7] * rs * gb.w);
            unsigned char* img = ws + WS_KIMG + (br ? KI_KW : KI_KS) + ((size_t)(b * 4 + g) * 32 + tl) * 8192;
            *(GAS u32x4*)(img + c * 1024 + r * 16) = o;
        }
    }
    { LAS bf16_t* vt = (LAS bf16_t*)F.lds;
      const int c = tid & 7, r = tid >> 3;
      u32x4 vv[8];
#pragma unroll
      for (int k = 0; k < 8; ++k) { const int br = k >> 2, g = k & 3; vv[k] = *(const GAS u32x4*)(Z + (tok0 + r) * ZW + (br ? ZC_VW : ZC_VS) + g * 64 + c * 8); }
      asm volatile("" : "+v"(vv[0]), "+v"(vv[1]), "+v"(vv[2]), "+v"(vv[3]), "+v"(vv[4]), "+v"(vv[5]), "+v"(vv[6]), "+v"(vv[7]));
#pragma unroll
      for (int k = 0; k < 8; ++k) *(LAS u32x4*)(vt + k * 4608 + r * 72 + c * 8) = vv[k];
      __syncthreads();
#pragma unroll
      for (int k = 0; k < 8; ++k) { const int br = k >> 2, g = k & 3;
          unsigned char* img = ws + WS_KIMG + (br ? KI_VW : KI_VS) + ((size_t)(b * 4 + g) * 32 + tl) * 8192;
#pragma unroll
          for (int hlf = 0; hlf < 2; ++hlf) { const int un = hlf * 512 + tid, kc = un >> 6, d = un & 63;
              const LAS bf16_t* s = vt + k * 4608 + (4 * kc) * 72 + d;
              u32x2 o; o.x = (unsigned)s[0] | ((unsigned)s[72] << 16); o.y = (unsigned)s[144] | ((unsigned)s[216] << 16);
              *(GAS u32x2*)(img + kc * 512 + d * 8) = o; } }
      __syncthreads(); }
}
__device__ __forceinline__ void compress_item(Frame& F, const Args& A, int item) {
    const int which = item & 1, cg = (item >> 1) & 7, g = (item >> 4) & 3, b = item >> 6;
    const int lane = F.lane, l15 = lane & 15, q = lane >> 4, c0 = cg * 16;
    unsigned char* ws = F.ws; const bf16_t* Z = (const bf16_t*)(ws + WS_Z);
    const bf16_t* WT = (const bf16_t*)(ws + WS_SMALL + (which ? SM_WCV : SM_WCK));
    const int zc = (which ? ZC_VC : ZC_KC) + g * 64;
    f32x4 acc[4];
#pragma unroll
    for (int nt = 0; nt < 4; ++nt) acc[nt] = (f32x4){0.f, 0.f, 0.f, 0.f};
    size_t tb = (size_t)b * SEQ + 16 * (c0 + l15);
#pragma unroll 1
    for (int s0 = 0; s0 < 64; s0 += 4) {
        bf16x8 xv[4], wv[4][4];
#pragma unroll
        for (int ss = 0; ss < 4; ++ss) { const int s = s0 + ss;
            size_t trow = tb + (s >> 1); if (trow > (size_t)b * SEQ + SEQ - 1) trow = (size_t)b * SEQ + SEQ - 1;
            xv[ss] = *(const GAS bf16x8*)(Z + trow * ZW + zc + 32 * (s & 1) + 8 * q);
#pragma unroll
            for (int nt = 0; nt < 4; ++nt) wv[ss][nt] = *(const GAS bf16x8*)(WT + (size_t)(16 * nt + l15) * DM + 32 * s + 8 * q); }
        asm volatile("" : "+v"(xv[0]), "+v"(xv[1]), "+v"(wv[0][0]), "+v"(wv[0][1]), "+v"(wv[0][2]), "+v"(wv[0][3]), "+v"(wv[1][0]), "+v"(wv[1][1]), "+v"(wv[1][2]), "+v"(wv[1][3]) :: "memory");
        asm volatile("" : "+v"(xv[2]), "+v"(xv[3]), "+v"(wv[2][0]), "+v"(wv[2][1]), "+v"(wv[2][2]), "+v"(wv[2][3]), "+v"(wv[3][0]), "+v"(wv[3][1]), "+v"(wv[3][2]), "+v"(wv[3][3]) :: "memory");
#pragma unroll
        for (int ss = 0; ss < 4; ++ss)
#pragma unroll
            for (int nt = 0; nt < 4; ++nt) {
                if (which == 0) acc[nt] = __builtin_amdgcn_mfma_f32_16x16x32_bf16(wv[ss][nt], xv[ss], acc[nt], 0, 0, 0);
                else            acc[nt] = __builtin_amdgcn_mfma_f32_16x16x32_bf16(xv[ss], wv[ss][nt], acc[nt], 0, 0, 0); }
    }
    if (which == 0) {
        const float* bias = (const float*)(ws + WS_SMALL + SM_BIASK);
        float ss = 0.f;
#pragma unroll
        for (int nt = 0; nt < 4; ++nt) { const f32x4 bv = *(const GAS f32x4*)(bias + 16 * nt + 4 * q); acc[nt] += bv; ss += (acc[nt].x * acc[nt].x + acc[nt].y * acc[nt].y) + (acc[nt].z * acc[nt].z + acc[nt].w * acc[nt].w); }
        ss += __shfl_xor(ss, 16); ss += __shfl_xor(ss, 32);
        const float rs = rsqrtf(ss * (1.f / 64.f) + EPS);
        const int c = c0 + l15, T = c >> 6, r = c & 63;
        unsigned char* img = ws + WS_KIMG + KI_KC + ((size_t)(b * 4 + g) * 2 + T) * 8192;
#pragma unroll
        for (int nt = 0; nt < 4; ++nt) { const f32x4 kg = *(const GAS f32x4*)(A.in[11] + 16 * nt + 4 * q);
            u32x2 o; o.x = pk2(acc[nt].x * rs * kg.x, acc[nt].y * rs * kg.y); o.y = pk2(acc[nt].z * rs * kg.z, acc[nt].w * rs * kg.w);
            if (c == 127) { o.x = 0u; o.y = 0u; }
            *(GAS u32x2*)(img + (2 * nt + (q >> 1)) * 1024 + r * 16 + (q & 1) * 8) = o; }
    } else {
        const float* bias = (const float*)(ws + WS_SMALL + SM_BIASV);
        const int cb = c0 + 4 * q, T = cb >> 6, kc = (cb & 63) >> 2;
        unsigned char* img = ws + WS_KIMG + KI_VC + ((size_t)(b * 4 + g) * 2 + T) * 8192;
#pragma unroll
        for (int nt = 0; nt < 4; ++nt) { const float bv = bias[16 * nt + l15];
            float v3 = acc[nt].w + bv; if (cb + 3 == 127) v3 = 0.f;
            u32x2 o; o.x = pk2(acc[nt].x + bv, acc[nt].y + bv); o.y = pk2(acc[nt].z + bv, v3);
            *(GAS u32x2*)(img + kc * 512 + (16 * nt + l15) * 8) = o; }
    }
}

constexpr int AT_SLOT = 16384, AT_IMP = 65536, AT_OT = 98304, AT_SEL = TILETAB_OFF, AT_SS = TILETAB_OFF + 256, AT_OST = 0;
__device__ __forceinline__ void at_stage(LAS unsigned char* lds, int slot, const unsigned char* kimg, const unsigned char* vimg, int wave, int lane) {
    __builtin_amdgcn_global_load_lds((const unsigned*)(kimg + wave * 1024 + lane * 16), (LAS unsigned*)(lds + slot * AT_SLOT + wave * 1024), 16, 0, 0);
    __builtin_amdgcn_global_load_lds((const unsigned*)(vimg + wave * 1024 + lane * 16), (LAS unsigned*)(lds + slot * AT_SLOT + 8192 + wave * 1024), 16, 0, 0);
}
__device__ __forceinline__ void at_qkt(f32x16& p0, f32x16& p1, const LAS unsigned char* ks, const bf16x8 (&qr)[4], const f32x16& cin, int r32, int hi) {
#pragma unroll
    for (int d0 = 0; d0 < 4; ++d0) {
        const bf16x8 k0 = *(const LAS bf16x8*)(ks + (2 * d0 + hi) * 1024 + r32 * 16), k1 = *(const LAS bf16x8*)(ks + (2 * d0 + hi) * 1024 + 512 + r32 * 16);
        if (d0 == 0) { p0 = __builtin_amdgcn_mfma_f32_32x32x16_bf16(k0, qr[0], cin, 0, 0, 0); p1 = __builtin_amdgcn_mfma_f32_32x32x16_bf16(k1, qr[0], cin, 0, 0, 0); }
        else { p0 = __builtin_amdgcn_mfma_f32_32x32x16_bf16(k0, qr[d0], p0, 0, 0, 0); p1 = __builtin_amdgcn_mfma_f32_32x32x16_bf16(k1, qr[d0], p1, 0, 0, 0); }
    }
}
__device__ __forceinline__ bf16x8 at_pack8(const f32x16& p, int base) {
    u32x4 w; w.x = cvt_pk_bf16(p[base], p[base + 1]); w.y = cvt_pk_bf16(p[base + 2], p[base + 3]); w.z = cvt_pk_bf16(p[base + 4], p[base + 5]); w.w = cvt_pk_bf16(p[base + 6], p[base + 7]);
    return __builtin_bit_cast(bf16x8, w);
}
__device__ __forceinline__ void at_pvp(f32x16 (&o)[2], bf16x8 pa0, bf16x8 pa1, bf16x8 pa2, bf16x8 pa3, const LAS unsigned char* vs, int r32, int hi) {
#pragma unroll
    for (int d0 = 0; d0 < 2; ++d0) {
        const LAS unsigned char* vb = vs + (32 * d0 + r32) * 8 + hi * 512;
#pragma unroll
        for (int s = 0; s < 4; ++s) {
            const s16x4 lo = *(const LAS s16x4*)(vb + (4 * s) * 512), h4 = *(const LAS s16x4*)(vb + (4 * s + 2) * 512);
            const bf16x8 vf = (bf16x8){lo[0], lo[1], lo[2], lo[3], h4[0], h4[1], h4[2], h4[3]};
            o[d0] = __builtin_amdgcn_mfma_f32_32x32x16_bf16(s == 0 ? pa0 : s == 1 ? pa1 : s == 2 ? pa2 : pa3, vf, o[d0], 0, 0, 0);
        }
    }
}
__device__ __forceinline__ void at_pv(f32x16 (&o)[2], const f32x16& p0, const f32x16& p1, const LAS unsigned char* vs, int r32, int hi) {
    at_pvp(o, at_pack8(p0, 0), at_pack8(p0, 8), at_pack8(p1, 0), at_pack8(p1, 8), vs, r32, hi);
}
__device__ __forceinline__ void at_tile(const LAS unsigned char* slot, const LAS unsigned char* ql, f32x16 (&o)[2], float& l, bool usekill, bool kill, bool masked, int kvlo, int kvhi, int r32, int hi) {
    bf16x8 kf[8];
#pragma unroll
    for (int d0 = 0; d0 < 4; ++d0) { kf[2 * d0] = *(const LAS bf16x8*)(slot + (2 * d0 + hi) * 1024 + r32 * 16); kf[2 * d0 + 1] = *(const LAS bf16x8*)(slot + (2 * d0 + hi) * 1024 + 512 + r32 * 16); }
    bf16x8 q4[4];
#pragma unroll
    for (int d0 = 0; d0 < 4; ++d0) q4[d0] = *(const LAS bf16x8*)(ql + d0 * 1024);
    const f32x16 zero16 = (f32x16){0.f, 0.f, 0.f, 0.f, 0.f, 0.f, 0.f, 0.f, 0.f, 0.f, 0.f, 0.f, 0.f, 0.f, 0.f, 0.f};
    f32x16 p0 = __builtin_amdgcn_mfma_f32_32x32x16_bf16(kf[0], q4[0], zero16, 0, 0, 0), p1 = __builtin_amdgcn_mfma_f32_32x32x16_bf16(kf[1], q4[0], zero16, 0, 0, 0);
#pragma unroll
    for (int d0 = 1; d0 < 4; ++d0) { p0 = __builtin_amdgcn_mfma_f32_32x32x16_bf16(kf[2 * d0], q4[d0], p0, 0, 0, 0); p1 = __builtin_amdgcn_mfma_f32_32x32x16_bf16(kf[2 * d0 + 1], q4[d0], p1, 0, 0, 0); }
    s16x4 vlo[2][4], vhi[2][4];
    const LAS unsigned char* vs = slot + 8192;
#pragma unroll
    for (int d0 = 0; d0 < 2; ++d0) { const LAS unsigned char* vb = vs + (32 * d0 + r32) * 8 + hi * 512;
#pragma unroll
        for (int s = 0; s < 4; ++s) { vlo[d0][s] = *(const LAS s16x4*)(vb + (4 * s) * 512); vhi[d0][s] = *(const LAS s16x4*)(vb + (4 * s + 2) * 512); } }
    if (masked) {
#pragma unroll
        for (int r = 0; r < 16; ++r) { const int kv = crow(r, hi);
            if (kv < kvlo || kv > kvhi) p0[r] = -INFINITY;
            if (kv + 32 < kvlo || kv + 32 > kvhi) p1[r] = -INFINITY; }
    }
    float s = 0.f;
#pragma unroll
    for (int r = 0; r < 16; ++r) { p0[r] = __builtin_amdgcn_exp2f(p0[r]); p1[r] = __builtin_amdgcn_exp2f(p1[r]); s += p0[r] + p1[r]; }
    u32x4 w0, w1, w2, w3;
    w0.x = cvt_pk_bf16(p0[0], p0[1]); w0.y = cvt_pk_bf16(p0[2], p0[3]); w0.z = cvt_pk_bf16(p0[4], p0[5]); w0.w = cvt_pk_bf16(p0[6], p0[7]);
    w1.x = cvt_pk_bf16(p0[8], p0[9]); w1.y = cvt_pk_bf16(p0[10], p0[11]); w1.z = cvt_pk_bf16(p0[12], p0[13]); w1.w = cvt_pk_bf16(p0[14], p0[15]);
    w2.x = cvt_pk_bf16(p1[0], p1[1]); w2.y = cvt_pk_bf16(p1[2], p1[3]); w2.z = cvt_pk_bf16(p1[4], p1[5]); w2.w = cvt_pk_bf16(p1[6], p1[7]);
    w3.x = cvt_pk_bf16(p1[8], p1[9]); w3.y = cvt_pk_bf16(p1[10], p1[11]); w3.z = cvt_pk_bf16(p1[12], p1[13]); w3.w = cvt_pk_bf16(p1[14], p1[15]);
    if (usekill) { const unsigned km = kill ? 0u : 0xffffffffu; s = kill ? 0.f : s;
        w0 = w0 & km; w1 = w1 & km; w2 = w2 & km; w3 = w3 & km; }
    l += s;
#pragma unroll
    for (int d0 = 0; d0 < 2; ++d0)
#pragma unroll
        for (int s4 = 0; s4 < 4; ++s4) { const bf16x8 vf = (bf16x8){vlo[d0][s4][0], vlo[d0][s4][1], vlo[d0][s4][2], vlo[d0][s4][3], vhi[d0][s4][0], vhi[d0][s4][1], vhi[d0][s4][2], vhi[d0][s4][3]};
            o[d0] = __builtin_amdgcn_mfma_f32_32x32x16_bf16(__builtin_bit_cast(bf16x8, s4 == 0 ? w0 : s4 == 1 ? w1 : s4 == 2 ? w2 : w3), vf, o[d0], 0, 0, 0); }
}

struct AtPre { bf16x8 q[4]; float gl[3]; };
__device__ __forceinline__ void at_first_stages(LAS unsigned char* lds, unsigned char* ws, int b, int g, int qblk, int wid, int lane) {
    const unsigned char* kimg_c = ws + WS_KIMG + KI_KC + (size_t)(b * 4 + g) * 2 * 8192;
    at_stage(lds, 0, kimg_c, kimg_c + (KI_VC - KI_KC), wid, lane); at_stage(lds, 1, kimg_c + 8192, kimg_c + 8192 + (KI_VC - KI_KC), wid, lane);
    const int j0 = (qblk >= 8) ? qblk - 8 : 0, total = (qblk + 1) + (qblk - j0 + 1);
#pragma unroll
    for (int it = 0; it < 2; ++it) { int i_ = it; if (i_ > total - 1) i_ = total - 1; const bool br_ = i_ > qblk; const int j_ = br_ ? j0 + (i_ - qblk - 1) : i_;
        const unsigned char* ki = ws + WS_KIMG + (br_ ? KI_KW : KI_KS) + ((size_t)(b * 4 + g) * 32 + j_) * 8192; at_stage(lds, (it + 2) & 3, ki, ki + (KI_VS - KI_KS), wid, lane); }
}
__device__ __forceinline__ void at_load_q(AtPre& pr, const bf16_t* Z, int b, int g, int qblk, int wid, int lane) {
    const int r32 = lane & 31, hi = lane >> 5, hh = wid >> 1, th = wid & 1, h = 4 * g + hh; const size_t tok = (size_t)b * SEQ + qblk * 64 + 32 * th + r32;
#pragma unroll
    for (int d0 = 0; d0 < 4; ++d0) pr.q[d0] = *(const GAS bf16x8*)(Z + tok * ZW + h * 64 + 16 * d0 + 8 * hi);
    const bf16_t* glp = Z + tok * ZW + ZC_GL + h * 3;
    pr.gl[0] = bf2f(glp[0]); pr.gl[1] = bf2f(glp[1]); pr.gl[2] = bf2f(glp[2]);
}
__device__ __forceinline__ void attn_unit(Frame& F, const Args& A, int b, int g, int qblk, bool pre_valid, AtPre& pre, bool has_next, int nb, int ng, int nq) {
    const int tid = F.tid, lane = F.lane, r32 = lane & 31, hi = lane >> 5, wid = F.wave, hh = wid >> 1, th = wid & 1, h = 4 * g + hh;
    unsigned char* ws = F.ws; const bf16_t* Z = (const bf16_t*)(ws + WS_Z);
    LAS unsigned char* lds = F.lds;
    const int qs = qblk * 64, tq = 32 * th + r32, t = qs + tq; const size_t tok = (size_t)b * SEQ + t;
    const unsigned char* kimg_c = ws + WS_KIMG + KI_KC + (size_t)(b * 4 + g) * 2 * 8192;
    const int j0 = (qblk >= 8) ? qblk - 8 : 0, total = (qblk + 1) + (qblk - j0 + 1);
#define AT_STAGE_IT(itx) do { int _i = (itx); if (_i > total - 1) _i = total - 1; const bool _br = _i > qblk; const int _j = _br ? j0 + (_i - qblk - 1) : _i; \
        const unsigned char* _ki = ws + WS_KIMG + (_br ? KI_KW : KI_KS) + ((size_t)(b * 4 + g) * 32 + _j) * 8192; at_stage(lds, ((itx) + 2) & 3, _ki, _ki + (KI_VS - KI_KS), wid, lane); } while (0)
    if (!pre_valid) { at_first_stages(lds, ws, b, g, qblk, wid, lane); at_load_q(pre, Z, b, g, qblk, wid, lane); }
    bf16x8 qr[4];
#pragma unroll
    for (int d0 = 0; d0 < 4; ++d0) qr[d0] = pre.q[d0];
    const float g0 = fast_sigmoid(pre.gl[0]), g1 = fast_sigmoid(pre.gl[1]), g2 = fast_sigmoid(pre.gl[2]);
    asm volatile("s_waitcnt vmcnt(0)" ::: "memory"); __builtin_amdgcn_s_barrier();
    {
        const int cmax = (t >= 31) ? ((t - 31) >> 4) : -1;
        f32x16 oc[2];
#pragma unroll
        for (int r = 0; r < 16; ++r) { oc[0][r] = 0.f; oc[1][r] = 0.f; }
        float l = 0.f, xprev = 0.f;
        LAS float* impw = (LAS float*)(lds + AT_IMP) + (size_t)(hh * 64 + tq) * 32;
#pragma unroll 1
        for (int T = 0; T < 2; ++T) {
            f32x16 p0, p1;
            { const f32x16 zero = (f32x16){0.f, 0.f, 0.f, 0.f, 0.f, 0.f, 0.f, 0.f, 0.f, 0.f, 0.f, 0.f, 0.f, 0.f, 0.f, 0.f}; at_qkt(p0, p1, lds + T * AT_SLOT, qr, zero, r32, hi); }
            float s = 0.f;
#pragma unroll
            for (int r = 0; r < 16; ++r) { const int c = 64 * T + crow(r, hi); if (c > cmax) p0[r] = -INFINITY; if (c + 32 > cmax) p1[r] = -INFINITY;
                p0[r] = __builtin_amdgcn_exp2f(p0[r]); p1[r] = __builtin_amdgcn_exp2f(p1[r]); s += p0[r] + p1[r]; }
            l += s;
#pragma unroll
            for (int u = 0; u < 2; ++u)
#pragma unroll
                for (int rr = 0; rr < 4; ++rr) {
                    const float a0 = u ? p1[4 * rr] : p0[4 * rr], a1 = u ? p1[4 * rr + 1] : p0[4 * rr + 1], a2 = u ? p1[4 * rr + 2] : p0[4 * rr + 2], a3 = u ? p1[4 * rr + 3] : p0[4 * rr + 3];
                    const float xc = __shfl_xor(a3, 32);
                    impw[2 * (8 * T + 4 * u + rr) + hi] = ((a0 + a1) + (a2 + a3)) + (hi ? xc : xprev);
                    xprev = xc;
                }
            at_pv(oc, p0, p1, lds + T * AT_SLOT + 8192, r32, hi);
        }
        l += __shfl_xor(l, 32);
        const float inv = (l > 0.f) ? 1.f / l : 0.f;
#pragma unroll
        for (int i = 0; i < 16; ++i) impw[2 * i + hi] *= inv;
        const float sc = g0 * inv;
        { LAS unsigned* otp = (LAS unsigned*)(lds + AT_OT + wid * 4096) + lane;
#pragma unroll
          for (int r = 0; r < 16; r += 2) { const float f0 = __shfl(sc, crow(r, hi)), f1 = __shfl(sc, crow(r + 1, hi));
              otp[(r >> 1) * 64] = cvt_pk_bf16(oc[0][r] * f0, oc[0][r + 1] * f1); otp[(8 + (r >> 1)) * 64] = cvt_pk_bf16(oc[1][r] * f0, oc[1][r + 1] * f1); } }
    }
    asm volatile("s_waitcnt lgkmcnt(0)" ::: "memory"); __builtin_amdgcn_s_barrier();
    AT_STAGE_IT(2);
    {
        const int tk = tid >> 3, sub = tid & 7;
        const LAS float* ip = (const LAS float*)(lds + AT_IMP) + tk * 32 + 4 * sub;
        const f32x4 i0 = *(const LAS f32x4*)ip, i1 = *(const LAS f32x4*)(ip + 64 * 32), i2 = *(const LAS f32x4*)(ip + 2 * 64 * 32), i3 = *(const LAS f32x4*)(ip + 3 * 64 * 32);
        const f32x4 vs = ((i0 + i1) + i2) + i3;
        float v[4] = {vs.x, vs.y, vs.z, vs.w};
        unsigned mask;
        if (qblk < 8) mask = (2u << qblk) - 1u;
        else {
#pragma unroll
            for (int jj = 0; jj < 4; ++jj) { const int j = 4 * sub + jj; const bool forced = (j == 0) || (j == qblk) || (j == qblk - 1); v[jj] = forced ? 1e30f : ((j <= qblk) ? v[jj] : -1e30f); }
            mask = 0u;
#pragma unroll 1
            for (int k = 0; k < 8; ++k) {
                float bv = v[0]; int bi = 4 * sub;
#pragma unroll
                for (int jj = 1; jj < 4; ++jj) if (v[jj] > bv) { bv = v[jj]; bi = 4 * sub + jj; }
#pragma unroll
                for (int o = 1; o < 8; o <<= 1) { const float ov = __shfl_xor(bv, o); const int oi = __shfl_xor(bi, o); if (ov > bv || (ov == bv && oi < bi)) { bv = ov; bi = oi; } }
                mask |= 1u << bi;
#pragma unroll
                for (int jj = 0; jj < 4; ++jj) if (bi == 4 * sub + jj) v[jj] = -INFINITY;
            }
        }
        if (sub == 0) ((LAS unsigned*)(lds + AT_SEL))[tk] = mask;
    }
    asm volatile("s_waitcnt vmcnt(0) lgkmcnt(0)" ::: "memory"); __builtin_amdgcn_s_barrier();
    const unsigned selm = ((const LAS unsigned*)(lds + AT_SEL))[tq];
    const LAS unsigned char* ql = lds + AT_IMP + wid * 4096 + lane * 16;
#pragma unroll
    for (int d0 = 0; d0 < 4; ++d0) *(LAS bf16x8*)(lds + AT_IMP + wid * 4096 + d0 * 1024 + lane * 16) = qr[d0];
    asm volatile("s_waitcnt lgkmcnt(0)" ::: "memory");
    f32x16 o[2];
    {
#pragma unroll
        for (int r = 0; r < 16; ++r) { o[0][r] = 0.f; o[1][r] = 0.f; }
        float l = 0.f;
#pragma unroll 1
        for (int it = 0; it < total; ++it) {
            const int cur = (it + 2) & 3; const bool br = it > qblk; const int j = br ? j0 + (it - qblk - 1) : it;
            AT_STAGE_IT(it + 3);
            bool masked, kill; int kvlo, kvhi;
            if (!br) { masked = (j == qblk); kvlo = 0; kvhi = tq; kill = !((selm >> j) & 1u); }
            else { const bool first = (qblk >= 8) && (j == j0), lastt = (j == qblk); masked = first || lastt; kvlo = first ? tq + 1 : 0; kvhi = lastt ? tq : 63; kill = false; }
            at_tile(lds + cur * AT_SLOT, ql, o, l, !br, kill, masked, kvlo, kvhi, r32, hi);
            asm volatile("s_waitcnt vmcnt(4) lgkmcnt(0)" ::: "memory"); __builtin_amdgcn_s_barrier();
            if (it == qblk || it == total - 1) {
                l += __shfl_xor(l, 32);
                const float sc = (br ? g2 : g1) / l;
                LAS unsigned* otp = (LAS unsigned*)(lds + AT_OT + wid * 4096) + lane;
                if (!br) {
#pragma unroll
                    for (int r = 0; r < 16; r += 2) { const float f0 = __shfl(sc, crow(r, hi)), f1 = __shfl(sc, crow(r + 1, hi));
                        const unsigned a = otp[(r >> 1) * 64], c = otp[(8 + (r >> 1)) * 64];
                        otp[(r >> 1) * 64] = cvt_pk_bf16(bflo(a) + o[0][r] * f0, bfhi(a) + o[0][r + 1] * f1); otp[(8 + (r >> 1)) * 64] = cvt_pk_bf16(bflo(c) + o[1][r] * f0, bfhi(c) + o[1][r + 1] * f1);
                        o[0][r] = 0.f; o[0][r + 1] = 0.f; o[1][r] = 0.f; o[1][r + 1] = 0.f; }
                } else {
#pragma unroll
                    for (int r = 0; r < 16; r += 2) { const float f0 = __shfl(sc, crow(r, hi)), f1 = __shfl(sc, crow(r + 1, hi));
                        const unsigned a = otp[(r >> 1) * 64], c = otp[(8 + (r >> 1)) * 64];
                        o[0][r] = bflo(a) + o[0][r] * f0; o[0][r + 1] = bfhi(a) + o[0][r + 1] * f1; o[1][r] = bflo(c) + o[1][r] * f0; o[1][r + 1] = bfhi(c) + o[1][r + 1] * f1; }
                }
                l = 0.f;
            }
        }
    }
    asm volatile("s_waitcnt vmcnt(0)" ::: "memory"); __builtin_amdgcn_s_barrier();
#undef AT_STAGE_IT
    {
        if (has_next) { at_first_stages(lds, ws, nb, ng, nq, wid, lane); at_load_q(pre, Z, nb, ng, nq, wid, lane); }
        LAS bf16_t* stg = (LAS bf16_t*)(lds + AT_IMP + wid * 4096);
#pragma unroll
        for (int r = 0; r < 16; ++r) { const int orow = crow(r, hi); stg[orow * 64 + r32] = (bf16_t)f2bf(o[0][r]); stg[orow * 64 + 32 + r32] = (bf16_t)f2bf(o[1][r]); }
        asm volatile("s_waitcnt lgkmcnt(0)" ::: "memory");
        unsigned char* A2 = ws + WS_A2;
        const int ch = lane & 7;
        const f32x4 ga = *(const GAS f32x4*)(A.in[19] + h * 64 + ch * 8), gb = *(const GAS f32x4*)(A.in[19] + h * 64 + ch * 8 + 4);
        LAS float* ssl = (LAS float*)(lds + AT_SS);
#pragma unroll
        for (int i = 0; i < 4; ++i) { const int row = i * 8 + (lane >> 3);
            const u32x4 v = *(const LAS u32x4*)(stg + row * 64 + ch * 8);
            const float f[8] = {bflo(v.x), bfhi(v.x), bflo(v.y), bfhi(v.y), bflo(v.z), bfhi(v.z), bflo(v.w), bfhi(v.w)};
            float ss = 0.f;
#pragma unroll
            for (int j = 0; j < 8; ++j) ss += f[j] * f[j];
            ss += __shfl_xor(ss, 1); ss += __shfl_xor(ss, 2); ss += __shfl_xor(ss, 4);
            if (ch == 0) ssl[hh * 64 + 32 * th + row] = ss;
            u32x2 o; o.x = pk4_fp8c(f[0] * ga.x * A2_SCALE, f[1] * ga.y * A2_SCALE, f[2] * ga.z * A2_SCALE, f[3] * ga.w * A2_SCALE); o.y = pk4_fp8c(f[4] * gb.x * A2_SCALE, f[5] * gb.y * A2_SCALE, f[6] * gb.z * A2_SCALE, f[7] * gb.w * A2_SCALE);
            *(GAS u32x2*)(A2 + ((size_t)b * SEQ + qs + 32 * th + row) * DM + h * 64 + ch * 8) = o; }
        asm volatile("s_waitcnt lgkmcnt(0)" ::: "memory"); __builtin_amdgcn_s_barrier();
        if (tid < 64) ((float*)(ws + WS_SSN))[((size_t)b * SEQ + qs + tid) * 4 + g] = ((ssl[tid] + ssl[64 + tid]) + ssl[128 + tid]) + ssl[192 + tid];
        asm volatile("s_waitcnt lgkmcnt(0)" ::: "memory"); __builtin_amdgcn_s_barrier();
    }
}
constexpr bool W2_LATE = false;
constexpr int NCX = 10, JOIN_PH = 4, CONV_SPLIT = 3072;
__global__ void __launch_bounds__(NWAVES * 64, 2) mega(Args args) {
    extern __shared__ __attribute__((aligned(16))) unsigned char lds_raw[];
    Frame F;
    F.lds = (LAS unsigned char*)lds_raw;
    F.tid = threadIdx.x; F.lane = F.tid & 63; F.wave = __builtin_amdgcn_readfirstlane(F.tid >> 6);
    F.ws = args.ws; F.ctl = (gu32*)(args.ws + WS_CTL);
    unsigned char* ws = args.ws;
    for (int u = F.tid; u < (LDS_BYTES - LDSCTL_OFF) / 4; u += NWAVES * 64) ((LAS unsigned*)(F.lds + LDSCTL_OFF))[u] = 0u;
    __syncthreads();
    volatile LAS unsigned* MISC = (volatile LAS unsigned*)(F.lds + MISC_OFF);
    const int lo = args.ph_lo, hi = args.ph_hi;
    const int G0 = gridDim.x, bx0 = blockIdx.x;
    const int vcu0 = (G0 % 8 == 0) ? (bx0 % 8) * (G0 / 8) + bx0 / 8 : bx0;
    const bool part = (G0 == 256) && lo < JOIN_PH && hi > JOIN_PH;
    const int xl = vcu0 & 31, xx = vcu0 >> 5;
    const bool is_conv = part && xl >= 32 - NCX;
    const int GB = part ? G0 - 8 * NCX : G0, vcuB = part ? xx * (32 - NCX) + xl : vcu0, bxB = part ? xl * 8 + xx : bx0;
    const int cv = (xl - (32 - NCX)) * 8 + xx;
    const bool w2_late = W2_LATE && (G0 == 256) && lo == 0 && hi > 5;
    const bool conv5 = w2_late && xl >= 32 - NCX;
    XcdBarrier bar = xcd_barrier_post((unsigned*)(F.ctl + CW_BAR) + args.li * XCD_BAR_WORDS, MISC + 8, (unsigned)G0, true);
    XcdBarrier barB = xcd_barrier_post((unsigned*)(F.ctl + CW_BAR) + (8 + args.li) * XCD_BAR_WORDS, MISC + 10, (unsigned)GB, part && !is_conv);
#define IN(k) (lo <= (k) && (k) < hi)
#define BOTH(k) (IN(k) && IN((k) + 1))
#define GRID_BAR(k) do { if (part && (k) + 1 < JOIN_PH) xcd_barrier(barB); else xcd_barrier(bar); } while (0)
#define SET_ID(k) do { const bool sub_ = part && (k) < JOIN_PH; F.G = sub_ ? GB : G0; F.vcu = sub_ ? vcuB : vcu0; F.bx = sub_ ? bxB : bx0; gw = F.vcu * NWAVES + F.wave; NGW = F.G * NWAVES; gw2 = F.wave * F.G + F.vcu; } while (0)
    int gw, NGW, gw2;
    SET_ID(lo);
    const float* mod = (const float*)(ws + WS_MOD);

    if (IN(0)) {
        p0_experts(F, args, is_conv ? cv : F.vcu, is_conv ? 8 * NCX : F.G, is_conv ? CONV_SPLIT : 0, (part && !is_conv) ? CONV_SPLIT : (w2_late ? CONV_NIT1 : CONV_NITX));
        if (!is_conv) p0_prologue(F, args);
        if (!is_conv && BOTH(0)) GRID_BAR(0);
    }
    if (is_conv) { xcd_barrier(bar); }
    const bool skip_pre = is_conv;
    if (IN(1) && !(skip_pre && 1 < JOIN_PH)) {
        const float* modp = (const float*)(ws + WS_MODPART); float* modw = (float*)(ws + WS_MOD);
        if (F.bx == 0 && F.wave < 2) pebias_reduce((const float*)(ws + WS_PEPART) + F.wave * 2048, (float*)(ws + WS_SMALL + (F.wave ? SM_BIASV : SM_BIASK)), F.lane);
        for (int idx = F.bx * (NWAVES * 64) + F.tid; idx < NB * 6 * DM; idx += F.G * NWAVES * 64) modw[idx] = mod_reduce1(modp, args.in[3], idx);
        LAS float* lmod = (LAS float*)F.lds;
        const int rpb = ((NTOK + F.G - 1) / F.G + 7) & ~7, r0 = F.bx * rpb, r1 = (r0 + rpb < NTOK) ? r0 + rpb : NTOK;
        int curb = -1;
        f32x4 g1v[8];
#pragma unroll
        for (int j = 0; j < 8; ++j) g1v[j] = *((const GAS f32x4*)args.in[4] + F.lane + 64 * j);
        for (int rb = r0; rb < r1; rb += 8) {
            const int b = rb / SEQ;
            if (b != curb) { __syncthreads(); for (int i = F.tid; i < 2 * DM; i += NWAVES * 64) lmod[i] = mod_reduce1(modp, args.in[3], b * 6 * DM + i); curb = b; __syncthreads(); }
            const int row = rb + F.wave;
            if (row < r1) {
                const GAS f32x4* xr = (const GAS f32x4*)(args.in[0] + (size_t)row * DM) + F.lane;
                f32x4 v[8]; float s = 0.f;
#pragma unroll
                for (int j = 0; j < 8; ++j) { v[j] = xr[64 * j]; s += (v[j].x * v[j].x + v[j].y * v[j].y) + (v[j].z * v[j].z + v[j].w * v[j].w); }
                const float rstd = rsqrtf(wsum(s) * (1.f / DM) + EPS);
                GAS unsigned long long* o8 = (GAS unsigned long long*)((bf16_t*)(ws + WS_H) + (size_t)row * DM) + F.lane;
#pragma unroll
                for (int j = 0; j < 8; ++j) {
                    const f32x4 gg = g1v[j], sh = *((const LAS f32x4*)lmod + F.lane + 64 * j), sc = *((const LAS f32x4*)(lmod + DM) + F.lane + 64 * j);
                    const f32x4 hv = v[j] * rstd * gg * (sc + 1.f) + sh;
                    o8[64 * j] = (unsigned long long)pk2(hv.x, hv.y) | ((unsigned long long)pk2(hv.z, hv.w) << 32);
                }
            }
        }
        __syncthreads();
        if (BOTH(1)) GRID_BAR(1);
    }
    if (IN(2)) SET_ID(2);
    if (IN(2) && !(skip_pre && 2 < JOIN_PH)) {
        ProbZ P; P.ord.init(NTOK, ZW, F.G, F.bx); P.A = (const bf16_t*)(ws + WS_H); P.Bt = (const bf16_t*)(ws + WS_WIN); P.Z = (bf16_t*)(ws + WS_Z);
        g8::gemm_phase<ProbZ>(F.lds, P);
        if (BOTH(2)) GRID_BAR(2);
    }
    if (IN(3)) SET_ID(3);
    if (IN(3) && !(skip_pre && 3 < JOIN_PH)) {
        for (int it = F.bx; it < NB * 32; it += F.G) prep_item(F, args, it);
        for (int it = gw2; it < NB * 4 * 8 * 2; it += NGW) compress_item(F, args, it);
        for (int it = gw; it < NB * 32 * 16; it += NGW) lru_item<false>(F, args, it);
        if (BOTH(3)) GRID_BAR(3);
    }
    if (IN(4)) SET_ID(4);
    if (IN(4)) {
        {
            const bool bal = (F.G == 256); const int nu = bal ? 4 : (NB * 4 * 32 + F.G - 1 - F.bx) / F.G;
            AtPre pre; bool pv = false;
#define AT_UNIT_OF(ii, bgv, qbv) do { if (bal) { const int s_ = F.vcu & 7; bgv = F.vcu >> 3; qbv = ((ii) == 0) ? 31 - s_ : ((ii) == 1) ? 16 + s_ : ((ii) == 2) ? 15 - s_ : s_; } \
                else { const int u_ = F.bx + (ii) * F.G; bgv = u_ & 31; qbv = 31 - (u_ >> 5); } } while (0)
#pragma unroll 1
            for (int i = 0; i < nu; ++i) {
                int bg, qb, nbg = 0, nqb = 0; AT_UNIT_OF(i, bg, qb);
                const bool hn = (i + 1 < nu); if (hn) AT_UNIT_OF(i + 1, nbg, nqb);
                attn_unit(F, args, bg >> 2, bg & 3, qb, pv, pre, hn, nbg >> 2, nbg & 3, nqb);
                pv = hn;
            }
#undef AT_UNIT_OF
        }
        for (int it = gw; it < NB * 32 * 16; it += NGW) lru_item<true>(F, args, it);
        if (BOTH(4)) GRID_BAR(4);
    }
    if (IN(5) && conv5) { p0_experts(F, args, cv, 8 * NCX, CONV_NIT1, CONV_NIT); if (BOTH(5)) GRID_BAR(5); }
    if (IN(5) && !conv5) {
        if (w2_late) { F.G = GB; F.vcu = vcuB; F.bx = bxB; }
        ProbMix8 P; P.ord.init(NTOK, DM, F.G, F.bx); P.A8 = ws + WS_A2; P.W8 = ws + WS_WOUT; P.x = args.in[0]; P.mod = mod; P.x1b = (bf16_t*)(ws + WS_X1B);
        P.rs = (const LAS float*)(F.lds + RSTAB_OFF);
        p5_build_rstab(F, P.ord, (const float*)(ws + WS_SSN), (const float*)(ws + WS_SSL));
        g8::gemm8_phase<ProbMix8>(F.lds, P);
        if (BOTH(5)) GRID_BAR(5);
    }
    if (IN(6)) SET_ID(6);
    if (IN(6)) { p6_route(F, args, mod); if (BOTH(6)) GRID_BAR(6); }
    if (IN(7)) {
        build_tile_table(F);
        ProbM1F P; P.ord.tab = (const LAS int*)(F.lds + TILETAB_OFF); P.ord.G = F.G; P.ord.c = F.bx; P.ord.NPN = 16;
        P.H8 = ws + WS_H8; P.W1T8 = ws + WS_W1; P.b1 = args.in[26]; P.rowtok = (const int*)(ws + WS_ROUTE + RT_ROWTOK); P.ACT8 = ws + WS_ACT;
        g8::gemm8_phase<ProbM1F>(F.lds, P);
        if (BOTH(7)) GRID_BAR(7);
    }
    if (IN(8)) {
        build_tile_table(F);
        ProbM2F P; P.ord.tab = (const LAS int*)(F.lds + TILETAB_OFF); P.ord.G = F.G; P.ord.c = F.bx; P.ord.NPN = 8;
        P.ACT8 = ws + WS_ACT; P.W2T8 = ws + WS_W2; P.b2 = args.in[28]; P.rowg = (const float*)(ws + WS_ROUTE + RT_ROWG); P.Y8 = ws + WS_Y;
        g8::gemm8_phase<ProbM2F>(F.lds, P);
        if (BOTH(8)) GRID_BAR(8);
    }
    if (IN(9)) { build_tile_table(F); p9_combine(F, args, mod); }
#undef IN
#undef BOTH
#undef GRID_BAR
#undef SET_ID
}

extern "C" void kernel_launch(void* const* d_in, const int* in_sizes, int n_in, void* d_out, int out_size, void* d_ws, size_t ws_size, hipStream_t stream) {
    float* out = (float*)d_out;
    static int grid = 0;
    if (grid == 0) {
        int dev = 0, cus = 0;
        (void)hipGetDevice(&dev); (void)hipDeviceGetAttribute(&cus, hipDeviceAttributeMultiprocessorCount, dev);
        (void)hipFuncSetAttribute((const void*)mega, hipFuncAttributeMaxDynamicSharedMemorySize, LDS_BYTES);
        int per_cu = 0;
        (void)hipOccupancyMaxActiveBlocksPerMultiprocessor(&per_cu, (const void*)mega, NWAVES * 64, LDS_BYTES);
        (void)hipGetLastError();
        grid = (cus > 0 ? cus : 256) * (per_cu >= 1 ? 1 : 1);
    }
    char* ws = (char*)d_ws;
    (void)ws_size; (void)in_sizes; (void)n_in; (void)out_size;

    (void)hipMemsetAsync(ws + WS_CTL, 0, CTL_ZERO_BYTES, stream);
    Args a{};
    for (int i = 0; i < 29; ++i) a.in[i] = (const float*)d_in[i];
    a.out = out; a.ws = (unsigned char*)d_ws; a.ph_lo = 0; a.ph_hi = 10; a.li = 0; a.pad = 0;
    hipLaunchKernelGGL(mega, dim3(grid), dim3(NWAVES * 64), LDS_BYTES, stream, a);
}
```
